# Optimizing an MI355X kernel written in HIP

```python
import math
import jax, jax.numpy as jnp
from jax import lax
import numpy as np

D_MODEL = 1024
BATCH = 8
SEQ = 2048
DEPTH = 4
DEC_BATCH = 128
DEC_SEQ = 1
PAST_LEN = 16384
PAGE_SIZE = 128

N_M_HEADS = 4
M_HEAD_DIM = D_MODEL // N_M_HEADS
M_WIDTH = N_M_HEADS * M_HEAD_DIM
CHUNK = 64
POOL_WINDOWS = (2, 4, 8, 16)
N_POOL_GROUPS = len(POOL_WINDOWS)
POOL_GROUP_DIM = D_MODEL // N_POOL_GROUPS
POOL_WIDTH = N_POOL_GROUPS * POOL_GROUP_DIM
POOL_BUF = max(POOL_WINDOWS) - 1
N_MEM = 256
N_X_HEADS = 4
X_HEAD_DIM = D_MODEL // N_X_HEADS
X_WIDTH = N_X_HEADS * X_HEAD_DIM
D_FF = ((8 * D_MODEL // 3 + 127) // 128) * 128
CONV_WIDTH = 3
N_BRANCH = 3
ALPHA = (2.0 * DEPTH) ** 0.25
BETA = (8.0 * DEPTH) ** -0.25
LN_EPS = 1e-5
NEG = -1e30
IN_SPLITS = (M_WIDTH, M_WIDTH, M_WIDTH, M_WIDTH, N_M_HEADS, N_M_HEADS, POOL_WIDTH, X_WIDTH, N_BRANCH * D_MODEL)
IN_WIDTH = sum(IN_SPLITS)
IN_OFFSETS = tuple(int(v) for v in np.cumsum(IN_SPLITS)[:-1])
F_GATE_OFF = 4 * M_WIDTH + N_M_HEADS

kernel_name = "hybrid_mlstm_pool_memxattn_step"


def layer_norm(x, g, b):
    xf = x.astype(jnp.float32)
    mu = jnp.mean(xf, axis=-1, keepdims=True)
    var = jnp.mean(jnp.square(xf - mu), axis=-1, keepdims=True)
    return ((xf - mu) * lax.rsqrt(var + LN_EPS) * g.astype(jnp.float32) + b.astype(jnp.float32)).astype(x.dtype)


def mlstm_chunkwise(q, k, v, ig, lf, C0, n0, m0):
    B, L, H, Dk = q.shape
    f32 = jnp.float32
    Lc = min(CHUNK, L)
    nc = -(-L // Lc)
    pad = nc * Lc - L
    q = q.astype(f32)
    k = k.astype(f32) * (Dk ** -0.5)
    v = v.astype(f32)
    ig = ig.astype(f32)
    lf = lf.astype(f32)
    if pad:
        p4 = ((0, 0), (0, pad), (0, 0), (0, 0))
        p3 = ((0, 0), (0, pad), (0, 0))
        q, k, v = jnp.pad(q, p4), jnp.pad(k, p4), jnp.pad(v, p4)
        ig = jnp.pad(ig, p3, constant_values=NEG)
        lf = jnp.pad(lf, p3)

    def to_chunks(t):
        return jnp.moveaxis(t.reshape((B, nc, Lc) + t.shape[2:]), 1, 0)

    causal = jnp.tril(jnp.ones((Lc, Lc), dtype=bool))[None, :, :, None]

    def step(carry, inp):
        C, n, m = carry
        qc, kc, vc, ic, fc = inp
        b = jnp.cumsum(fc, axis=1)
        a = ic - b
        mt = b + jnp.maximum(m[:, None, :], lax.cummax(a, axis=1))
        inter = jnp.exp(m[:, None, :] + b - mt)
        logd = a[:, None, :, :] + b[:, :, None, :] - mt[:, :, None, :]
        dmat = jnp.exp(jnp.where(causal, logd, NEG))
        s = jnp.einsum('bthd,bshd->btsh', qc, kc) * dmat
        num = jnp.einsum('btsh,bshd->bthd', s, vc) + inter[..., None] * jnp.einsum('bthd,bhde->bthe', qc, C)
        den = jnp.sum(s, axis=2) + inter * jnp.einsum('bthd,bhd->bth', qc, n)
        h = num / jnp.maximum(jnp.abs(den), jnp.exp(-mt))[..., None]
        mL = mt[:, -1]
        bL = b[:, -1]
        ws = jnp.exp(a + bL[:, None] - mL[:, None])
        decay = jnp.exp(m + bL - mL)
        kw = kc * ws[..., None]
        C_new = decay[..., None, None] * C + jnp.einsum('bshd,bshe->bhde', kw, vc)
        n_new = decay[..., None] * n + jnp.sum(kw, axis=1)
        return (C_new, n_new, mL), h

    (C, n, m), h = lax.scan(step, (C0.astype(f32), n0.astype(f32), m0.astype(f32)),
                            tuple(to_chunks(t) for t in (q, k, v, ig, lf)))
    h = jnp.moveaxis(h, 0, 1).reshape(B, nc * Lc, H, Dk)[:, :L]
    return h, C, n, m


def pool_mix(u, buf, pos0, w_pool, pool_scale):
    B, L, _ = u.shape
    P = POOL_BUF
    ext = jnp.concatenate([buf.astype(u.dtype), u], axis=1)
    extf = ext.astype(jnp.float32)
    cs = jnp.concatenate([jnp.zeros((B, 1, POOL_WIDTH), jnp.float32), jnp.cumsum(extf, axis=1)], axis=1)
    pos = pos0 + jnp.arange(L, dtype=jnp.int32)
    outs = []
    for g, w in enumerate(POOL_WINDOWS):
        lo, hi = g * POOL_GROUP_DIM, (g + 1) * POOL_GROUP_DIM
        wsum = cs[:, P + 1:P + 1 + L, lo:hi] - cs[:, P + 1 - w:P + 1 - w + L, lo:hi]
        cnt = jnp.minimum(w, pos + 1).astype(jnp.float32)[None, :, None]
        outs.append(wsum / cnt - extf[:, P:, lo:hi])
    d = jnp.stack(outs, axis=2).astype(u.dtype)
    y = jnp.einsum('blgc,gce->blge', d, w_pool).reshape(B, L, POOL_WIDTH) * pool_scale
    return y, ext[:, -P:]


def mem_kv(mem, w_kv):
    B = mem.shape[0]
    kv = (mem @ w_kv).reshape(B, N_MEM, 2, N_X_HEADS, X_HEAD_DIM)
    return kv[:, :, 0], kv[:, :, 1]


def mem_xattn(xq, mk, mv, w_x_out):
    B, L, _ = xq.shape
    q = xq.reshape(B, L, N_X_HEADS, X_HEAD_DIM).astype(jnp.float32)
    s = jnp.einsum('blhd,bmhd->bhlm', q, mk.astype(jnp.float32)) * (X_HEAD_DIM ** -0.5)
    p = jax.nn.softmax(s, axis=-1)
    o = jnp.einsum('bhlm,bmhd->blhd', p, mv.astype(jnp.float32)).astype(xq.dtype)
    return o.reshape(B, L, X_WIDTH) @ w_x_out


def conv_ffn(x, buf, w_up, conv_w, conv_b, w_down):
    L = x.shape[1]
    hup = x @ w_up
    ext = jnp.concatenate([buf.astype(hup.dtype), hup], axis=1)
    c = ext[:, 0:L] * conv_w[0] + ext[:, 1:L + 1] * conv_w[1] + ext[:, 2:L + 2] * conv_w[2] + conv_b
    a, b = jnp.split(c, 2, axis=-1)
    return (jax.nn.gelu(a) * b) @ w_down, ext[:, -(CONV_WIDTH - 1):]


def trunk_layer(x, mk, mv, C0, n0, m0, pbuf, cbuf, pos0,
                w_in, b_in, mh_g, w_m_out, w_pool, pool_scale, w_x_out, w_o,
                ln1_g, ln1_b, w_up, conv_w, conv_b, w_down, ln2_g, ln2_b):
    B, L, _ = x.shape
    proj = x @ w_in + b_in
    q, k, v, o, ig, fg, u, xq, gates = jnp.split(proj, IN_OFFSETS, axis=-1)
    hs = lambda t: t.reshape(B, L, N_M_HEADS, M_HEAD_DIM)
    lf = jax.nn.log_sigmoid(fg.astype(jnp.float32))
    ht, C, n, m = mlstm_chunkwise(hs(q), hs(k), hs(v), ig, lf, C0, n0, m0)
    hc = jax.nn.sigmoid(hs(o).astype(jnp.float32)) * ht
    mu = jnp.mean(hc, axis=-1, keepdims=True)
    var = jnp.mean(jnp.square(hc - mu), axis=-1, keepdims=True)
    hn = (hc - mu) * lax.rsqrt(var + LN_EPS) * mh_g.reshape(N_M_HEADS, M_HEAD_DIM).astype(jnp.float32)
    y_m = hn.reshape(B, L, M_WIDTH).astype(x.dtype) @ w_m_out
    y_p, pbuf_new = pool_mix(u, pbuf, pos0, w_pool, pool_scale)
    y_x = mem_xattn(xq, mk, mv, w_x_out)
    g = jax.nn.sigmoid(gates.reshape(B, L, N_BRANCH, D_MODEL))
    mix = (g[:, :, 0] * y_m + g[:, :, 1] * y_p + g[:, :, 2] * y_x) @ w_o
    x = layer_norm(ALPHA * x + mix, ln1_g, ln1_b)
    f, cbuf_new = conv_ffn(x, cbuf, w_up, conv_w, conv_b, w_down)
    x = layer_norm(ALPHA * x + f, ln2_g, ln2_b)
    return (x, C.astype(C0.dtype), n.astype(n0.dtype), m.astype(m0.dtype),
            pbuf_new.astype(pbuf.dtype), cbuf_new.astype(cbuf.dtype))


def setup_inputs(seed: int = 0) -> dict:
    key = jax.random.key(seed)
    ks = iter(jax.random.split(key, 40))

    def nrm(shape, scale):
        return scale * jax.random.normal(next(ks), shape, jnp.float32)

    d = {}
    d['x_prompt'] = nrm((BATCH, SEQ, D_MODEL), 1.0)
    d['mem_prompt'] = nrm((BATCH, N_MEM, D_MODEL), 1.0)
    d['x_sample'] = nrm((DEC_BATCH, DEC_SEQ, D_MODEL), 1.0)
    d['cache_mem_k'] = nrm((DEPTH, DEC_BATCH, N_MEM, N_X_HEADS, X_HEAD_DIM), 1.0)
    d['cache_mem_v'] = nrm((DEPTH, DEC_BATCH, N_MEM, N_X_HEADS, X_HEAD_DIM), 1.0)
    d['state_C'] = nrm((DEPTH, DEC_BATCH, N_M_HEADS, M_HEAD_DIM, M_HEAD_DIM), 1.0)
    d['state_n'] = nrm((DEPTH, DEC_BATCH, N_M_HEADS, M_HEAD_DIM), 1.0)
    d['state_m'] = nrm((DEPTH, DEC_BATCH, N_M_HEADS), 1.0)
    d['state_pool'] = nrm((DEPTH, DEC_BATCH, POOL_BUF, POOL_WIDTH), 1.0)
    d['state_conv'] = nrm((DEPTH, DEC_BATCH, CONV_WIDTH - 1, 2 * D_FF), 1.0)
    d['ln_in_g'] = 1.0 + nrm((D_MODEL,), 0.02)
    d['ln_in_b'] = nrm((D_MODEL,), 0.02)
    d['w_in'] = nrm((DEPTH, D_MODEL, IN_WIDTH), D_MODEL ** -0.5)
    b_in = nrm((DEPTH, IN_WIDTH), 0.02)
    d['b_in'] = b_in.at[:, F_GATE_OFF:F_GATE_OFF + N_M_HEADS].add(jnp.linspace(3.0, 6.0, N_M_HEADS))
    d['mh_g'] = 1.0 + nrm((DEPTH, M_WIDTH), 0.02)
    d['w_m_out'] = nrm((DEPTH, M_WIDTH, D_MODEL), M_WIDTH ** -0.5)
    d['w_pool'] = nrm((DEPTH, N_POOL_GROUPS, POOL_GROUP_DIM, POOL_GROUP_DIM), POOL_GROUP_DIM ** -0.5)
    d['pool_scale'] = 1.0 + nrm((DEPTH, POOL_WIDTH), 0.02)
    d['w_mem_kv'] = nrm((DEPTH, D_MODEL, 2 * X_WIDTH), D_MODEL ** -0.5)
    d['w_x_out'] = nrm((DEPTH, X_WIDTH, D_MODEL), X_WIDTH ** -0.5)
    d['w_o'] = nrm((DEPTH, D_MODEL, D_MODEL), BETA * D_MODEL ** -0.5)
    d['ln1_g'] = 1.0 + nrm((DEPTH, D_MODEL), 0.02)
    d['ln1_b'] = nrm((DEPTH, D_MODEL), 0.02)
    d['w_up'] = nrm((DEPTH, D_MODEL, 2 * D_FF), D_MODEL ** -0.5)
    d['conv_w'] = nrm((DEPTH, CONV_WIDTH, 2 * D_FF), CONV_WIDTH ** -0.5)
    d['conv_b'] = nrm((DEPTH, 2 * D_FF), 0.02)
    d['w_down'] = nrm((DEPTH, D_FF, D_MODEL), BETA * D_FF ** -0.5)
    d['ln2_g'] = 1.0 + nrm((DEPTH, D_MODEL), 0.02)
    d['ln2_b'] = nrm((DEPTH, D_MODEL), 0.02)
    return d


def reference(x_prompt, mem_prompt, x_sample, cache_mem_k, cache_mem_v, state_C, state_n, state_m,
              state_pool, state_conv, ln_in_g, ln_in_b, w_in, b_in, mh_g, w_m_out, w_pool, pool_scale,
              w_mem_kv, w_x_out, w_o, ln1_g, ln1_b, w_up, conv_w, conv_b, w_down, ln2_g, ln2_b):
    dt = x_prompt.dtype
    xp = layer_norm(x_prompt, ln_in_g, ln_in_b)
    xs = layer_norm(x_sample, ln_in_g, ln_in_b)
    pC, pn, pm, ppool, pconv, pmk, pmv = [], [], [], [], [], [], []
    sC, sn, sm, spool, sconv = [], [], [], [], []
    for l in range(DEPTH):
        w = (w_in[l], b_in[l], mh_g[l], w_m_out[l], w_pool[l], pool_scale[l], w_x_out[l], w_o[l],
             ln1_g[l], ln1_b[l], w_up[l], conv_w[l], conv_b[l], w_down[l], ln2_g[l], ln2_b[l])
        mk, mv = mem_kv(mem_prompt, w_mem_kv[l])
        xp, C1, n1, m1, pb1, cb1 = trunk_layer(
            xp, mk, mv,
            jnp.zeros((BATCH, N_M_HEADS, M_HEAD_DIM, M_HEAD_DIM), dt),
            jnp.zeros((BATCH, N_M_HEADS, M_HEAD_DIM), dt),
            jnp.zeros((BATCH, N_M_HEADS), dt),
            jnp.zeros((BATCH, POOL_BUF, POOL_WIDTH), dt),
            jnp.zeros((BATCH, CONV_WIDTH - 1, 2 * D_FF), dt),
            0, *w)
        pC.append(C1); pn.append(n1); pm.append(m1); ppool.append(pb1); pconv.append(cb1)
        pmk.append(mk); pmv.append(mv)
        xs, C2, n2, m2, pb2, cb2 = trunk_layer(
            xs, cache_mem_k[l], cache_mem_v[l], state_C[l], state_n[l], state_m[l],
            state_pool[l], state_conv[l], PAST_LEN, *w)
        sC.append(C2); sn.append(n2); sm.append(m2); spool.append(pb2); sconv.append(cb2)
    return (xp, xs,
            jnp.stack(pC), jnp.stack(pn), jnp.stack(pm), jnp.stack(ppool), jnp.stack(pconv),
            jnp.stack(pmk), jnp.stack(pmv),
            jnp.stack(sC), jnp.stack(sn), jnp.stack(sm), jnp.stack(spool), jnp.stack(sconv))
```

```cpp
#include <hip/hip_runtime.h>
#include <cstdio>
#include <cstdint>

#define LAS __attribute__((address_space(3)))
#define GAS __attribute__((address_space(1)))
typedef unsigned short bf16;
typedef short bf16x8 __attribute__((ext_vector_type(8)));
typedef float f32x4 __attribute__((ext_vector_type(4)));
typedef float f32x2 __attribute__((ext_vector_type(2)));
typedef unsigned u32x4 __attribute__((ext_vector_type(4)));
typedef unsigned u32x2 __attribute__((ext_vector_type(2)));
#define DI __device__ __forceinline__

#ifndef PHMASK
#define PHMASK 0xFFFFFFFFu
#endif
#ifndef SUBMASK
#define SUBMASK 0xFFFFFFFFu
#endif
#define SM(b) ((SUBMASK >> (b)) & 1u)
#ifndef MK_SPLIT
#define MK_SPLIT 0
#endif

constexpr int D = 1024, NB = 8, SEQ = 2048, MP = NB * SEQ, MS = 128, MT = MP + MS, MTP = MP + 256, DEPTH = 4;
constexpr int NPROJ = 9216, INW = 9224;
constexpr int C_Q = 0, C_K = 1024, C_V = 2048, C_O = 3072, C_U = 4096, C_XQ = 5120, C_G = 6144;
constexpr int FF = 2816, FF2 = 5632, NMEM = 256, HD = 256, NH = 4;
constexpr float LN_EPS = 1e-5f;
constexpr float ALPHA = 1.681792830507429f;
constexpr int PAST_LEN = 16384;

constexpr size_t O_YP = 0, O_YS = 16777216, O_PC = 16908288, O_PN = 25296896, O_PM = 25329664, O_PPOOL = 25329792, O_PCONV = 25821312,
                 O_PMK = 26181760, O_PMV = 34570368, O_SC = 42958976, O_SN = 177176704, O_SM = 177700992, O_SPOOL = 177703040, O_SCONV = 185567360, O_END = 191334528;

constexpr size_t al256(size_t x) { return (x + 255) & ~(size_t)255; }
constexpr size_t WS_CTL = 0, CTL_BYTES = 2u << 20;
constexpr size_t WS_WIN = CTL_BYTES;                                        constexpr size_t SZ_WIN = (size_t)NPROJ * D * 2;
constexpr size_t WS_WM = WS_WIN + DEPTH * SZ_WIN;                           constexpr size_t SZ_W1K = (size_t)D * D * 2;
constexpr size_t WS_WX = WS_WM + DEPTH * SZ_W1K;
constexpr size_t WS_WO = WS_WX + DEPTH * SZ_W1K;
constexpr size_t WS_WP = WS_WO + DEPTH * SZ_W1K;                            constexpr size_t SZ_WP = (size_t)4 * 256 * 256 * 2;
constexpr size_t WS_WKV = WS_WP + DEPTH * SZ_WP;                            constexpr size_t SZ_WKV = (size_t)2048 * D * 2;
constexpr size_t WS_WUP = WS_WKV + DEPTH * SZ_WKV;                          constexpr size_t SZ_WUP = (size_t)FF2 * D * 2;
constexpr size_t WS_WDN = WS_WUP + DEPTH * SZ_WUP;                          constexpr size_t SZ_WDN = (size_t)D * FF * 2;
constexpr size_t WS_X = al256(WS_WDN + DEPTH * SZ_WDN);
constexpr size_t WS_T = WS_X + (size_t)MTP * D * 4;
constexpr size_t WS_MIX = WS_T + (size_t)MTP * D * 4;
constexpr size_t WS_XN = WS_MIX + (size_t)MTP * D * 4;
constexpr size_t WS_PROJ = WS_XN + (size_t)MTP * D * 2;
constexpr size_t WS_HC = WS_PROJ + (size_t)MTP * NPROJ * 2;
constexpr size_t WS_HN = WS_HC + (size_t)MTP * D * 2;
constexpr size_t WS_DP = WS_HN + (size_t)MTP * D * 2;
constexpr size_t WS_PB = WS_DP + (size_t)MTP * D * 2;
constexpr size_t WS_OX = WS_PB + (size_t)MTP * D * 2;
constexpr size_t WS_MIXB = WS_OX + (size_t)MTP * D * 2;
constexpr size_t WS_HUP = WS_MIXB + (size_t)MTP * D * 2;
constexpr size_t WS_ACT = WS_HUP + (size_t)MTP * FF2 * 2;
constexpr size_t WS_IGFG = WS_ACT + (size_t)MTP * FF * 2;
constexpr size_t WS_MEMB = WS_IGFG + (size_t)MTP * 8 * 4;
constexpr size_t WS_MK = WS_MEMB + (size_t)2048 * D * 2;
constexpr size_t WS_MVT = WS_MK + (size_t)DEPTH * 2048 * D * 2;
constexpr size_t WS_END = WS_MVT + (size_t)DEPTH * 2048 * D * 2;
static_assert(WS_END <= 2147483648ull, "workspace map exceeds 2 GiB");
constexpr int CW_BAR = 4096;

constexpr int LDS_BYTES = 147456;
constexpr int XCH_OFF = 131072;
constexpr int MISC_OFF = LDS_BYTES - 256;

DI float bf2f(unsigned v) { return __uint_as_float(v << 16); }
DI unsigned f2bf(float f) { unsigned u = __float_as_uint(f); return (u + 0x7fffu + ((u >> 16) & 1u)) >> 16; }
DI unsigned pk2(float lo, float hi) { return f2bf(lo) | (f2bf(hi) << 16); }
DI float lo16(unsigned w) { return __uint_as_float(w << 16); }
DI float hi16(unsigned w) { return __uint_as_float(w & 0xffff0000u); }
DI float sigmoid_fast(float x) { return __builtin_amdgcn_rcpf(1.0f + __expf(-x)); }
DI float wave_sum(float v) {
#pragma unroll
    for (int o = 1; o < 64; o <<= 1) v += __shfl_xor(v, o);
    return v;
}
DI void unpack8(const u32x4 w, float (&f)[8]) { f[0] = lo16(w.x); f[1] = hi16(w.x); f[2] = lo16(w.y); f[3] = hi16(w.y); f[4] = lo16(w.z); f[5] = hi16(w.z); f[6] = lo16(w.w); f[7] = hi16(w.w); }
DI int opaque_tid() { int t = threadIdx.x; asm volatile("" : "+v"(t)); return t; }
#define LDS_WAIT() asm volatile("s_waitcnt lgkmcnt(0)" ::: "memory")
#define VM_WAIT() asm volatile("s_waitcnt vmcnt(0)" ::: "memory")

namespace pg8 {
constexpr int BM = 256, BK = 64, HALF = 128, HTB = HALF * BK * 2, STAGE_BYTES = 8 * HTB, NXCD = 8, WGM = 8;
__host__ __device__ __forceinline__ int lds_byte(int r, int c) { const int st = (r >> 4) * 2 + (c >> 5), rr = r & 15, cc = c & 31, ob = rr * 64 + cc * 2; return st * 1024 + (ob ^ (((ob >> 9) & 1) << 5)); }
__host__ __device__ __forceinline__ void stage_rc(int b, int& R, int& C) { const int st = b / 1024, sb = b % 1024, swz = sb ^ (((sb >> 9) & 1) << 5); R = (st >> 1) * 16 + swz / 64; C = (st & 1) * 32 + (swz % 64) / 2; }

struct Unit { const char* a; const char* b; int pm, pn; };

struct OrderMN {
    int nM, nN, nwg, G, c; const char* A; const char* Bt; size_t astep, bstep, apn;
    DI void init(const bf16* A_, int lda, const bf16* Bt_, int ldb, int M, int N, int G_, int c_, int apn_ = 0) { nM = M / BM; nN = N / BM; nwg = nM * nN; G = G_; c = c_; A = (const char*)A_; Bt = (const char*)Bt_; astep = (size_t)BM * lda * 2; bstep = (size_t)BM * ldb * 2; apn = (size_t)apn_; }
    DI bool next(int i, Unit& u) const {
        const long L = (long)i * G + c; if (L >= nwg) return false;
        int wgid = (int)L; { const int q = nwg / NXCD, r = nwg % NXCD, xcd = wgid % NXCD, off = wgid / NXCD; wgid = (xcd < r ? xcd * (q + 1) : r * (q + 1) + (xcd - r) * q) + off; }
        const int nig = WGM * nN, gid = wgid / nig, fm = gid * WGM, gsz = (nM - fm) < WGM ? (nM - fm) : WGM;
        u.pm = fm + ((wgid % nig) % gsz); u.pn = (wgid % nig) / gsz; u.a = A + (size_t)u.pm * astep + (size_t)u.pn * apn; u.b = Bt + (size_t)u.pn * bstep; return true;
    }
};

template <class Epi, class Sched>
DI void gemm_phase(LAS unsigned char* lds, const int K, const int lda, const int ldb, const Sched& S, const Epi& E) {
    const int tid = opaque_tid(), wid = __builtin_amdgcn_readfirstlane(tid >> 6), lane = tid & 63, wr = wid >> 2, wc = wid & 3, fr = lane & 15, fq = lane >> 4;
    const int nt = K / BK;
    unsigned voffA[2], voffB[2];
#pragma unroll
    for (int i = 0; i < 2; ++i) { int R, C; stage_rc(tid * 16 + i * 8192, R, C); voffA[i] = (unsigned)(R * lda + C) * 2u; voffB[i] = (unsigned)(R * ldb + C) * 2u; }
    const size_t kstep = (size_t)(BK * 2);
    const size_t hstepA = (size_t)HALF * lda * 2, hstepB = (size_t)HALF * ldb * 2;
    const unsigned ldsw = (unsigned)wid * 1024u;
    const int aoff = lds_byte(wr * 64 + fr, fq * 8), boff = lds_byte(wc * 32 + fr, fq * 8);
#define PG8_SA(b, h) (((b) * 2 + (h)) * HTB)
#define PG8_SB(b, h) ((4 + (b) * 2 + (h)) * HTB)
#define PG8_STAGE(bufoff, gbase, voff) do { _Pragma("unroll") for (int _i = 0; _i < 2; ++_i) \
        __builtin_amdgcn_global_load_lds((const unsigned*)((const char*)(gbase) + (voff)[_i]), (LAS unsigned*)(lds + (bufoff) + ldsw + _i * 8192), 16, 0, 0); } while (0)
#define PG8_LDA(dst, b, h) do { _Pragma("unroll") for (int m = 0; m < 4; ++m) _Pragma("unroll") for (int k = 0; k < 2; ++k) dst[m][k] = *(const LAS bf16x8*)(lds + PG8_SA(b, h) + aoff + m * 2048 + k * 1024); } while (0)
#define PG8_LDB(dst, b, h) do { _Pragma("unroll") for (int n = 0; n < 2; ++n) _Pragma("unroll") for (int k = 0; k < 2; ++k) dst[n][k] = *(const LAS bf16x8*)(lds + PG8_SB(b, h) + boff + n * 2048 + k * 1024); } while (0)
#define PG8_MMA(ai, bj, At, Bt) do { __builtin_amdgcn_s_setprio(1); _Pragma("unroll") for (int m = 0; m < 4; ++m) _Pragma("unroll") for (int n = 0; n < 2; ++n) _Pragma("unroll") for (int k = 0; k < 2; ++k) \
        acc[ai][bj][m][n] = __builtin_amdgcn_mfma_f32_16x16x32_bf16(Bt[n][k], At[m][k], acc[ai][bj][m][n], 0, 0, 0); __builtin_amdgcn_s_setprio(0); } while (0)
#define PG8_WAIT_V(n) asm volatile("s_waitcnt vmcnt(" #n ")" ::: "memory")
#define PG8_WAIT_L(n) asm volatile("s_waitcnt lgkmcnt(" #n ")" ::: "memory")
#define PG8_BAR __builtin_amdgcn_s_barrier()
#define PG8_SCHED __builtin_amdgcn_sched_barrier(0)
    Unit cur, nxt; int ui = 0;
    if (!S.next(0, cur)) return;
    f32x4 acc[2][2][4][2];
#pragma unroll
    for (int a = 0; a < 2; ++a)
#pragma unroll
        for (int b = 0; b < 2; ++b)
#pragma unroll
            for (int m = 0; m < 4; ++m)
#pragma unroll
                for (int n = 0; n < 2; ++n) acc[a][b][m][n] = (f32x4){0.f, 0.f, 0.f, 0.f};
    bf16x8 At[4][2], B0[2][2], B1[2][2];
    const char* cA = cur.a; const char* cB = cur.b;
    PG8_STAGE(PG8_SB(0, 0), cB, voffB); PG8_STAGE(PG8_SB(0, 1), cB + hstepB, voffB); PG8_STAGE(PG8_SA(0, 0), cA, voffA); PG8_STAGE(PG8_SA(0, 1), cA + hstepA, voffA);
    if (wr == 1) PG8_BAR;
    PG8_WAIT_V(2); PG8_BAR;
    PG8_STAGE(PG8_SB(1, 0), cB + kstep, voffB); PG8_STAGE(PG8_SA(1, 0), cA + kstep, voffA); PG8_STAGE(PG8_SB(1, 1), cB + hstepB + kstep, voffB);
    PG8_WAIT_V(6); PG8_BAR;
    for (;;) {
        const bool has_next = S.next(ui + 1, nxt);
        const char* nA = has_next ? nxt.a : cA; const char* nB = has_next ? nxt.b : cB;
#pragma unroll 1
        for (int t = 0; t < nt; t += 2) {
            const bool last = (t == nt - 2);
            const char* a1 = cA + (size_t)(t + 1) * kstep;
            const char* a2 = last ? nA : cA + (size_t)(t + 2) * kstep; const char* b2 = last ? nB : cB + (size_t)(t + 2) * kstep;
            const char* a3 = a2 + kstep; const char* b3 = b2 + kstep;
            PG8_LDB(B0, 0, 0); PG8_LDB(B1, 0, 1); PG8_SCHED; PG8_LDA(At, 0, 0); PG8_STAGE(PG8_SA(1, 1), a1 + hstepA, voffA);
            PG8_WAIT_V(8); PG8_WAIT_L(0); PG8_BAR; PG8_MMA(0, 0, At, B0); PG8_MMA(0, 1, At, B1); PG8_BAR; PG8_SCHED;
            PG8_LDA(At, 0, 1); PG8_STAGE(PG8_SB(0, 0), b2, voffB); PG8_STAGE(PG8_SB(0, 1), b2 + hstepB, voffB); PG8_STAGE(PG8_SA(0, 0), a2, voffA);
            PG8_WAIT_V(8); PG8_WAIT_L(0); PG8_BAR; PG8_MMA(1, 0, At, B0); PG8_MMA(1, 1, At, B1); PG8_BAR; PG8_SCHED;
            PG8_LDB(B0, 1, 0); PG8_LDB(B1, 1, 1); PG8_SCHED; PG8_LDA(At, 1, 0); PG8_STAGE(PG8_SA(0, 1), a2 + hstepA, voffA);
            PG8_WAIT_V(8); PG8_WAIT_L(0); PG8_BAR; PG8_MMA(0, 0, At, B0); PG8_MMA(0, 1, At, B1); PG8_BAR; PG8_SCHED;
            PG8_LDA(At, 1, 1); PG8_STAGE(PG8_SB(1, 0), b3, voffB); PG8_STAGE(PG8_SB(1, 1), b3 + hstepB, voffB); PG8_STAGE(PG8_SA(1, 0), a3, voffA);
            PG8_WAIT_V(8); PG8_WAIT_L(0); PG8_BAR; PG8_MMA(1, 0, At, B0); PG8_MMA(1, 1, At, B1); PG8_BAR; PG8_SCHED;
        }
        if (wr == 0) PG8_BAR;
        E(acc, cur, wr, wc, fr, fq);
        if (!has_next) break;
#pragma unroll
        for (int a = 0; a < 2; ++a)
#pragma unroll
            for (int b = 0; b < 2; ++b)
#pragma unroll
                for (int m = 0; m < 4; ++m)
#pragma unroll
                    for (int n = 0; n < 2; ++n) acc[a][b][m][n] = (f32x4){0.f, 0.f, 0.f, 0.f};
        cur = nxt; cA = nA; cB = nB; ++ui;
        if (wr == 1) PG8_BAR;
    }
    PG8_WAIT_V(0);
    PG8_BAR;
#undef PG8_SA
#undef PG8_SB
#undef PG8_STAGE
#undef PG8_LDA
#undef PG8_LDB
#undef PG8_MMA
#undef PG8_WAIT_V
#undef PG8_WAIT_L
#undef PG8_BAR
#undef PG8_SCHED
}

template <class GE> struct EpiGran {
    GE g;
    DI void operator()(f32x4 (&acc)[2][2][4][2], const Unit& u, int wr, int wc, int fr, int fq) const {
        const int row0 = u.pm * BM + wr * 64 + fr, col0 = u.pn * BM + wc * 32 + 4 * fq;
#pragma unroll
        for (int ai = 0; ai < 2; ++ai)
#pragma unroll
            for (int m = 0; m < 4; ++m)
#pragma unroll
                for (int bj = 0; bj < 2; ++bj)
#pragma unroll
                    for (int n = 0; n < 2; ++n) g(row0 + ai * HALF + m * 16, col0 + bj * HALF + n * 16, acc[ai][bj][m][n]);
    }
};
}

#define XB_TMO      128
#define XB_XCNT(j)  (256  + 64 * (j))
#define XB_XSUB(j)  (1280 + 64 * (j))
#define XB_XGEN(j)  (2304 + 64 * (j))
#define XB_TOP      3328
#define XB_TOPGEN   3392
#define XCD_BAR_WORDS 3456
#define XB_SPIN_CAP (1u << 22)
DI unsigned xb_ld(unsigned* p)              { return __hip_atomic_load(p, __ATOMIC_RELAXED, __HIP_MEMORY_SCOPE_AGENT); }
DI unsigned xb_add(unsigned* p, unsigned v) { return __hip_atomic_fetch_add(p, v, __ATOMIC_RELAXED, __HIP_MEMORY_SCOPE_AGENT); }
DI unsigned xb_xcc_id() { return (unsigned)__builtin_amdgcn_s_getreg((3 << 11) | 20) & 0xFu; }
#define XB_SPIN(cond, bar) do { unsigned _sp = 0; while (cond) { __builtin_amdgcn_s_sleep(1); \
    if ((++_sp & 255u) == 0u) { if (xb_ld(&(bar)[XB_TMO])) break; if (_sp > XB_SPIN_CAP) { atomicAdd(&(bar)[XB_TMO], 1u); break; } } } } while (0)
struct XcdBarrier { unsigned* bar; unsigned x; volatile LAS unsigned* st; };
DI XcdBarrier xcd_barrier_post(unsigned* bar, volatile LAS unsigned* st) {
    XcdBarrier b; b.bar = bar; b.x = xb_xcc_id(); b.st = st;
    if (threadIdx.x == 0) (void)xb_add(&bar[XB_XCNT(b.x)], 1u);
    return b;
}
DI void xcd_barrier_complete(unsigned* bar, unsigned x, unsigned& nloc, unsigned& nx) {
    const unsigned G = gridDim.x * gridDim.y * gridDim.z;
    unsigned sum, cnt, mine, sp = 0u;
    for (;;) {
        sum = 0u; cnt = 0u; mine = 0u;
#pragma unroll
        for (unsigned j = 0; j < 16; ++j) { const unsigned c = xb_ld(&bar[XB_XCNT(j)]); sum += c; cnt += (c > 0u) ? 1u : 0u; mine = (j == x) ? c : mine; }
        if (sum == G) break;
        __builtin_amdgcn_s_sleep(1);
        if ((++sp & 255u) == 0u) { if (xb_ld(&bar[XB_TMO])) break; if (sp > XB_SPIN_CAP) { atomicAdd(&bar[XB_TMO], 1u); break; } }
    }
    nloc = mine > 0u ? mine : 1u; nx = cnt > 0u ? cnt : 1u;
}
DI void xcd_barrier(const XcdBarrier& b) {
    asm volatile("s_waitcnt vmcnt(0)" ::: "memory");
    __syncthreads();
    if (threadIdx.x == 0) {
        unsigned* bar = b.bar;
        __builtin_amdgcn_s_waitcnt(0);
        unsigned nloc = b.st[0], nx = b.st[1];
        if (nloc == 0u) { xcd_barrier_complete(bar, b.x, nloc, nx); b.st[0] = nloc; b.st[1] = nx; }
        const unsigned old = xb_add(&bar[XB_XSUB(b.x)], 1u);
        const unsigned gen = old / nloc;
        if (old + 1u == (gen + 1u) * nloc) {
            __builtin_amdgcn_fence(__ATOMIC_RELEASE, "agent");
            asm volatile("s_waitcnt vmcnt(0)" ::: "memory");
            const unsigned og = xb_add(&bar[XB_TOP], 1u);
            const unsigned tg = og / nx;
            if (og + 1u == (tg + 1u) * nx) xb_add(&bar[XB_TOPGEN], 1u);
            else XB_SPIN(xb_ld(&bar[XB_TOPGEN]) == tg, bar);
            __builtin_amdgcn_fence(__ATOMIC_ACQUIRE, "agent");
            xb_add(&bar[XB_XGEN(b.x)], 1u);
            asm volatile("s_waitcnt vmcnt(0)" ::: "memory");
        } else {
            XB_SPIN(xb_ld(&bar[XB_XGEN(b.x)]) == gen, bar);
            __builtin_amdgcn_fence(__ATOMIC_ACQUIRE, "agent");
            asm volatile("s_waitcnt vmcnt(0)" ::: "memory");
        }
    }
    __syncthreads();
}

typedef const float* fptr_t;
typedef const __attribute__((address_space(4))) fptr_t* in_tab_t;
struct Frame {
    LAS unsigned char* lds;
    int vcu, G;
    in_tab_t in; float* out; unsigned char* ws;
};
#define PHASE_BEGIN(F) Frame F = F0; int bx = bx0; { unsigned long long _a = (unsigned long long)F0.in, _b = (unsigned long long)F0.out, _c = (unsigned long long)F0.ws; int _g = F0.G, _v = F0.vcu; \
    asm volatile("" : "+s"(_a), "+s"(_b), "+s"(_c), "+s"(_g), "+s"(_v), "+s"(bx)); \
    F.in = (in_tab_t)_a; F.out = (float*)_b; F.ws = (unsigned char*)_c; F.G = _g; F.vcu = _v; }
#define WSP(T, off) ((T*)(F.ws + (off)))

struct GeIn {
    bf16* proj; const float* bias;
    DI void operator()(int row, int col, const f32x4& a) const {
        const int bc = col + (col >= 4096 ? 8 : 0);
        const f32x4 bv = *(const f32x4*)(bias + bc);
        f32x4 v = a + bv;
        const bool sg = (col >= C_O && col < C_U) || col >= C_G;
        if (sg) { v.x = sigmoid_fast(v.x); v.y = sigmoid_fast(v.y); v.z = sigmoid_fast(v.z); v.w = sigmoid_fast(v.w); }
        u32x2 w; w.x = pk2(v.x, v.y); w.y = pk2(v.z, v.w);
        *(u32x2*)(proj + (size_t)row * NPROJ + col) = w;
    }
};
struct GeKV {
    float* out; bf16* mk; bf16* mvt;
    DI void operator()(int row, int col, const f32x4& a) const {
        const int l = col >> 11, c = col & 2047;
        if (c < 1024) {
            *(f32x4*)(out + O_PMK + ((size_t)l * 2048 + row) * 1024 + c) = a;
            u32x2 w; w.x = pk2(a.x, a.y); w.y = pk2(a.z, a.w);
            *(u32x2*)(mk + ((size_t)l * 2048 + row) * 1024 + c) = w;
        } else {
            const int cc = c - 1024;
            *(f32x4*)(out + O_PMV + ((size_t)l * 2048 + row) * 1024 + cc) = a;
            bf16* t = mvt + ((size_t)l * 1024 + cc) * 2048 + row;
            t[0] = (bf16)f2bf(a.x); t[2048] = (bf16)f2bf(a.y); t[4096] = (bf16)f2bf(a.z); t[6144] = (bf16)f2bf(a.w);
        }
    }
};
struct GeBf16 {
    bf16* o; int ldc;
    DI void operator()(int row, int col, const f32x4& a) const { u32x2 w; w.x = pk2(a.x, a.y); w.y = pk2(a.z, a.w); *(u32x2*)(o + (size_t)row * ldc + col) = w; }
};
template <int MODE> struct GeMix {
    float* mix; bf16* mixb; const bf16* proj; const float* ps;
    DI void operator()(int row, int col, const f32x4& a) const {
        const u32x2 gw = *(const u32x2*)(proj + (size_t)row * NPROJ + C_G + MODE * 1024 + col);
        const f32x4 g = (f32x4){lo16(gw.x), hi16(gw.x), lo16(gw.y), hi16(gw.y)};
        float* mp = mix + (size_t)row * D + col;
        if (MODE == 0) { *(f32x4*)mp = g * a; }
        else if (MODE == 1) { const f32x4 s = *(const f32x4*)(ps + col); *(f32x4*)mp = *(const f32x4*)mp + g * s * a; }
        else { const f32x4 v = *(const f32x4*)mp + g * a; u32x2 w; w.x = pk2(v.x, v.y); w.y = pk2(v.z, v.w); *(u32x2*)(mixb + (size_t)row * D + col) = w; }
    }
};
struct GeRes {
    const float* x; float* t;
    DI void operator()(int row, int col, const f32x4& a) const { const size_t o = (size_t)row * D + col; *(f32x4*)(t + o) = *(const f32x4*)(x + o) * ALPHA + a; }
};

struct EpiSoftmax {
    bf16* P; LAS float* X;
    DI void operator()(f32x4 (&acc)[2][2][4][2], const pg8::Unit& u, int wr, int wc, int fr, int fq) const {
        const float sc = 0.0625f * 1.4426950408889634f;
        LAS float* XM = X; LAS float* XS = X + 1024;
#pragma unroll
        for (int ai = 0; ai < 2; ++ai)
#pragma unroll
            for (int m = 0; m < 4; ++m) {
                float v = -3.0e38f;
#pragma unroll
                for (int bj = 0; bj < 2; ++bj)
#pragma unroll
                    for (int n = 0; n < 2; ++n) { const f32x4 x = acc[ai][bj][m][n]; v = fmaxf(v, fmaxf(fmaxf(x.x, x.y), fmaxf(x.z, x.w))); }
                v = fmaxf(v, __shfl_xor(v, 16)); v = fmaxf(v, __shfl_xor(v, 32));
                if (fq == 0) XM[(ai * 128 + wr * 64 + m * 16 + fr) * 4 + wc] = v;
            }
        LDS_WAIT(); __builtin_amdgcn_s_barrier(); asm volatile("" ::: "memory");
#pragma unroll
        for (int ai = 0; ai < 2; ++ai)
#pragma unroll
            for (int m = 0; m < 4; ++m) {
                const int r = ai * 128 + wr * 64 + m * 16 + fr;
                const f32x4 mm = *(const LAS f32x4*)(XM + r * 4);
                const float mx = fmaxf(fmaxf(mm.x, mm.y), fmaxf(mm.z, mm.w)) * sc;
                float s = 0.f;
#pragma unroll
                for (int bj = 0; bj < 2; ++bj)
#pragma unroll
                    for (int n = 0; n < 2; ++n) { f32x4 x = acc[ai][bj][m][n];
                        x.x = __builtin_amdgcn_exp2f(x.x * sc - mx); x.y = __builtin_amdgcn_exp2f(x.y * sc - mx); x.z = __builtin_amdgcn_exp2f(x.z * sc - mx); x.w = __builtin_amdgcn_exp2f(x.w * sc - mx);
                        acc[ai][bj][m][n] = x; s += (x.x + x.y) + (x.z + x.w); }
                s += __shfl_xor(s, 16); s += __shfl_xor(s, 32);
                if (fq == 0) XS[r * 4 + wc] = s;
                asm volatile("" ::: "memory");
            }
        LDS_WAIT(); __builtin_amdgcn_s_barrier(); asm volatile("" ::: "memory");
#pragma unroll
        for (int ai = 0; ai < 2; ++ai)
#pragma unroll
            for (int m = 0; m < 4; ++m) {
                const int r = ai * 128 + wr * 64 + m * 16 + fr;
                const f32x4 ss = *(const LAS f32x4*)(XS + r * 4);
                const float inv = 1.0f / ((ss.x + ss.y) + (ss.z + ss.w));
                bf16* rowp = P + (size_t)(u.pm * 256 + r) * D + u.pn * 256 + wc * 32 + 4 * fq;
#pragma unroll
                for (int bj = 0; bj < 2; ++bj)
#pragma unroll
                    for (int n = 0; n < 2; ++n) { const f32x4 x = acc[ai][bj][m][n] * inv; u32x2 w; w.x = pk2(x.x, x.y); w.y = pk2(x.z, x.w); *(u32x2*)(rowp + bj * 128 + n * 16) = w; }
                asm volatile("" ::: "memory");
            }
        LDS_WAIT(); __builtin_amdgcn_s_barrier(); asm volatile("" ::: "memory");
    }
};

template <size_t AROW, size_t AH, size_t BB, size_t BH>
struct OrderAttn {
    int G, c; const char* A; const char* Bt;
    DI bool next(int i, pg8::Unit& u) const {
        const long L = (long)i * G + c; if (L >= 256) return false;
        const int b = (int)L >> 5, h = ((int)L >> 3) & 3, rb = (int)L & 7;
        u.pm = b * 8 + rb; u.pn = h;
        u.a = A + (size_t)u.pm * 256 * AROW + (size_t)h * AH;
        u.b = Bt + (size_t)b * BB + (size_t)h * BH; return true;
    }
};

template <class GE>
DI void skinny_job(Frame& F, const bf16* A, int lda, const bf16* Bt, int ldb, int K, const GE& ge, int col_out) {
    const int tid = opaque_tid(), lane = tid & 63, wid = __builtin_amdgcn_readfirstlane(tid >> 6), fr = lane & 15, fq = lane >> 4, row = wid * 16 + fr;
    const bf16* ap = A + (size_t)row * lda + fq * 8;
    const bf16* b0 = Bt + (size_t)fr * ldb + fq * 8; const bf16* b1 = b0 + (size_t)16 * ldb;
    f32x4 acc0 = (f32x4){0.f, 0.f, 0.f, 0.f}, acc1 = acc0;
#pragma unroll 8
    for (int k0 = 0; k0 < K; k0 += 32) {
        const bf16x8 a = *(const bf16x8*)(ap + k0), x0 = *(const bf16x8*)(b0 + k0), x1 = *(const bf16x8*)(b1 + k0);
        acc0 = __builtin_amdgcn_mfma_f32_16x16x32_bf16(x0, a, acc0, 0, 0, 0);
        acc1 = __builtin_amdgcn_mfma_f32_16x16x32_bf16(x1, a, acc1, 0, 0, 0);
    }
    ge(MP + row, col_out + fq * 4, acc0); ge(MP + row, col_out + 16 + fq * 4, acc1);
}
template <class GE>
DI void skinny_gemm(Frame& F, const bf16* A, int lda, const bf16* Bt, int ldb, int N, int K, const GE& ge) {
    for (int job = F.vcu; job < N / 32; job += F.G) skinny_job(F, A, lda, Bt + (size_t)job * 32 * ldb, ldb, K, ge, job * 32);
}

DI void transpose_item(const float* W, int ldw, int K, bf16* WT, int k0, int n0src, int n0dst, LAS float* scr, int lane) {
#pragma unroll 8
    for (int i = 0; i < 32; ++i) { const int kk = 2 * i + (lane >> 5); scr[kk * 33 + (lane & 31)] = W[(size_t)(k0 + kk) * ldw + n0src + (lane & 31)]; }
    LDS_WAIT(); asm volatile("" ::: "memory");
    const int c = lane & 7;
#pragma unroll
    for (int j = 0; j < 4; ++j) { const int n = (lane >> 3) + 8 * j; const LAS float* s = scr + (8 * c) * 33 + n;
        u32x4 o; o.x = pk2(s[0 * 33], s[1 * 33]); o.y = pk2(s[2 * 33], s[3 * 33]); o.z = pk2(s[4 * 33], s[5 * 33]); o.w = pk2(s[6 * 33], s[7 * 33]);
        *(u32x4*)(WT + (size_t)(n0dst + n) * K + k0 + 8 * c) = o; }
    LDS_WAIT(); asm volatile("" ::: "memory");
}
DI void mat_item(const float* W, int ldw, int K, int N, bf16* WT, int item, LAS float* scr, int lane, int shift_at) {
    const int nblk = N / 32, kb = item / nblk, nb = item % nblk, n0 = 32 * nb;
    transpose_item(W, ldw, K, WT, 64 * kb, n0 + (n0 >= shift_at ? 8 : 0), n0, scr, lane);
}
DI void phase_convert(Frame& F) {
    const int tid = opaque_tid(), lane = tid & 63, wid = __builtin_amdgcn_readfirstlane(tid >> 6);
    LAS float* scr = (LAS float*)(F.lds + wid * 16384);
    const int gw = F.vcu * 8 + wid, NGW = F.G * 8;
    constexpr int I_IN = 16 * 288, I_SQ = 16 * 32, I_KV = 16 * 64, I_UP = 16 * 176, I_DN = 44 * 32, I_P = 4 * 8;
    constexpr int PER_L = I_IN + 3 * I_SQ + I_KV + I_UP + I_DN + 4 * I_P;
    for (int it = gw; it < DEPTH * PER_L; it += NGW) {
        const int l = it / PER_L; int r = it % PER_L;
        if (r < I_IN) { mat_item(F.in[12] + (size_t)l * D * INW, INW, D, NPROJ, WSP(bf16, WS_WIN + l * SZ_WIN), r, scr, lane, 4096); continue; } r -= I_IN;
        if (r < I_SQ) { mat_item(F.in[15] + (size_t)l * D * D, D, D, D, WSP(bf16, WS_WM + l * SZ_W1K), r, scr, lane, 1 << 30); continue; } r -= I_SQ;
        if (r < I_SQ) { mat_item(F.in[19] + (size_t)l * D * D, D, D, D, WSP(bf16, WS_WX + l * SZ_W1K), r, scr, lane, 1 << 30); continue; } r -= I_SQ;
        if (r < I_SQ) { mat_item(F.in[20] + (size_t)l * D * D, D, D, D, WSP(bf16, WS_WO + l * SZ_W1K), r, scr, lane, 1 << 30); continue; } r -= I_SQ;
        if (r < I_KV) { mat_item(F.in[18] + (size_t)l * D * 2048, 2048, D, 2048, WSP(bf16, WS_WKV + l * SZ_WKV), r, scr, lane, 1 << 30); continue; } r -= I_KV;
        if (r < I_UP) { mat_item(F.in[23] + (size_t)l * D * FF2, FF2, D, FF2, WSP(bf16, WS_WUP + l * SZ_WUP), r, scr, lane, 1 << 30); continue; } r -= I_UP;
        if (r < I_DN) { mat_item(F.in[26] + (size_t)l * FF * D, D, FF, D, WSP(bf16, WS_WDN + l * SZ_WDN), r, scr, lane, 1 << 30); continue; } r -= I_DN;
        { const int g = r / I_P, ri = r % I_P; mat_item(F.in[16] + ((size_t)l * 4 + g) * 65536, 256, 256, 256, WSP(bf16, WS_WP + l * SZ_WP) + (size_t)g * 65536, ri, scr, lane, 1 << 30); }
    }
    { const float* mem = F.in[1]; bf16* mb = WSP(bf16, WS_MEMB);
      for (size_t i = ((size_t)F.vcu * 512 + tid) * 8; i < (size_t)2048 * D; i += (size_t)F.G * 512 * 8) {
          const f32x4 a = *(const f32x4*)(mem + i), b = *(const f32x4*)(mem + i + 4);
          u32x4 o; o.x = pk2(a.x, a.y); o.y = pk2(a.z, a.w); o.z = pk2(b.x, b.y); o.w = pk2(b.z, b.w); *(u32x4*)(mb + i) = o; } }
}

DI void stage_gate_w(Frame& F, int l) {
    LAS float* wg = (LAS float*)F.lds;
    const float* w = F.in[12] + (size_t)l * D * INW + 4096;
    for (int i = opaque_tid(); i < 8192; i += 512) { const int k = i >> 3, j = i & 7; wg[j * 1024 + k] = w[(size_t)k * INW + j]; }
    __syncthreads();
}
DI void ln_row(Frame& F, const int lane, const float* src, const float* gam, const float* bet, int row, int lg, float* fin) {
    const f32x4* xr = (const f32x4*)src + lane;
    f32x4 v[4]; float s = 0.f;
#pragma unroll
    for (int j = 0; j < 4; ++j) { v[j] = xr[64 * j]; s += (v[j].x + v[j].y) + (v[j].z + v[j].w); }
    const float mean = wave_sum(s) * (1.f / D); float s2 = 0.f;
#pragma unroll
    for (int j = 0; j < 4; ++j) { v[j] = v[j] - mean; s2 += (v[j].x * v[j].x + v[j].y * v[j].y) + (v[j].z * v[j].z + v[j].w * v[j].w); }
    const float rstd = 1.f / sqrtf(wave_sum(s2) * (1.f / D) + LN_EPS);
    f32x4* xo = (f32x4*)(WSP(float, WS_X) + (size_t)row * D) + lane;
    u32x2* no = (u32x2*)(WSP(bf16, WS_XN) + (size_t)row * D) + lane;
#pragma unroll
    for (int j = 0; j < 4; ++j) {
        const f32x4 g = ((const f32x4*)gam)[lane + 64 * j], b = ((const f32x4*)bet)[lane + 64 * j];
        v[j] = v[j] * rstd * g + b;
        xo[64 * j] = v[j];
        u32x2 w; w.x = pk2(v[j].x, v[j].y); w.y = pk2(v[j].z, v[j].w); no[64 * j] = w;
        if (fin) ((f32x4*)fin)[lane + 64 * j] = v[j];
    }
    if (lg >= 0) {
        const LAS float* wg = (const LAS float*)F.lds;
        float a[8];
#pragma unroll
        for (int q = 0; q < 8; ++q) { float t = 0.f;
#pragma unroll
            for (int j = 0; j < 4; ++j) { const f32x4 w = *(const LAS f32x4*)(wg + q * 1024 + 4 * lane + 256 * j); t += (v[j].x * w.x + v[j].y * w.y) + (v[j].z * w.z + v[j].w * w.w); }
            a[q] = wave_sum(t); }
        if (lane == 0) { const float* bb = F.in[13] + (size_t)lg * INW + 4096; float* o = WSP(float, WS_IGFG) + (size_t)row * 8;
#pragma unroll
            for (int q = 0; q < 8; ++q) o[q] = a[q] + bb[q]; }
    }
}
DI void phase_ln_in(Frame& F) {
    stage_gate_w(F, 0);
    const int tid = opaque_tid(), lane = tid & 63, wid = __builtin_amdgcn_readfirstlane(tid >> 6);
    const int gw = F.vcu * 8 + wid, NGW = F.G * 8;
    for (int r = gw; r < MT; r += NGW) {
        const float* src = r < MP ? F.in[0] + (size_t)r * D : F.in[2] + (size_t)(r - MP) * D;
        ln_row(F, lane, src, F.in[10], F.in[11], r, 0, nullptr);
    }
    __syncthreads();
}
DI void phase_ln(Frame& F, int l, int which) {
    const int lg = (which == 1 && l + 1 < DEPTH) ? l + 1 : -1;
    if (lg >= 0) stage_gate_w(F, lg);
    const float* gam = F.in[which ? 27 : 21] + (size_t)l * D; const float* bet = F.in[which ? 28 : 22] + (size_t)l * D;
    const bool last = (which == 1 && l == DEPTH - 1);
    const int tid = opaque_tid(), lane = tid & 63, wid = __builtin_amdgcn_readfirstlane(tid >> 6);
    const int gw = F.vcu * 8 + wid, NGW = F.G * 8;
    for (int r = gw; r < MT; r += NGW) {
        float* fin = last ? (r < MP ? F.out + O_YP + (size_t)r * D : F.out + O_YS + (size_t)(r - MP) * D) : nullptr;
        ln_row(F, lane, WSP(float, WS_T) + (size_t)r * D, gam, bet, r, lg, fin);
    }
    __syncthreads();
}

constexpr int ML_Q = 0, ML_K = 33792, ML_VT = 70656, ML_VWT = 77568, ML_P = 84480, ML_CT = 93696, ML_NUM = 119040, ML_DEN = 127232, ML_VEC = 127744, ML_END = 129792;
static_assert(ML_END <= XCH_OFF, "mLSTM LDS map");
DI float log_sigmoid(float x) { return fminf(x, 0.f) - log1pf(expf(-fabsf(x))); }
DI void mlstm_prompt_job(Frame& F, int l, int job) {
    const int b = job >> 5, hh = (job >> 3) & 3, sl = job & 7;
    const int tid = opaque_tid(), lane = tid & 63, wid = __builtin_amdgcn_readfirstlane(tid >> 6), fr = lane & 15, fq = lane >> 4;
    LAS unsigned char* L = F.lds;
    LAS float* vec = (LAS float*)(L + ML_VEC);
    const bf16* proj = WSP(bf16, WS_PROJ) + (size_t)b * SEQ * NPROJ;
    const float* igfg = WSP(float, WS_IGFG) + (size_t)b * SEQ * 8;
    bf16* hc = WSP(bf16, WS_HC) + (size_t)b * SEQ * D + hh * 256 + sl * 32;
    for (int i = tid; i < 25344 / 4; i += 512) ((LAS unsigned*)(L + ML_CT))[i] = 0u;
    for (int i = tid; i < 16 * 72; i += 512) { const int e = 32 + i / 72; const unsigned short v = (e == 32) ? 0x3F80 : 0; ((LAS unsigned short*)(L + ML_VT))[e * 72 + i % 72] = v; ((LAS unsigned short*)(L + ML_VWT))[e * 72 + i % 72] = 0; }
    f32x4 cacc[2][3];
#pragma unroll
    for (int i = 0; i < 2; ++i)
#pragma unroll
        for (int j = 0; j < 3; ++j) cacc[i][j] = (f32x4){0.f, 0.f, 0.f, 0.f};
    float mprev = 0.f;
    u32x4 qr[4], kr[4]; u32x4 vr = (u32x4){0, 0, 0, 0}; u32x2 sor; float igv = 0.f, fgv = 0.f;
    const int prow = tid >> 5, pc16 = tid & 31;
    const int vrow = tid >> 2, vc = tid & 3;
    const int ht = tid >> 3, he0 = (tid & 7) * 4;
#define ML_LOAD(c) do { const bf16* pb = proj + (size_t)((c) * 64) * NPROJ; \
        _Pragma("unroll") for (int i = 0; i < 4; ++i) { qr[i] = *(const u32x4*)(pb + (size_t)(prow + 16 * i) * NPROJ + C_Q + hh * 256 + pc16 * 8); kr[i] = *(const u32x4*)(pb + (size_t)(prow + 16 * i) * NPROJ + C_K + hh * 256 + pc16 * 8); } \
        if (tid < 256) vr = *(const u32x4*)(pb + (size_t)vrow * NPROJ + C_V + hh * 256 + sl * 32 + vc * 8); \
        sor = *(const u32x2*)(pb + (size_t)ht * NPROJ + C_O + hh * 256 + sl * 32 + he0); \
        if (wid == 0) { igv = igfg[(size_t)((c) * 64 + lane) * 8 + hh]; fgv = igfg[(size_t)((c) * 64 + lane) * 8 + 4 + hh]; } } while (0)
    ML_LOAD(0);
    __syncthreads();
    for (int c = 0; c < SEQ / 64; ++c) {
#pragma unroll
        for (int i = 0; i < 4; ++i) { *(LAS u32x4*)(L + ML_Q + (prow + 16 * i) * 528 + pc16 * 16) = qr[i]; *(LAS u32x4*)(L + ML_K + (prow + 16 * i) * 528 + pc16 * 16) = kr[i]; }
        const u32x2 so_cur = sor;
        if (wid == 0) {
            const float lf = log_sigmoid(fgv);
            float bb = lf;
#pragma unroll
            for (int o = 1; o < 64; o <<= 1) { const float t = __shfl_up(bb, o); if (lane >= o) bb += t; }
            const float a = igv - bb; float cm = a;
#pragma unroll
            for (int o = 1; o < 64; o <<= 1) { const float t = __shfl_up(cm, o); if (lane >= o) cm = fmaxf(cm, t); }
            const float mt = bb + fmaxf(mprev, cm);
            const float inter = expf(mprev + bb - mt);
            const float mL = __shfl(mt, 63), bL = __shfl(bb, 63);
            const float ws = expf(a + bL - mL);
            const float decay = expf(mprev + bL - mL);
            vec[lane] = a; vec[64 + lane] = bb; vec[128 + lane] = mt; vec[192 + lane] = inter; vec[256 + lane] = ws; vec[320 + lane] = expf(-mt);
            if (lane == 0) vec[384] = decay;
            mprev = mL;
        }
        u32x4 kc[4];
#pragma unroll
        for (int i = 0; i < 4; ++i) kc[i] = kr[i];
        const u32x4 vcur = vr;
        __syncthreads();
        if (c + 1 < SEQ / 64) ML_LOAD(c + 1);
        if (tid < 256) {
            float vf[8]; unpack8(vcur, vf); const float w = vec[256 + vrow] * 0.0625f;
#pragma unroll
            for (int i = 0; i < 8; ++i) { ((LAS unsigned short*)(L + ML_VT))[(vc * 8 + i) * 72 + vrow] = (unsigned short)f2bf(vf[i]); ((LAS unsigned short*)(L + ML_VWT))[(vc * 8 + i) * 72 + vrow] = (unsigned short)f2bf(vf[i] * w); }
        } else if (tid < 320) { const int s = tid - 256; ((LAS unsigned short*)(L + ML_VWT))[32 * 72 + s] = (unsigned short)f2bf(vec[256 + s] * 0.0625f); }
        { const int tt = wid >> 1;
#pragma unroll
          for (int si = 0; si < 2; ++si) { const int st = (wid & 1) * 2 + si;
            f32x4 acc = (f32x4){0.f, 0.f, 0.f, 0.f};
            if (st <= tt) {
#pragma unroll
                for (int kk = 0; kk < 8; ++kk) { const bf16x8 kf = *(const LAS bf16x8*)(L + ML_K + (st * 16 + fr) * 528 + (kk * 32 + fq * 8) * 2), qf = *(const LAS bf16x8*)(L + ML_Q + (tt * 16 + fr) * 528 + (kk * 32 + fq * 8) * 2);
                    acc = __builtin_amdgcn_mfma_f32_16x16x32_bf16(kf, qf, acc, 0, 0, 0); }
            }
            const int t = tt * 16 + fr, s0 = st * 16 + fq * 4; const float bt = vec[64 + t] - vec[128 + t];
            float p[4];
#pragma unroll
            for (int j = 0; j < 4; ++j) { const int s = s0 + j; p[j] = (s <= t) ? acc[j] * 0.0625f * __expf(vec[s] + bt) : 0.f; }
            u32x2 w; w.x = pk2(p[0], p[1]); w.y = pk2(p[2], p[3]); *(LAS u32x2*)(L + ML_P + t * 144 + s0 * 2) = w; } }
        __syncthreads();
#pragma unroll
        for (int i = 0; i < 4; ++i) { float kf[8]; unpack8(kc[i], kf); const int s = prow + 16 * i;
#pragma unroll
            for (int j = 0; j < 8; ++j) ((LAS unsigned short*)(L + ML_K))[(pc16 * 8 + j) * 72 + s] = (unsigned short)(__float_as_uint(kf[j]) >> 16); }
        { const int tt = wid >> 1, et = wid & 1; const int t = tt * 16 + fr;
          f32x4 aP = (f32x4){0.f, 0.f, 0.f, 0.f}, aC = aP, dP = aP, dC = aP;
#pragma unroll
          for (int ks = 0; ks < 2; ++ks) { const bf16x8 vf = *(const LAS bf16x8*)(L + ML_VT + (et * 16 + fr) * 144 + (ks * 32 + fq * 8) * 2), pf = *(const LAS bf16x8*)(L + ML_P + t * 144 + (ks * 32 + fq * 8) * 2);
              aP = __builtin_amdgcn_mfma_f32_16x16x32_bf16(vf, pf, aP, 0, 0, 0);
              if (et == 0) { const bf16x8 v2 = *(const LAS bf16x8*)(L + ML_VT + (32 + fr) * 144 + (ks * 32 + fq * 8) * 2); dP = __builtin_amdgcn_mfma_f32_16x16x32_bf16(v2, pf, dP, 0, 0, 0); } }
#pragma unroll
          for (int kk = 0; kk < 8; ++kk) { const bf16x8 cf = *(const LAS bf16x8*)(L + ML_CT + (et * 16 + fr) * 528 + (kk * 32 + fq * 8) * 2), qf = *(const LAS bf16x8*)(L + ML_Q + t * 528 + (kk * 32 + fq * 8) * 2);
              aC = __builtin_amdgcn_mfma_f32_16x16x32_bf16(cf, qf, aC, 0, 0, 0);
              if ((kk >> 2) == et) { const bf16x8 c2 = *(const LAS bf16x8*)(L + ML_CT + (32 + fr) * 528 + (kk * 32 + fq * 8) * 2); dC = __builtin_amdgcn_mfma_f32_16x16x32_bf16(c2, qf, dC, 0, 0, 0); } }
          const float inter = vec[192 + t];
          *(LAS f32x4*)(L + ML_NUM + (t * 32 + et * 16 + fq * 4) * 4) = aP + aC * inter;
          if (fq == 0) ((LAS float*)(L + ML_DEN))[t * 2 + et] = dP.x + dC.x * inter; }
        __syncthreads();
        { const f32x4 nm = *(const LAS f32x4*)(L + ML_NUM + (ht * 32 + he0) * 4); const float den = ((LAS float*)(L + ML_DEN))[ht * 2] + ((LAS float*)(L + ML_DEN))[ht * 2 + 1];
          const float inv = 1.0f / fmaxf(fabsf(den), vec[320 + ht]);
          u32x2 w; w.x = pk2(lo16(so_cur.x) * nm.x * inv, hi16(so_cur.x) * nm.y * inv); w.y = pk2(lo16(so_cur.y) * nm.z * inv, hi16(so_cur.y) * nm.w * inv);
          *(u32x2*)(hc + (size_t)(c * 64 + ht) * D + he0) = w; }
        { const float decay = vec[384];
#pragma unroll
          for (int di = 0; di < 2; ++di) { const int dt = wid * 2 + di;
#pragma unroll
            for (int et = 0; et < 3; ++et) { f32x4 a = cacc[di][et] * decay;
#pragma unroll
                for (int ks = 0; ks < 2; ++ks) { const bf16x8 kf = *(const LAS bf16x8*)(L + ML_K + (dt * 16 + fr) * 144 + (ks * 32 + fq * 8) * 2), vf = *(const LAS bf16x8*)(L + ML_VWT + (et * 16 + fr) * 144 + (ks * 32 + fq * 8) * 2);
                    a = __builtin_amdgcn_mfma_f32_16x16x32_bf16(kf, vf, a, 0, 0, 0); }
                cacc[di][et] = a;
                u32x2 w; w.x = pk2(a.x, a.y); w.y = pk2(a.z, a.w); *(LAS u32x2*)(L + ML_CT + (et * 16 + fr) * 528 + (dt * 16 + fq * 4) * 2) = w; } } }
        __syncthreads();
    }
#undef ML_LOAD
    { float* pc = F.out + O_PC + ((size_t)((l * NB + b) * NH + hh)) * 65536;
#pragma unroll
      for (int di = 0; di < 2; ++di) { const int dt = wid * 2 + di;
#pragma unroll
        for (int et = 0; et < 2; ++et)
#pragma unroll
            for (int j = 0; j < 4; ++j) pc[(size_t)(dt * 16 + fq * 4 + j) * 256 + sl * 32 + et * 16 + fr] = cacc[di][et][j];
        if (sl == 0 && fr == 0) { float* pn = F.out + O_PN + ((size_t)((l * NB + b) * NH + hh)) * 256;
#pragma unroll
            for (int j = 0; j < 4; ++j) pn[dt * 16 + fq * 4 + j] = cacc[di][2][j]; } }
      if (sl == 0 && tid == 0) F.out[O_PM + (l * NB + b) * NH + hh] = mprev; }
    __syncthreads();
}

DI void mlstm_sample_job(Frame& F, int l, int job) {
    const int b = job >> 2, hh = job & 3; const int tid = opaque_tid(), lane = tid & 63, wid = __builtin_amdgcn_readfirstlane(tid >> 6);
    LAS float* qs = (LAS float*)F.lds;
    LAS float* kws = qs + 256; LAS float* red = qs + 512; LAS float* scal = qs + 512 + 2048;
    const bf16* prow = WSP(bf16, WS_PROJ) + (size_t)(MP + b) * NPROJ;
    const size_t sidx = (size_t)((l * MS + b) * NH + hh);
    const float* C = F.in[5] + sidx * 65536; const float* nst = F.in[6] + sidx * 256; float* Cn = F.out + O_SC + sidx * 65536;
    const float ig = WSP(float, WS_IGFG)[(size_t)(MP + b) * 8 + hh], fg = WSP(float, WS_IGFG)[(size_t)(MP + b) * 8 + 4 + hh];
    const float m0 = F.in[7][sidx];
    const float lf = log_sigmoid(fg), mt = fmaxf(m0 + lf, ig), inter = expf(m0 + lf - mt), wsi = expf(ig - mt);
    if (tid < 256) {
        const float q = bf2f(prow[C_Q + hh * 256 + tid]), k = bf2f(prow[C_K + hh * 256 + tid]) * 0.0625f;
        qs[tid] = q; kws[tid] = k * wsi;
        const float n0 = nst[tid];
        F.out[O_SN + sidx * 256 + tid] = inter * n0 + k * wsi;
        float qk = q * k, qn = q * n0;
        qk = wave_sum(qk); qn = wave_sum(qn);
        if (lane == 0) { scal[wid * 2] = qk; scal[wid * 2 + 1] = qn; }
    }
    __syncthreads();
    const float qk = scal[0] + scal[2] + scal[4] + scal[6], qn = scal[1] + scal[3] + scal[5] + scal[7];
    const float s = qk * wsi, den = s + inter * qn, inv = 1.0f / fmaxf(fabsf(den), expf(-mt));
    const u32x2 vw = *(const u32x2*)(prow + C_V + hh * 256 + lane * 4);
    const f32x4 v4 = (f32x4){lo16(vw.x), hi16(vw.x), lo16(vw.y), hi16(vw.y)};
    f32x4 acc = (f32x4){0.f, 0.f, 0.f, 0.f};
#pragma unroll 8
    for (int i = 0; i < 32; ++i) { const int d = wid * 32 + i; const f32x4 c = *(const f32x4*)(C + (size_t)d * 256 + lane * 4);
        acc += c * qs[d]; *(f32x4*)(Cn + (size_t)d * 256 + lane * 4) = c * inter + v4 * kws[d]; }
    *(LAS f32x4*)(red + wid * 256 + lane * 4) = acc;
    __syncthreads();
    if (tid < 256) { float qc = 0.f;
#pragma unroll
        for (int w = 0; w < 8; ++w) qc += red[w * 256 + tid];
        const float v = bf2f(prow[C_V + hh * 256 + tid]), so = bf2f(prow[C_O + hh * 256 + tid]);
        const float h = (s * v + inter * qc) * inv;
        WSP(bf16, WS_HC)[(size_t)(MP + b) * D + hh * 256 + tid] = (bf16)f2bf(so * h); }
    if (tid == 0) F.out[O_SM + sidx] = mt;
    __syncthreads();
}

DI void xattn_sample_job(Frame& F, int l, int job) {
    const int b = job >> 1, hp = job & 1; const int tid = opaque_tid(), lane = tid & 63, wid = __builtin_amdgcn_readfirstlane(tid >> 6);
    LAS float* sc = (LAS float*)F.lds;
    const bf16* prow = WSP(bf16, WS_PROJ) + (size_t)(MP + b) * NPROJ + C_XQ + hp * 512;
    const float* Kc = F.in[3] + ((size_t)(l * MS + b) * NMEM) * 1024 + hp * 512;
    const float* Vc = F.in[4] + ((size_t)(l * MS + b) * NMEM) * 1024 + hp * 512;
    float q[8]; { const u32x4 w = *(const u32x4*)(prow + lane * 8); unpack8(w, q); }
#pragma unroll 4
    for (int i = 0; i < 32; ++i) { const int m = wid + 8 * i; const f32x4 k0 = *(const f32x4*)(Kc + (size_t)m * 1024 + lane * 8), k1 = *(const f32x4*)(Kc + (size_t)m * 1024 + lane * 8 + 4);
        float t = (q[0] * k0.x + q[1] * k0.y) + (q[2] * k0.z + q[3] * k0.w) + (q[4] * k1.x + q[5] * k1.y) + (q[6] * k1.z + q[7] * k1.w);
#pragma unroll
        for (int o = 1; o < 32; o <<= 1) t += __shfl_xor(t, o);
        if ((lane & 31) == 0) sc[(lane >> 5) * 256 + m] = t * 0.0625f; }
    __syncthreads();
    if (wid < 2) { float x[4]; float mx = -3.0e38f;
#pragma unroll
        for (int j = 0; j < 4; ++j) { x[j] = sc[wid * 256 + lane + 64 * j]; mx = fmaxf(mx, x[j]); }
#pragma unroll
        for (int o = 1; o < 64; o <<= 1) mx = fmaxf(mx, __shfl_xor(mx, o));
        float s = 0.f;
#pragma unroll
        for (int j = 0; j < 4; ++j) { x[j] = expf(x[j] - mx); s += x[j]; }
        s = wave_sum(s); const float inv = 1.0f / s;
#pragma unroll
        for (int j = 0; j < 4; ++j) sc[wid * 256 + lane + 64 * j] = x[j] * inv; }
    __syncthreads();
    { const int hsel = tid >> 8; float acc = 0.f;
#pragma unroll 8
      for (int m = 0; m < 256; ++m) acc += sc[hsel * 256 + m] * Vc[(size_t)m * 1024 + tid];
      WSP(bf16, WS_OX)[(size_t)(MP + b) * D + hp * 512 + tid] = (bf16)f2bf(acc); }
    __syncthreads();
}

DI void phase_pool_d(Frame& F, int l) {
    const bf16* proj = WSP(bf16, WS_PROJ); bf16* dp = WSP(bf16, WS_DP);
    const size_t gt = (size_t)F.vcu * 512 + opaque_tid(), gs = (size_t)F.G * 512;
    for (size_t it = gt; it < (size_t)MP * 128; it += gs) {
        const int row = (int)(it >> 7), cg = (int)(it & 127), t = row & (SEQ - 1), b = row >> 11, w = 2 << (cg >> 5), nw = (t + 1 < w) ? t + 1 : w;
        const bf16* up = proj + (size_t)row * NPROJ + C_U + cg * 8;
        float u0[8], sum[8]; { const u32x4 x = *(const u32x4*)up; unpack8(x, u0); }
#pragma unroll
        for (int j = 0; j < 8; ++j) sum[j] = u0[j];
        for (int i = 1; i < nw; ++i) { float f[8]; const u32x4 x = *(const u32x4*)(up - (size_t)i * NPROJ); unpack8(x, f);
#pragma unroll
            for (int j = 0; j < 8; ++j) sum[j] += f[j]; }
        const float inv = 1.0f / (float)nw;
        u32x4 o; o.x = pk2(sum[0] * inv - u0[0], sum[1] * inv - u0[1]); o.y = pk2(sum[2] * inv - u0[2], sum[3] * inv - u0[3]); o.z = pk2(sum[4] * inv - u0[4], sum[5] * inv - u0[5]); o.w = pk2(sum[6] * inv - u0[6], sum[7] * inv - u0[7]);
        *(u32x4*)(dp + (size_t)row * D + cg * 8) = o;
        if (t >= SEQ - 15) { float* pp = F.out + O_PPOOL + ((size_t)(l * NB + b) * 15 + (t - (SEQ - 15))) * 1024 + cg * 8;
            *(f32x4*)pp = (f32x4){u0[0], u0[1], u0[2], u0[3]}; *(f32x4*)(pp + 4) = (f32x4){u0[4], u0[5], u0[6], u0[7]}; }
    }
    for (size_t it = gt; it < (size_t)MS * 128; it += gs) {
        const int b = (int)(it >> 7), cg = (int)(it & 127), w = 2 << (cg >> 5);
        const float* sp = F.in[8] + ((size_t)(l * MS + b) * 15) * 1024 + cg * 8;
        float u0[8], sum[8]; { const u32x4 x = *(const u32x4*)(proj + (size_t)(MP + b) * NPROJ + C_U + cg * 8); unpack8(x, u0); }
#pragma unroll
        for (int j = 0; j < 8; ++j) sum[j] = u0[j];
        for (int i = 1; i < w; ++i) { const f32x4 a = *(const f32x4*)(sp + (size_t)(15 - i) * 1024), c = *(const f32x4*)(sp + (size_t)(15 - i) * 1024 + 4);
            sum[0] += a.x; sum[1] += a.y; sum[2] += a.z; sum[3] += a.w; sum[4] += c.x; sum[5] += c.y; sum[6] += c.z; sum[7] += c.w; }
        const float inv = 1.0f / (float)w;
        u32x4 o; o.x = pk2(sum[0] * inv - u0[0], sum[1] * inv - u0[1]); o.y = pk2(sum[2] * inv - u0[2], sum[3] * inv - u0[3]); o.z = pk2(sum[4] * inv - u0[4], sum[5] * inv - u0[5]); o.w = pk2(sum[6] * inv - u0[6], sum[7] * inv - u0[7]);
        *(u32x4*)(dp + (size_t)(MP + b) * D + cg * 8) = o;
        float* so = F.out + O_SPOOL + ((size_t)(l * MS + b) * 15) * 1024 + cg * 8;
        for (int i = 0; i < 14; ++i) { *(f32x4*)(so + (size_t)i * 1024) = *(const f32x4*)(sp + (size_t)(i + 1) * 1024); *(f32x4*)(so + (size_t)i * 1024 + 4) = *(const f32x4*)(sp + (size_t)(i + 1) * 1024 + 4); }
        *(f32x4*)(so + (size_t)14 * 1024) = (f32x4){u0[0], u0[1], u0[2], u0[3]}; *(f32x4*)(so + (size_t)14 * 1024 + 4) = (f32x4){u0[4], u0[5], u0[6], u0[7]};
    }
}

DI void phase_headnorm(Frame& F, int l) {
    const bf16* hc = WSP(bf16, WS_HC); bf16* hn = WSP(bf16, WS_HN); const float* g = F.in[14] + (size_t)l * D;
    const int tid = opaque_tid(), lane = tid & 63, wid = __builtin_amdgcn_readfirstlane(tid >> 6);
    const int gw = F.vcu * 8 + wid, NGW = F.G * 8;
    for (int it = gw; it < MT * 4; it += NGW) {
        const size_t off = (size_t)(it >> 2) * D + (it & 3) * 256 + lane * 4;
        const u32x2 w = *(const u32x2*)(hc + off);
        float x0 = lo16(w.x), x1 = hi16(w.x), x2 = lo16(w.y), x3 = hi16(w.y);
        const float mu = wave_sum((x0 + x1) + (x2 + x3)) * (1.f / 256.f);
        x0 -= mu; x1 -= mu; x2 -= mu; x3 -= mu;
        const float var = wave_sum((x0 * x0 + x1 * x1) + (x2 * x2 + x3 * x3)) * (1.f / 256.f);
        const float r = 1.f / sqrtf(var + LN_EPS);
        const f32x4 gg = *(const f32x4*)(g + (it & 3) * 256 + lane * 4);
        u32x2 o; o.x = pk2(x0 * r * gg.x, x1 * r * gg.y); o.y = pk2(x2 * r * gg.z, x3 * r * gg.w);
        *(u32x2*)(hn + off) = o;
    }
}

DI float gelu_tanh(float x) { return x * sigmoid_fast(1.5957691216057308f * (x + 0.044715f * x * x * x)); }
DI void conv8(const float (&h0)[8], const float (&h1)[8], const float (&h2)[8], const float* cw, const float* cb, int c, float (&o)[8]) {
    const f32x4 w0a = *(const f32x4*)(cw + c), w0b = *(const f32x4*)(cw + c + 4), w1a = *(const f32x4*)(cw + FF2 + c), w1b = *(const f32x4*)(cw + FF2 + c + 4), w2a = *(const f32x4*)(cw + 2 * FF2 + c), w2b = *(const f32x4*)(cw + 2 * FF2 + c + 4);
    const f32x4 ba = *(const f32x4*)(cb + c), bb = *(const f32x4*)(cb + c + 4);
    const float w0[8] = {w0a.x, w0a.y, w0a.z, w0a.w, w0b.x, w0b.y, w0b.z, w0b.w}, w1[8] = {w1a.x, w1a.y, w1a.z, w1a.w, w1b.x, w1b.y, w1b.z, w1b.w}, w2[8] = {w2a.x, w2a.y, w2a.z, w2a.w, w2b.x, w2b.y, w2b.z, w2b.w};
    const float bv[8] = {ba.x, ba.y, ba.z, ba.w, bb.x, bb.y, bb.z, bb.w};
#pragma unroll
    for (int j = 0; j < 8; ++j) o[j] = h0[j] * w0[j] + h1[j] * w1[j] + h2[j] * w2[j] + bv[j];
}
DI void phase_conv_act(Frame& F, int l) {
    const bf16* hup = WSP(bf16, WS_HUP); bf16* act = WSP(bf16, WS_ACT);
    const float* cw = F.in[24] + (size_t)l * 3 * FF2; const float* cb = F.in[25] + (size_t)l * FF2;
    const size_t gt = (size_t)F.vcu * 512 + opaque_tid(), gs = (size_t)F.G * 512;
    for (size_t it = gt; it < (size_t)MP * 352; it += gs) {
        const int row = (int)(it / 352), cg = (int)(it % 352), t = row & (SEQ - 1), b = row >> 11;
        float ha[3][8], hb[3][8];
#pragma unroll
        for (int i = 0; i < 3; ++i) {
            if (t - (2 - i) >= 0) { const bf16* p = hup + (size_t)(row - (2 - i)) * FF2 + cg * 8; const u32x4 xa = *(const u32x4*)p, xb = *(const u32x4*)(p + FF); unpack8(xa, ha[i]); unpack8(xb, hb[i]); }
            else {
#pragma unroll
                for (int j = 0; j < 8; ++j) { ha[i][j] = 0.f; hb[i][j] = 0.f; } }
        }
        float ca[8], cbv[8]; conv8(ha[0], ha[1], ha[2], cw, cb, cg * 8, ca); conv8(hb[0], hb[1], hb[2], cw, cb, FF + cg * 8, cbv);
        u32x4 o; o.x = pk2(gelu_tanh(ca[0]) * cbv[0], gelu_tanh(ca[1]) * cbv[1]); o.y = pk2(gelu_tanh(ca[2]) * cbv[2], gelu_tanh(ca[3]) * cbv[3]);
        o.z = pk2(gelu_tanh(ca[4]) * cbv[4], gelu_tanh(ca[5]) * cbv[5]); o.w = pk2(gelu_tanh(ca[6]) * cbv[6], gelu_tanh(ca[7]) * cbv[7]);
        *(u32x4*)(act + (size_t)row * FF + cg * 8) = o;
        if (t >= SEQ - 2) { float* pc = F.out + O_PCONV + ((size_t)(l * NB + b) * 2 + (t - (SEQ - 2))) * FF2 + cg * 8;
            *(f32x4*)pc = (f32x4){ha[2][0], ha[2][1], ha[2][2], ha[2][3]}; *(f32x4*)(pc + 4) = (f32x4){ha[2][4], ha[2][5], ha[2][6], ha[2][7]};
            *(f32x4*)(pc + FF) = (f32x4){hb[2][0], hb[2][1], hb[2][2], hb[2][3]}; *(f32x4*)(pc + FF + 4) = (f32x4){hb[2][4], hb[2][5], hb[2][6], hb[2][7]}; }
    }
    for (size_t it = gt; it < (size_t)MS * 352; it += gs) {
        const int b = (int)(it / 352), cg = (int)(it % 352);
        const float* sc = F.in[9] + ((size_t)(l * MS + b) * 2) * FF2 + cg * 8;
        float ha[3][8], hb[3][8];
#pragma unroll
        for (int i = 0; i < 2; ++i) { const f32x4 a0 = *(const f32x4*)(sc + (size_t)i * FF2), a1 = *(const f32x4*)(sc + (size_t)i * FF2 + 4), b0 = *(const f32x4*)(sc + (size_t)i * FF2 + FF), b1 = *(const f32x4*)(sc + (size_t)i * FF2 + FF + 4);
            ha[i][0] = a0.x; ha[i][1] = a0.y; ha[i][2] = a0.z; ha[i][3] = a0.w; ha[i][4] = a1.x; ha[i][5] = a1.y; ha[i][6] = a1.z; ha[i][7] = a1.w;
            hb[i][0] = b0.x; hb[i][1] = b0.y; hb[i][2] = b0.z; hb[i][3] = b0.w; hb[i][4] = b1.x; hb[i][5] = b1.y; hb[i][6] = b1.z; hb[i][7] = b1.w; }
        { const bf16* p = hup + (size_t)(MP + b) * FF2 + cg * 8; const u32x4 xa = *(const u32x4*)p, xb = *(const u32x4*)(p + FF); unpack8(xa, ha[2]); unpack8(xb, hb[2]); }
        float ca[8], cbv[8]; conv8(ha[0], ha[1], ha[2], cw, cb, cg * 8, ca); conv8(hb[0], hb[1], hb[2], cw, cb, FF + cg * 8, cbv);
        u32x4 o; o.x = pk2(gelu_tanh(ca[0]) * cbv[0], gelu_tanh(ca[1]) * cbv[1]); o.y = pk2(gelu_tanh(ca[2]) * cbv[2], gelu_tanh(ca[3]) * cbv[3]);
        o.z = pk2(gelu_tanh(ca[4]) * cbv[4], gelu_tanh(ca[5]) * cbv[5]); o.w = pk2(gelu_tanh(ca[6]) * cbv[6], gelu_tanh(ca[7]) * cbv[7]);
        *(u32x4*)(act + (size_t)(MP + b) * FF + cg * 8) = o;
        float* so = F.out + O_SCONV + ((size_t)(l * MS + b) * 2) * FF2 + cg * 8;
#pragma unroll
        for (int i = 0; i < 2; ++i) { *(f32x4*)(so + (size_t)i * FF2) = (f32x4){ha[i + 1][0], ha[i + 1][1], ha[i + 1][2], ha[i + 1][3]}; *(f32x4*)(so + (size_t)i * FF2 + 4) = (f32x4){ha[i + 1][4], ha[i + 1][5], ha[i + 1][6], ha[i + 1][7]};
            *(f32x4*)(so + (size_t)i * FF2 + FF) = (f32x4){hb[i + 1][0], hb[i + 1][1], hb[i + 1][2], hb[i + 1][3]}; *(f32x4*)(so + (size_t)i * FF2 + FF + 4) = (f32x4){hb[i + 1][4], hb[i + 1][5], hb[i + 1][6], hb[i + 1][7]}; }
    }
}

constexpr int PH_PER_L = 10, PH_TOTAL = 2 + DEPTH * PH_PER_L;
struct Args { const float* in[29]; float* out; unsigned char* ws; int ph_lo, ph_hi, li, pad; };
__global__ void __launch_bounds__(512, 2) trunk_fwd(Args args) {
    extern __shared__ __attribute__((aligned(16))) unsigned char lds_raw[];
    Frame F0;
    F0.lds = (LAS unsigned char*)lds_raw;
    F0.G = gridDim.x; { const int bx = blockIdx.x; F0.vcu = (F0.G % 8 == 0) ? (bx % 8) * (F0.G / 8) + bx / 8 : bx; }
    F0.in = (in_tab_t)__builtin_amdgcn_kernarg_segment_ptr(); F0.out = args.out; F0.ws = args.ws;
    volatile LAS unsigned* MISC = (volatile LAS unsigned*)(F0.lds + MISC_OFF);
    if (threadIdx.x < 64) MISC[threadIdx.x] = 0u;
    __syncthreads();
    unsigned* ctl = (unsigned*)(args.ws + WS_CTL);
    XcdBarrier bar = xcd_barrier_post(ctl + CW_BAR + args.li * XCD_BAR_WORDS, MISC + 8);
    const int lo = args.ph_lo, hi = args.ph_hi;
#define IN(k) (lo <= (k) && (k) < hi)
#define PM(b) ((PHMASK >> (b)) & 1u)
#define SEAM(k) do { if (IN(k) && IN((k) + 1)) xcd_barrier(bar); } while (0)
    const int bx0 = (int)blockIdx.x;

    if (PM(0) && IN(0)) { PHASE_BEGIN(F); phase_convert(F); __syncthreads(); phase_ln_in(F); }
    SEAM(0);
    if (PM(1) && IN(1)) {
        PHASE_BEGIN(F);
        pg8::OrderMN S; S.init(WSP(bf16, WS_MEMB), D, WSP(bf16, WS_WKV), D, 2048, DEPTH * 2048, F.G, bx);
        pg8::EpiGran<GeKV> E{{F.out, WSP(bf16, WS_MK), WSP(bf16, WS_MVT)}};
        pg8::gemm_phase(F.lds, D, D, D, S, E);
    }
    SEAM(1);
    for (int l = 0; l < DEPTH; ++l) {
        const int p0 = 2 + l * PH_PER_L;
        if (PM(2) && IN(p0 + 0)) {
            PHASE_BEGIN(F);
            const bf16* W = WSP(bf16, WS_WIN + l * SZ_WIN);
            pg8::OrderMN S; S.init(WSP(bf16, WS_XN), D, W, D, MP, NPROJ, F.G, bx);
            pg8::EpiGran<GeIn> E{{WSP(bf16, WS_PROJ), F.in[13] + (size_t)l * INW}};
            pg8::gemm_phase(F.lds, D, D, D, S, E);
            skinny_gemm(F, WSP(bf16, WS_XN) + (size_t)MP * D, D, W, D, NPROJ, D, E.g);
        }
        SEAM(p0 + 0);
        if (PM(3) && IN(p0 + 1)) {
            PHASE_BEGIN(F);
            if (SM(0)) for (int j = F.vcu; j < 256; j += F.G) mlstm_prompt_job(F, l, j);
            if (SM(1)) {
                OrderAttn<(size_t)NPROJ * 2, (size_t)256 * 2, (size_t)256 * D * 2, (size_t)256 * 2> S{F.G, bx, (const char*)(WSP(bf16, WS_PROJ) + C_XQ), (const char*)(WSP(bf16, WS_MK) + (size_t)l * 2048 * D)};
                EpiSoftmax E{WSP(bf16, WS_PB), (LAS float*)(F.lds + XCH_OFF)};
                pg8::gemm_phase(F.lds, 256, NPROJ, D, S, E);
            }
            if (SM(2)) for (int j = F.vcu; j < MS * NH; j += F.G) mlstm_sample_job(F, l, j);
            if (SM(3)) for (int j = F.vcu; j < MS * 2; j += F.G) xattn_sample_job(F, l, j);
            if (SM(4)) phase_pool_d(F, l);
        }
        SEAM(p0 + 1);
        if (PM(4) && IN(p0 + 2)) {
            PHASE_BEGIN(F);
            if (SM(5)) phase_headnorm(F, l);
            OrderAttn<(size_t)D * 2, (size_t)256 * 2, (size_t)256 * 2, (size_t)256 * 2048 * 2> S{F.G, bx, (const char*)WSP(bf16, WS_PB), (const char*)(WSP(bf16, WS_MVT) + (size_t)l * 1024 * 2048)};
            pg8::EpiGran<GeBf16> E{{WSP(bf16, WS_OX), D}};
            pg8::gemm_phase(F.lds, 256, D, 2048, S, E);
        }
        SEAM(p0 + 2);
        if (PM(5) && IN(p0 + 3)) {
            PHASE_BEGIN(F);
            const bf16* proj = WSP(bf16, WS_PROJ); float* mix = WSP(float, WS_MIX); bf16* mixb = WSP(bf16, WS_MIXB); const float* ps = F.in[17] + (size_t)l * D;
            { const bf16* W = WSP(bf16, WS_WM + l * SZ_W1K); pg8::OrderMN S; S.init(WSP(bf16, WS_HN), D, W, D, MP, D, F.G, bx);
              pg8::EpiGran<GeMix<0>> E{{mix, mixb, proj, ps}}; pg8::gemm_phase(F.lds, D, D, D, S, E);
              skinny_gemm(F, WSP(bf16, WS_HN) + (size_t)MP * D, D, W, D, D, D, E.g); }
            { const bf16* W = WSP(bf16, WS_WP + l * SZ_WP); pg8::OrderMN S; S.init(WSP(bf16, WS_DP), D, W, 256, MP, D, F.G, bx, 512);
              pg8::EpiGran<GeMix<1>> E{{mix, mixb, proj, ps}}; pg8::gemm_phase(F.lds, 256, D, 256, S, E);
              for (int job = F.vcu; job < 32; job += F.G) { const int g = job >> 3;
                  skinny_job(F, WSP(bf16, WS_DP) + (size_t)MP * D + g * 256, D, W + (size_t)g * 65536 + (size_t)(job & 7) * 32 * 256, 256, 256, E.g, job * 32); } }
            { const bf16* W = WSP(bf16, WS_WX + l * SZ_W1K); pg8::OrderMN S; S.init(WSP(bf16, WS_OX), D, W, D, MP, D, F.G, bx);
              pg8::EpiGran<GeMix<2>> E{{mix, mixb, proj, ps}}; pg8::gemm_phase(F.lds, D, D, D, S, E);
              skinny_gemm(F, WSP(bf16, WS_OX) + (size_t)MP * D, D, W, D, D, D, E.g); }
        }
        SEAM(p0 + 3);
        if (PM(6) && IN(p0 + 4)) {
            PHASE_BEGIN(F);
            const bf16* W = WSP(bf16, WS_WO + l * SZ_W1K); pg8::OrderMN S; S.init(WSP(bf16, WS_MIXB), D, W, D, MP, D, F.G, bx);
            pg8::EpiGran<GeRes> E{{WSP(float, WS_X), WSP(float, WS_T)}}; pg8::gemm_phase(F.lds, D, D, D, S, E);
            skinny_gemm(F, WSP(bf16, WS_MIXB) + (size_t)MP * D, D, W, D, D, D, E.g);
        }
        SEAM(p0 + 4);
        if (PM(7) && IN(p0 + 5)) { PHASE_BEGIN(F); phase_ln(F, l, 0); }
        SEAM(p0 + 5);
        if (PM(8) && IN(p0 + 6)) {
            PHASE_BEGIN(F);
            const bf16* W = WSP(bf16, WS_WUP + l * SZ_WUP); pg8::OrderMN S; S.init(WSP(bf16, WS_XN), D, W, D, MP, FF2, F.G, bx);
            pg8::EpiGran<GeBf16> E{{WSP(bf16, WS_HUP), FF2}}; pg8::gemm_phase(F.lds, D, D, D, S, E);
            skinny_gemm(F, WSP(bf16, WS_XN) + (size_t)MP * D, D, W, D, FF2, D, E.g);
        }
        SEAM(p0 + 6);
        if (PM(9) && IN(p0 + 7)) { PHASE_BEGIN(F); phase_conv_act(F, l); }
        SEAM(p0 + 7);
        if (PM(10) && IN(p0 + 8)) {
            PHASE_BEGIN(F);
            const bf16* W = WSP(bf16, WS_WDN + l * SZ_WDN); pg8::OrderMN S; S.init(WSP(bf16, WS_ACT), FF, W, FF, MP, D, F.G, bx);
            pg8::EpiGran<GeRes> E{{WSP(float, WS_X), WSP(float, WS_T)}}; pg8::gemm_phase(F.lds, FF, FF, FF, S, E);
            skinny_gemm(F, WSP(bf16, WS_ACT) + (size_t)MP * FF, FF, W, FF, D, FF, E.g);
        }
        SEAM(p0 + 8);
        if (PM(11) && IN(p0 + 9)) { PHASE_BEGIN(F); phase_ln(F, l, 1); }
        SEAM(p0 + 9);
    }
#undef IN
#undef SEAM
}

extern "C" void kernel_launch(void* const* d_in, const int* in_sizes, int n_in, void* d_out, int out_size, void* d_ws, size_t ws_size, hipStream_t stream) {
    static int grid = 0;
    if (grid == 0) {
        if (n_in != 29 || (size_t)out_size != O_END || ws_size < WS_END) { fprintf(stderr, "kernel_launch: unexpected shapes (n_in %d, out %d, ws %zu; need ws >= %zu)\n", n_in, out_size, ws_size, (size_t)WS_END); grid = -1; return; }
        int dev = 0, cus = 0, per_cu = 0;
        if (hipGetDevice(&dev) != hipSuccess || hipDeviceGetAttribute(&cus, hipDeviceAttributeMultiprocessorCount, dev) != hipSuccess) { grid = -1; return; }
        if (hipFuncSetAttribute((const void*)trunk_fwd, hipFuncAttributeMaxDynamicSharedMemorySize, LDS_BYTES) != hipSuccess) { fprintf(stderr, "kernel_launch: hipFuncSetAttribute failed\n"); grid = -1; return; }
        if (hipOccupancyMaxActiveBlocksPerMultiprocessor(&per_cu, (const void*)trunk_fwd, 512, LDS_BYTES) != hipSuccess || per_cu < 1) fprintf(stderr, "kernel_launch: occupancy query reports %d\n", per_cu);
        (void)hipGetLastError();
        grid = cus;
    }
    if (grid < 0) return;
    (void)hipMemsetAsync((char*)d_ws + WS_CTL, 0, CTL_BYTES, stream);
    Args a{};
    for (int i = 0; i < 29; ++i) a.in[i] = (const float*)d_in[i];
    a.out = (float*)d_out; a.ws = (unsigned char*)d_ws; a.pad = 0;
#if MK_SPLIT
    for (int p = 0; p < PH_TOTAL; ++p) { a.ph_lo = p; a.ph_hi = p + 1; a.li = p; hipLaunchKernelGGL(trunk_fwd, dim3(grid), dim3(512), LDS_BYTES, stream, a); }
#else
    a.ph_lo = 0; a.ph_hi = PH_TOTAL; a.li = 0;
    hipLaunchKernelGGL(trunk_fwd, dim3(grid), dim3(512), LDS_BYTES, stream, a);
#endif
}
```

```cpp
#include <hip/hip_runtime.h>
#include <cstdio>
#include <cstdint>

#define LAS __attribute__((address_space(3)))
#define GAS __attribute__((address_space(1)))
typedef unsigned short bf16;
typedef short bf16x8 __attribute__((ext_vector_type(8)));
typedef float f32x4 __attribute__((ext_vector_type(4)));
typedef float f32x2 __attribute__((ext_vector_type(2)));
typedef unsigned u32x4 __attribute__((ext_vector_type(4)));
typedef unsigned u32x2 __attribute__((ext_vector_type(2)));
#define DI __device__ __forceinline__

#ifndef PHMASK
#define PHMASK 0xFFFFFFFFu
#endif
#ifndef SUBMASK
#define SUBMASK 0xFFFFFFFFu
#endif
#define SM(b) ((SUBMASK >> (b)) & 1u)
#ifndef REPMASK
#define REPMASK 0u
#endif
#ifndef SUBREP
#define SUBREP 0u
#endif
#define REP(k) ((int)((REPMASK >> (k)) & 1u))
#define SREP(k) ((int)((SUBREP >> (k)) & 1u))
#ifndef MK_SPLIT
#define MK_SPLIT 0
#endif

constexpr int D = 1024, NB = 8, SEQ = 2048, MP = NB * SEQ, MS = 128, MT = MP + MS, MTP = MP + 256, DEPTH = 4;
constexpr int NPROJ = 9216, INW = 9224;
constexpr int C_Q = 0, C_K = 1024, C_V = 2048, C_O = 3072, C_U = 4096, C_XQ = 5120, C_G = 6144;
constexpr int FF = 2816, FF2 = 5632, NMEM = 256, HD = 256, NH = 4;
constexpr float LN_EPS = 1e-5f;
constexpr float ALPHA = 1.681792830507429f;
constexpr int PAST_LEN = 16384;

constexpr size_t O_YP = 0, O_YS = 16777216, O_PC = 16908288, O_PN = 25296896, O_PM = 25329664, O_PPOOL = 25329792, O_PCONV = 25821312,
                 O_PMK = 26181760, O_PMV = 34570368, O_SC = 42958976, O_SN = 177176704, O_SM = 177700992, O_SPOOL = 177703040, O_SCONV = 185567360, O_END = 191334528;

constexpr size_t al256(size_t x) { return (x + 255) & ~(size_t)255; }
constexpr size_t WS_CTL = 0, CTL_BYTES = 2u << 20;
constexpr size_t WS_WIN = CTL_BYTES;                                        constexpr size_t SZ_WIN = (size_t)NPROJ * D * 2;
constexpr size_t WS_WM = WS_WIN + DEPTH * SZ_WIN;                           constexpr size_t SZ_W1K = (size_t)D * D * 2;
constexpr size_t WS_WX = WS_WM + DEPTH * SZ_W1K;
constexpr size_t WS_WO = WS_WX + DEPTH * SZ_W1K;
constexpr size_t WS_WP = WS_WO + DEPTH * SZ_W1K;                            constexpr size_t SZ_WP = (size_t)4 * 256 * 256 * 2;
constexpr size_t WS_WKV = WS_WP + DEPTH * SZ_WP;                            constexpr size_t SZ_WKV = (size_t)2048 * D * 2;
constexpr size_t WS_WUP = WS_WKV + DEPTH * SZ_WKV;                          constexpr size_t SZ_WUP = (size_t)FF2 * D * 2;
constexpr size_t WS_WDN = WS_WUP + DEPTH * SZ_WUP;                          constexpr size_t SZ_WDN = (size_t)D * FF * 2;
constexpr size_t WS_X = al256(WS_WDN + DEPTH * SZ_WDN);
constexpr size_t WS_T = WS_X + (size_t)MTP * D * 4;
constexpr size_t WS_MIX = WS_T + (size_t)MTP * D * 4;
constexpr size_t WS_XN = WS_MIX + (size_t)MTP * D * 4;
constexpr size_t WS_PROJ = WS_XN + (size_t)MTP * D * 2;
constexpr size_t WS_HC = WS_PROJ + (size_t)MTP * NPROJ * 2;
constexpr size_t WS_HN = WS_HC + (size_t)MTP * D * 2;
constexpr size_t WS_DP = WS_HN + (size_t)MTP * D * 2;
constexpr size_t WS_PB = WS_DP + (size_t)MTP * D * 2;
constexpr size_t WS_OX = WS_PB + (size_t)MTP * D * 2;
constexpr size_t WS_MIXB = WS_OX + (size_t)MTP * D * 2;
constexpr size_t WS_HUP = WS_MIXB + (size_t)MTP * D * 2;
constexpr size_t WS_ACT = WS_HUP + (size_t)MTP * FF2 * 2;
constexpr size_t WS_IGFG = WS_ACT + (size_t)MTP * FF * 2;
constexpr size_t WS_MEMB = WS_IGFG + (size_t)MTP * 8 * 4;
constexpr size_t WS_MK = WS_MEMB + (size_t)2048 * D * 2;
constexpr size_t WS_MVT = WS_MK + (size_t)DEPTH * 2048 * D * 2;
constexpr size_t WS_PT = WS_MVT + (size_t)DEPTH * 2048 * D * 2;
constexpr size_t WS_KWT = WS_PT + (size_t)32 * 32 * 4096 * 2;
constexpr size_t WS_VTT = WS_KWT + (size_t)32 * 32 * 16384 * 2;
constexpr size_t WS_GT = WS_VTT + (size_t)32 * 32 * 16384 * 2;
constexpr size_t WS_END = WS_GT + (size_t)32 * 32 * 192 * 4;
static_assert(WS_END <= 2147483648ull, "workspace map exceeds 2 GiB");
constexpr int CW_BAR = 4096;

constexpr int LDS_BYTES = 147456;
constexpr int XCH_OFF = 131072;
constexpr int MISC_OFF = LDS_BYTES - 256;

DI float bf2f(unsigned v) { return __uint_as_float(v << 16); }
DI unsigned f2bf(float f) { unsigned u = __float_as_uint(f); return (u + 0x7fffu + ((u >> 16) & 1u)) >> 16; }
DI unsigned pk2(float lo, float hi) { return f2bf(lo) | (f2bf(hi) << 16); }
DI float lo16(unsigned w) { return __uint_as_float(w << 16); }
DI float hi16(unsigned w) { return __uint_as_float(w & 0xffff0000u); }
DI float sigmoid_fast(float x) { return __builtin_amdgcn_rcpf(1.0f + __expf(-x)); }
DI float wave_sum(float v) {
#pragma unroll
    for (int o = 1; o < 64; o <<= 1) v += __shfl_xor(v, o);
    return v;
}
DI void unpack8(const u32x4 w, float (&f)[8]) { f[0] = lo16(w.x); f[1] = hi16(w.x); f[2] = lo16(w.y); f[3] = hi16(w.y); f[4] = lo16(w.z); f[5] = hi16(w.z); f[6] = lo16(w.w); f[7] = hi16(w.w); }
DI int opaque_tid() { int t = threadIdx.x; asm volatile("" : "+v"(t)); return t; }
#define LDS_WAIT() asm volatile("s_waitcnt lgkmcnt(0)" ::: "memory")
#define VM_WAIT() asm volatile("s_waitcnt vmcnt(0)" ::: "memory")

namespace pg8 {
constexpr int BM = 256, BK = 64, HALF = 128, HTB = HALF * BK * 2, STAGE_BYTES = 8 * HTB, NXCD = 8, WGM = 8;
__host__ __device__ __forceinline__ int lds_byte(int r, int c) { const int st = (r >> 4) * 2 + (c >> 5), rr = r & 15, cc = c & 31, ob = rr * 64 + cc * 2; return st * 1024 + (ob ^ (((ob >> 9) & 1) << 5)); }
__host__ __device__ __forceinline__ void stage_rc(int b, int& R, int& C) { const int st = b / 1024, sb = b % 1024, swz = sb ^ (((sb >> 9) & 1) << 5); R = (st >> 1) * 16 + swz / 64; C = (st & 1) * 32 + (swz % 64) / 2; }

struct Unit { const char* a; const char* b; int pm, pn; };

struct OrderMN {
    int nM, nN, nwg, G, c; const char* A; const char* Bt; size_t astep, bstep, apn;
    DI void init(const bf16* A_, int lda, const bf16* Bt_, int ldb, int M, int N, int G_, int c_, int apn_ = 0) { nM = M / BM; nN = N / BM; nwg = nM * nN; G = G_; c = c_; A = (const char*)A_; Bt = (const char*)Bt_; astep = (size_t)BM * lda * 2; bstep = (size_t)BM * ldb * 2; apn = (size_t)apn_; }
    DI bool next(int i, Unit& u) const {
        const long L = (long)i * G + c; if (L >= nwg) return false;
        int wgid = (int)L; { const int q = nwg / NXCD, r = nwg % NXCD, xcd = wgid % NXCD, off = wgid / NXCD; wgid = (xcd < r ? xcd * (q + 1) : r * (q + 1) + (xcd - r) * q) + off; }
        const int nig = WGM * nN, gid = wgid / nig, fm = gid * WGM, gsz = (nM - fm) < WGM ? (nM - fm) : WGM;
        u.pm = fm + ((wgid % nig) % gsz); u.pn = (wgid % nig) / gsz; u.a = A + (size_t)u.pm * astep + (size_t)u.pn * apn; u.b = Bt + (size_t)u.pn * bstep; return true;
    }
};

template <class Epi, class Sched>
DI void gemm_phase(LAS unsigned char* lds, const int K, const int lda, const int ldb, const Sched& S, const Epi& E) {
    const int tid = opaque_tid(), wid = __builtin_amdgcn_readfirstlane(tid >> 6), lane = tid & 63, wr = wid >> 2, wc = wid & 3, fr = lane & 15, fq = lane >> 4;
    const int nt = K / BK;
    unsigned voffA[2], voffB[2];
#pragma unroll
    for (int i = 0; i < 2; ++i) { int R, C; stage_rc(tid * 16 + i * 8192, R, C); voffA[i] = (unsigned)(R * lda + C) * 2u; voffB[i] = (unsigned)(R * ldb + C) * 2u; }
    const size_t kstep = (size_t)(BK * 2);
    const size_t hstepA = (size_t)HALF * lda * 2, hstepB = (size_t)HALF * ldb * 2;
    const unsigned ldsw = (unsigned)wid * 1024u;
    const int aoff = lds_byte(wr * 64 + fr, fq * 8), boff = lds_byte(wc * 32 + fr, fq * 8);
#define PG8_SA(b, h) (((b) * 2 + (h)) * HTB)
#define PG8_SB(b, h) ((4 + (b) * 2 + (h)) * HTB)
#define PG8_STAGE(bufoff, gbase, voff) do { _Pragma("unroll") for (int _i = 0; _i < 2; ++_i) \
        __builtin_amdgcn_global_load_lds((const unsigned*)((const char*)(gbase) + (voff)[_i]), (LAS unsigned*)(lds + (bufoff) + ldsw + _i * 8192), 16, 0, 0); } while (0)
#define PG8_LDA(dst, b, h) do { _Pragma("unroll") for (int m = 0; m < 4; ++m) _Pragma("unroll") for (int k = 0; k < 2; ++k) dst[m][k] = *(const LAS bf16x8*)(lds + PG8_SA(b, h) + aoff + m * 2048 + k * 1024); } while (0)
#define PG8_LDB(dst, b, h) do { _Pragma("unroll") for (int n = 0; n < 2; ++n) _Pragma("unroll") for (int k = 0; k < 2; ++k) dst[n][k] = *(const LAS bf16x8*)(lds + PG8_SB(b, h) + boff + n * 2048 + k * 1024); } while (0)
#define PG8_MMA(ai, bj, At, Bt) do { __builtin_amdgcn_s_setprio(1); _Pragma("unroll") for (int m = 0; m < 4; ++m) _Pragma("unroll") for (int n = 0; n < 2; ++n) _Pragma("unroll") for (int k = 0; k < 2; ++k) \
        acc[ai][bj][m][n] = __builtin_amdgcn_mfma_f32_16x16x32_bf16(Bt[n][k], At[m][k], acc[ai][bj][m][n], 0, 0, 0); __builtin_amdgcn_s_setprio(0); } while (0)
#define PG8_WAIT_V(n) asm volatile("s_waitcnt vmcnt(" #n ")" ::: "memory")
#define PG8_WAIT_L(n) asm volatile("s_waitcnt lgkmcnt(" #n ")" ::: "memory")
#define PG8_BAR __builtin_amdgcn_s_barrier()
#define PG8_SCHED __builtin_amdgcn_sched_barrier(0)
    Unit cur, nxt; int ui = 0;
    if (!S.next(0, cur)) return;
    f32x4 acc[2][2][4][2];
#pragma unroll
    for (int a = 0; a < 2; ++a)
#pragma unroll
        for (int b = 0; b < 2; ++b)
#pragma unroll
            for (int m = 0; m < 4; ++m)
#pragma unroll
                for (int n = 0; n < 2; ++n) acc[a][b][m][n] = (f32x4){0.f, 0.f, 0.f, 0.f};
    bf16x8 At[4][2], B0[2][2], B1[2][2];
    const char* cA = cur.a; const char* cB = cur.b;
    PG8_STAGE(PG8_SB(0, 0), cB, voffB); PG8_STAGE(PG8_SB(0, 1), cB + hstepB, voffB); PG8_STAGE(PG8_SA(0, 0), cA, voffA); PG8_STAGE(PG8_SA(0, 1), cA + hstepA, voffA);
    if (wr == 1) PG8_BAR;
    PG8_WAIT_V(2); PG8_BAR;
    PG8_STAGE(PG8_SB(1, 0), cB + kstep, voffB); PG8_STAGE(PG8_SA(1, 0), cA + kstep, voffA); PG8_STAGE(PG8_SB(1, 1), cB + hstepB + kstep, voffB);
    PG8_WAIT_V(6); PG8_BAR;
    for (;;) {
        const bool has_next = S.next(ui + 1, nxt);
        const char* nA = has_next ? nxt.a : cA; const char* nB = has_next ? nxt.b : cB;
#pragma unroll 1
        for (int t = 0; t < nt; t += 2) {
            const bool last = (t == nt - 2);
            const char* a1 = cA + (size_t)(t + 1) * kstep;
            const char* a2 = last ? nA : cA + (size_t)(t + 2) * kstep; const char* b2 = last ? nB : cB + (size_t)(t + 2) * kstep;
            const char* a3 = a2 + kstep; const char* b3 = b2 + kstep;
            PG8_LDB(B0, 0, 0); PG8_LDB(B1, 0, 1); PG8_SCHED; PG8_LDA(At, 0, 0); PG8_STAGE(PG8_SA(1, 1), a1 + hstepA, voffA);
            PG8_WAIT_V(8); PG8_WAIT_L(0); PG8_BAR; PG8_MMA(0, 0, At, B0); PG8_MMA(0, 1, At, B1); PG8_BAR; PG8_SCHED;
            PG8_LDA(At, 0, 1); PG8_STAGE(PG8_SB(0, 0), b2, voffB); PG8_STAGE(PG8_SB(0, 1), b2 + hstepB, voffB); PG8_STAGE(PG8_SA(0, 0), a2, voffA);
            PG8_WAIT_V(8); PG8_WAIT_L(0); PG8_BAR; PG8_MMA(1, 0, At, B0); PG8_MMA(1, 1, At, B1); PG8_BAR; PG8_SCHED;
            PG8_LDB(B0, 1, 0); PG8_LDB(B1, 1, 1); PG8_SCHED; PG8_LDA(At, 1, 0); PG8_STAGE(PG8_SA(0, 1), a2 + hstepA, voffA);
            PG8_WAIT_V(8); PG8_WAIT_L(0); PG8_BAR; PG8_MMA(0, 0, At, B0); PG8_MMA(0, 1, At, B1); PG8_BAR; PG8_SCHED;
            PG8_LDA(At, 1, 1); PG8_STAGE(PG8_SB(1, 0), b3, voffB); PG8_STAGE(PG8_SB(1, 1), b3 + hstepB, voffB); PG8_STAGE(PG8_SA(1, 0), a3, voffA);
            PG8_WAIT_V(8); PG8_WAIT_L(0); PG8_BAR; PG8_MMA(1, 0, At, B0); PG8_MMA(1, 1, At, B1); PG8_BAR; PG8_SCHED;
        }
        if (wr == 0) PG8_BAR;
        E(acc, cur, wr, wc, fr, fq);
        if (!has_next) break;
#pragma unroll
        for (int a = 0; a < 2; ++a)
#pragma unroll
            for (int b = 0; b < 2; ++b)
#pragma unroll
                for (int m = 0; m < 4; ++m)
#pragma unroll
                    for (int n = 0; n < 2; ++n) acc[a][b][m][n] = (f32x4){0.f, 0.f, 0.f, 0.f};
        cur = nxt; cA = nA; cB = nB; ++ui;
        if (wr == 1) PG8_BAR;
    }
    PG8_WAIT_V(0);
    PG8_BAR;
#undef PG8_SA
#undef PG8_SB
#undef PG8_STAGE
#undef PG8_LDA
#undef PG8_LDB
#undef PG8_MMA
#undef PG8_WAIT_V
#undef PG8_WAIT_L
#undef PG8_BAR
#undef PG8_SCHED
}

template <class GE> struct EpiGran {
    GE g;
    DI void operator()(f32x4 (&acc)[2][2][4][2], const Unit& u, int wr, int wc, int fr, int fq) const {
        const int row0 = u.pm * BM + wr * 64 + fr, col0 = u.pn * BM + wc * 32 + 4 * fq;
#pragma unroll
        for (int ai = 0; ai < 2; ++ai)
#pragma unroll
            for (int m = 0; m < 4; ++m)
#pragma unroll
                for (int bj = 0; bj < 2; ++bj)
#pragma unroll
                    for (int n = 0; n < 2; ++n) g(row0 + ai * HALF + m * 16, col0 + bj * HALF + n * 16, acc[ai][bj][m][n]);
    }
};
}

#define XB_TMO      128
#define XB_XCNT(j)  (256  + 64 * (j))
#define XB_XSUB(j)  (1280 + 64 * (j))
#define XB_XGEN(j)  (2304 + 64 * (j))
#define XB_TOP      3328
#define XB_TOPGEN   3392
#define XCD_BAR_WORDS 3456
#define XB_SPIN_CAP (1u << 22)
DI unsigned xb_ld(unsigned* p)              { return __hip_atomic_load(p, __ATOMIC_RELAXED, __HIP_MEMORY_SCOPE_AGENT); }
DI unsigned xb_add(unsigned* p, unsigned v) { return __hip_atomic_fetch_add(p, v, __ATOMIC_RELAXED, __HIP_MEMORY_SCOPE_AGENT); }
DI unsigned xb_xcc_id() { return (unsigned)__builtin_amdgcn_s_getreg((3 << 11) | 20) & 0xFu; }
#define XB_SPIN(cond, bar) do { unsigned _sp = 0; while (cond) { __builtin_amdgcn_s_sleep(1); \
    if ((++_sp & 255u) == 0u) { if (xb_ld(&(bar)[XB_TMO])) break; if (_sp > XB_SPIN_CAP) { atomicAdd(&(bar)[XB_TMO], 1u); break; } } } } while (0)
struct XcdBarrier { unsigned* bar; unsigned x; volatile LAS unsigned* st; };
DI XcdBarrier xcd_barrier_post(unsigned* bar, volatile LAS unsigned* st) {
    XcdBarrier b; b.bar = bar; b.x = xb_xcc_id(); b.st = st;
    if (threadIdx.x == 0) (void)xb_add(&bar[XB_XCNT(b.x)], 1u);
    return b;
}
DI void xcd_barrier_complete(unsigned* bar, unsigned x, unsigned& nloc, unsigned& nx) {
    const unsigned G = gridDim.x * gridDim.y * gridDim.z;
    unsigned sum, cnt, mine, sp = 0u;
    for (;;) {
        sum = 0u; cnt = 0u; mine = 0u;
#pragma unroll
        for (unsigned j = 0; j < 16; ++j) { const unsigned c = xb_ld(&bar[XB_XCNT(j)]); sum += c; cnt += (c > 0u) ? 1u : 0u; mine = (j == x) ? c : mine; }
        if (sum == G) break;
        __builtin_amdgcn_s_sleep(1);
        if ((++sp & 255u) == 0u) { if (xb_ld(&bar[XB_TMO])) break; if (sp > XB_SPIN_CAP) { atomicAdd(&bar[XB_TMO], 1u); break; } }
    }
    nloc = mine > 0u ? mine : 1u; nx = cnt > 0u ? cnt : 1u;
}
DI void xcd_barrier(const XcdBarrier& b) {
    asm volatile("s_waitcnt vmcnt(0)" ::: "memory");
    __syncthreads();
    if (threadIdx.x == 0) {
        unsigned* bar = b.bar;
        __builtin_amdgcn_s_waitcnt(0);
        unsigned nloc = b.st[0], nx = b.st[1];
        if (nloc == 0u) { xcd_barrier_complete(bar, b.x, nloc, nx); b.st[0] = nloc; b.st[1] = nx; }
        const unsigned old = xb_add(&bar[XB_XSUB(b.x)], 1u);
        const unsigned gen = old / nloc;
        if (old + 1u == (gen + 1u) * nloc) {
            __builtin_amdgcn_fence(__ATOMIC_RELEASE, "agent");
            asm volatile("s_waitcnt vmcnt(0)" ::: "memory");
            const unsigned og = xb_add(&bar[XB_TOP], 1u);
            const unsigned tg = og / nx;
            if (og + 1u == (tg + 1u) * nx) xb_add(&bar[XB_TOPGEN], 1u);
            else XB_SPIN(xb_ld(&bar[XB_TOPGEN]) == tg, bar);
            __builtin_amdgcn_fence(__ATOMIC_ACQUIRE, "agent");
            xb_add(&bar[XB_XGEN(b.x)], 1u);
            asm volatile("s_waitcnt vmcnt(0)" ::: "memory");
        } else {
            XB_SPIN(xb_ld(&bar[XB_XGEN(b.x)]) == gen, bar);
            __builtin_amdgcn_fence(__ATOMIC_ACQUIRE, "agent");
            asm volatile("s_waitcnt vmcnt(0)" ::: "memory");
        }
    }
    __syncthreads();
}

typedef const GAS float* fptr_t;
typedef const __attribute__((address_space(4))) fptr_t* in_tab_t;
struct Frame {
    LAS unsigned char* lds;
    int vcu, G;
    in_tab_t in; float* out; unsigned char* ws;
};
#define PHASE_BEGIN(F) Frame F = F0; int bx = bx0; { unsigned long long _a = (unsigned long long)F0.in, _b = (unsigned long long)F0.out, _c = (unsigned long long)F0.ws; int _g = F0.G, _v = F0.vcu; \
    asm volatile("" : "+s"(_a), "+s"(_b), "+s"(_c), "+s"(_g), "+s"(_v), "+s"(bx)); \
    F.in = (in_tab_t)_a; F.out = (float*)(GAS float*)_b; F.ws = (unsigned char*)(GAS unsigned char*)_c; F.G = _g; F.vcu = _v; }
#define WSP(T, off) ((T*)(F.ws + (off)))

struct GeIn {
    bf16* proj; const float* bias;
    DI void operator()(int row, int col, const f32x4& a) const {
        const int bc = col + (col >= 4096 ? 8 : 0);
        const f32x4 bv = *(const f32x4*)(bias + bc);
        f32x4 v = a + bv;
        const bool sg = (col >= C_O && col < C_U) || col >= C_G;
        if (sg) { v.x = sigmoid_fast(v.x); v.y = sigmoid_fast(v.y); v.z = sigmoid_fast(v.z); v.w = sigmoid_fast(v.w); }
        u32x2 w; w.x = pk2(v.x, v.y); w.y = pk2(v.z, v.w);
        *(u32x2*)(proj + (size_t)row * NPROJ + col) = w;
    }
};
struct GeKV {
    float* out; bf16* mk; bf16* mvt;
    DI void operator()(int row, int col, const f32x4& a) const {
        const int l = col >> 11, c = col & 2047;
        if (c < 1024) {
            *(f32x4*)(out + O_PMK + ((size_t)l * 2048 + row) * 1024 + c) = a;
            u32x2 w; w.x = pk2(a.x, a.y); w.y = pk2(a.z, a.w);
            *(u32x2*)(mk + ((size_t)l * 2048 + row) * 1024 + c) = w;
        } else {
            const int cc = c - 1024;
            *(f32x4*)(out + O_PMV + ((size_t)l * 2048 + row) * 1024 + cc) = a;
            bf16* t = mvt + ((size_t)l * 1024 + cc) * 2048 + row;
            t[0] = (bf16)f2bf(a.x); t[2048] = (bf16)f2bf(a.y); t[4096] = (bf16)f2bf(a.z); t[6144] = (bf16)f2bf(a.w);
        }
    }
};
struct GeBf16 {
    bf16* o; int ldc;
    DI void operator()(int row, int col, const f32x4& a) const { u32x2 w; w.x = pk2(a.x, a.y); w.y = pk2(a.z, a.w); *(u32x2*)(o + (size_t)row * ldc + col) = w; }
};
template <int MODE> struct GeMix {
    float* mix; bf16* mixb; const bf16* proj; const float* ps;
    DI void operator()(int row, int col, const f32x4& a) const {
        const u32x2 gw = *(const u32x2*)(proj + (size_t)row * NPROJ + C_G + MODE * 1024 + col);
        const f32x4 g = (f32x4){lo16(gw.x), hi16(gw.x), lo16(gw.y), hi16(gw.y)};
        float* mp = mix + (size_t)row * D + col;
        if (MODE == 0) { *(f32x4*)mp = g * a; }
        else if (MODE == 1) { const f32x4 s = *(const f32x4*)(ps + col); *(f32x4*)mp = *(const f32x4*)mp + g * s * a; }
        else { const f32x4 v = *(const f32x4*)mp + g * a; u32x2 w; w.x = pk2(v.x, v.y); w.y = pk2(v.z, v.w); *(u32x2*)(mixb + (size_t)row * D + col) = w; }
    }
};
struct GeRes {
    const float* x; float* t;
    DI void operator()(int row, int col, const f32x4& a) const { const size_t o = (size_t)row * D + col; *(f32x4*)(t + o) = *(const f32x4*)(x + o) * ALPHA + a; }
};

struct EpiSoftmax {
    bf16* P; LAS float* X;
    DI void operator()(f32x4 (&acc)[2][2][4][2], const pg8::Unit& u, int wr, int wc, int fr, int fq) const {
        const float sc = 0.0625f * 1.4426950408889634f;
        LAS float* XM = X; LAS float* XS = X + 1024;
#pragma unroll
        for (int ai = 0; ai < 2; ++ai)
#pragma unroll
            for (int m = 0; m < 4; ++m) {
                float v = -3.0e38f;
#pragma unroll
                for (int bj = 0; bj < 2; ++bj)
#pragma unroll
                    for (int n = 0; n < 2; ++n) { const f32x4 x = acc[ai][bj][m][n]; v = fmaxf(v, fmaxf(fmaxf(x.x, x.y), fmaxf(x.z, x.w))); }
                v = fmaxf(v, __shfl_xor(v, 16)); v = fmaxf(v, __shfl_xor(v, 32));
                if (fq == 0) XM[(ai * 128 + wr * 64 + m * 16 + fr) * 4 + wc] = v;
            }
        LDS_WAIT(); __builtin_amdgcn_s_barrier(); asm volatile("" ::: "memory");
#pragma unroll
        for (int ai = 0; ai < 2; ++ai)
#pragma unroll
            for (int m = 0; m < 4; ++m) {
                const int r = ai * 128 + wr * 64 + m * 16 + fr;
                const f32x4 mm = *(const LAS f32x4*)(XM + r * 4);
                const float mx = fmaxf(fmaxf(mm.x, mm.y), fmaxf(mm.z, mm.w)) * sc;
                float s = 0.f;
#pragma unroll
                for (int bj = 0; bj < 2; ++bj)
#pragma unroll
                    for (int n = 0; n < 2; ++n) { f32x4 x = acc[ai][bj][m][n];
                        x.x = __builtin_amdgcn_exp2f(x.x * sc - mx); x.y = __builtin_amdgcn_exp2f(x.y * sc - mx); x.z = __builtin_amdgcn_exp2f(x.z * sc - mx); x.w = __builtin_amdgcn_exp2f(x.w * sc - mx);
                        acc[ai][bj][m][n] = x; s += (x.x + x.y) + (x.z + x.w); }
                s += __shfl_xor(s, 16); s += __shfl_xor(s, 32);
                if (fq == 0) XS[r * 4 + wc] = s;
                asm volatile("" ::: "memory");
            }
        LDS_WAIT(); __builtin_amdgcn_s_barrier(); asm volatile("" ::: "memory");
#pragma unroll
        for (int ai = 0; ai < 2; ++ai)
#pragma unroll
            for (int m = 0; m < 4; ++m) {
                const int r = ai * 128 + wr * 64 + m * 16 + fr;
                const f32x4 ss = *(const LAS f32x4*)(XS + r * 4);
                const float inv = 1.0f / ((ss.x + ss.y) + (ss.z + ss.w));
                bf16* rowp = P + (size_t)(u.pm * 256 + r) * D + u.pn * 256 + wc * 32 + 4 * fq;
#pragma unroll
                for (int bj = 0; bj < 2; ++bj)
#pragma unroll
                    for (int n = 0; n < 2; ++n) { const f32x4 x = acc[ai][bj][m][n] * inv; u32x2 w; w.x = pk2(x.x, x.y); w.y = pk2(x.z, x.w); *(u32x2*)(rowp + bj * 128 + n * 16) = w; }
                asm volatile("" ::: "memory");
            }
        LDS_WAIT(); __builtin_amdgcn_s_barrier(); asm volatile("" ::: "memory");
    }
};

template <size_t AROW, size_t AH, size_t BB, size_t BH>
struct OrderAttn {
    int G, c; const char* A; const char* Bt;
    DI bool next(int i, pg8::Unit& u) const {
        const long L = (long)i * G + c; if (L >= 256) return false;
        const int b = (int)L >> 5, h = ((int)L >> 3) & 3, rb = (int)L & 7;
        u.pm = b * 8 + rb; u.pn = h;
        u.a = A + (size_t)u.pm * 256 * AROW + (size_t)h * AH;
        u.b = Bt + (size_t)b * BB + (size_t)h * BH; return true;
    }
};

template <class GE>
DI void skinny_job(Frame& F, const bf16* A, int lda, const bf16* Bt, int ldb, int K, const GE& ge, int col_out) {
    const int tid = opaque_tid(), lane = tid & 63, wid = __builtin_amdgcn_readfirstlane(tid >> 6), fr = lane & 15, fq = lane >> 4, row = wid * 16 + fr;
    const bf16* ap = A + (size_t)row * lda + fq * 8;
    const bf16* b0 = Bt + (size_t)fr * ldb + fq * 8; const bf16* b1 = b0 + (size_t)16 * ldb;
    f32x4 acc0 = (f32x4){0.f, 0.f, 0.f, 0.f}, acc1 = acc0;
#pragma unroll 8
    for (int k0 = 0; k0 < K; k0 += 32) {
        const bf16x8 a = *(const bf16x8*)(ap + k0), x0 = *(const bf16x8*)(b0 + k0), x1 = *(const bf16x8*)(b1 + k0);
        acc0 = __builtin_amdgcn_mfma_f32_16x16x32_bf16(x0, a, acc0, 0, 0, 0);
        acc1 = __builtin_amdgcn_mfma_f32_16x16x32_bf16(x1, a, acc1, 0, 0, 0);
    }
    ge(MP + row, col_out + fq * 4, acc0); ge(MP + row, col_out + 16 + fq * 4, acc1);
}
template <class GE>
DI void skinny_gemm(Frame& F, const bf16* A, int lda, const bf16* Bt, int ldb, int N, int K, const GE& ge) {
    for (int job = F.vcu; job < N / 32; job += F.G) skinny_job(F, A, lda, Bt + (size_t)job * 32 * ldb, ldb, K, ge, job * 32);
}

DI void transpose_item(const float* W, int ldw, int K, bf16* WT, int k0, int n0src, int n0dst, LAS float* scr, int lane) {
#pragma unroll 8
    for (int i = 0; i < 32; ++i) { const int kk = 2 * i + (lane >> 5); scr[kk * 33 + (lane & 31)] = W[(size_t)(k0 + kk) * ldw + n0src + (lane & 31)]; }
    LDS_WAIT(); asm volatile("" ::: "memory");
    const int c = lane & 7;
#pragma unroll
    for (int j = 0; j < 4; ++j) { const int n = (lane >> 3) + 8 * j; const LAS float* s = scr + (8 * c) * 33 + n;
        u32x4 o; o.x = pk2(s[0 * 33], s[1 * 33]); o.y = pk2(s[2 * 33], s[3 * 33]); o.z = pk2(s[4 * 33], s[5 * 33]); o.w = pk2(s[6 * 33], s[7 * 33]);
        *(u32x4*)(WT + (size_t)(n0dst + n) * K + k0 + 8 * c) = o; }
    LDS_WAIT(); asm volatile("" ::: "memory");
}
DI void mat_item(const float* W, int ldw, int K, int N, bf16* WT, int item, LAS float* scr, int lane, int shift_at) {
    const int nblk = N / 32, kb = item / nblk, nb = item % nblk, n0 = 32 * nb;
    transpose_item(W, ldw, K, WT, 64 * kb, n0 + (n0 >= shift_at ? 8 : 0), n0, scr, lane);
}
DI void phase_convert(Frame& F) {
    const int tid = opaque_tid(), lane = tid & 63, wid = __builtin_amdgcn_readfirstlane(tid >> 6);
    LAS float* scr = (LAS float*)(F.lds + wid * 16384);
    const int gw = F.vcu * 8 + wid, NGW = F.G * 8;
    constexpr int I_IN = 16 * 288, I_SQ = 16 * 32, I_KV = 16 * 64, I_UP = 16 * 176, I_DN = 44 * 32, I_P = 4 * 8;
    constexpr int PER_L = I_IN + 3 * I_SQ + I_KV + I_UP + I_DN + 4 * I_P;
    for (int it = gw; it < DEPTH * PER_L; it += NGW) {
        const int l = it / PER_L; int r = it % PER_L;
        if (r < I_IN) { mat_item(((const float*)F.in[12]) + (size_t)l * D * INW, INW, D, NPROJ, WSP(bf16, WS_WIN + l * SZ_WIN), r, scr, lane, 4096); continue; } r -= I_IN;
        if (r < I_SQ) { mat_item(((const float*)F.in[15]) + (size_t)l * D * D, D, D, D, WSP(bf16, WS_WM + l * SZ_W1K), r, scr, lane, 1 << 30); continue; } r -= I_SQ;
        if (r < I_SQ) { mat_item(((const float*)F.in[19]) + (size_t)l * D * D, D, D, D, WSP(bf16, WS_WX + l * SZ_W1K), r, scr, lane, 1 << 30); continue; } r -= I_SQ;
        if (r < I_SQ) { mat_item(((const float*)F.in[20]) + (size_t)l * D * D, D, D, D, WSP(bf16, WS_WO + l * SZ_W1K), r, scr, lane, 1 << 30); continue; } r -= I_SQ;
        if (r < I_KV) { mat_item(((const float*)F.in[18]) + (size_t)l * D * 2048, 2048, D, 2048, WSP(bf16, WS_WKV + l * SZ_WKV), r, scr, lane, 1 << 30); continue; } r -= I_KV;
        if (r < I_UP) { mat_item(((const float*)F.in[23]) + (size_t)l * D * FF2, FF2, D, FF2, WSP(bf16, WS_WUP + l * SZ_WUP), r, scr, lane, 1 << 30); continue; } r -= I_UP;
        if (r < I_DN) { mat_item(((const float*)F.in[26]) + (size_t)l * FF * D, D, FF, D, WSP(bf16, WS_WDN + l * SZ_WDN), r, scr, lane, 1 << 30); continue; } r -= I_DN;
        { const int g = r / I_P, ri = r % I_P; mat_item(((const float*)F.in[16]) + ((size_t)l * 4 + g) * 65536, 256, 256, 256, WSP(bf16, WS_WP + l * SZ_WP) + (size_t)g * 65536, ri, scr, lane, 1 << 30); }
    }
    { const float* mem = ((const float*)F.in[1]); bf16* mb = WSP(bf16, WS_MEMB);
      for (size_t i = ((size_t)F.vcu * 512 + tid) * 8; i < (size_t)2048 * D; i += (size_t)F.G * 512 * 8) {
          const f32x4 a = *(const f32x4*)(mem + i), b = *(const f32x4*)(mem + i + 4);
          u32x4 o; o.x = pk2(a.x, a.y); o.y = pk2(a.z, a.w); o.z = pk2(b.x, b.y); o.w = pk2(b.z, b.w); *(u32x4*)(mb + i) = o; } }
}

DI void stage_gate_w(Frame& F, int l) {
    LAS float* wg = (LAS float*)F.lds;
    const float* w = ((const float*)F.in[12]) + (size_t)l * D * INW + 4096;
    for (int i = opaque_tid(); i < 8192; i += 512) { const int k = i >> 3, j = i & 7; wg[j * 1024 + k] = w[(size_t)k * INW + j]; }
    __syncthreads();
}
DI void ln_row(Frame& F, const int lane, const float* src, const float* gam, const float* bet, int row, int lg, float* fin) {
    const f32x4* xr = (const f32x4*)src + lane;
    f32x4 v[4]; float s = 0.f;
#pragma unroll
    for (int j = 0; j < 4; ++j) { v[j] = xr[64 * j]; s += (v[j].x + v[j].y) + (v[j].z + v[j].w); }
    const float mean = wave_sum(s) * (1.f / D); float s2 = 0.f;
#pragma unroll
    for (int j = 0; j < 4; ++j) { v[j] = v[j] - mean; s2 += (v[j].x * v[j].x + v[j].y * v[j].y) + (v[j].z * v[j].z + v[j].w * v[j].w); }
    const float rstd = 1.f / sqrtf(wave_sum(s2) * (1.f / D) + LN_EPS);
    f32x4* xo = (f32x4*)(WSP(float, WS_X) + (size_t)row * D) + lane;
    u32x2* no = (u32x2*)(WSP(bf16, WS_XN) + (size_t)row * D) + lane;
#pragma unroll
    for (int j = 0; j < 4; ++j) {
        const f32x4 g = ((const f32x4*)gam)[lane + 64 * j], b = ((const f32x4*)bet)[lane + 64 * j];
        v[j] = v[j] * rstd * g + b;
        xo[64 * j] = v[j];
        u32x2 w; w.x = pk2(v[j].x, v[j].y); w.y = pk2(v[j].z, v[j].w); no[64 * j] = w;
        if (fin) ((f32x4*)fin)[lane + 64 * j] = v[j];
    }
    if (lg >= 0) {
        const LAS float* wg = (const LAS float*)F.lds;
        float a[8];
#pragma unroll
        for (int q = 0; q < 8; ++q) { float t = 0.f;
#pragma unroll
            for (int j = 0; j < 4; ++j) { const f32x4 w = *(const LAS f32x4*)(wg + q * 1024 + 4 * lane + 256 * j); t += (v[j].x * w.x + v[j].y * w.y) + (v[j].z * w.z + v[j].w * w.w); }
            a[q] = wave_sum(t); }
        if (lane == 0) { const float* bb = ((const float*)F.in[13]) + (size_t)lg * INW + 4096; float* o = WSP(float, WS_IGFG) + (size_t)row * 8;
#pragma unroll
            for (int q = 0; q < 8; ++q) o[q] = a[q] + bb[q]; }
    }
}
DI void phase_ln_in(Frame& F) {
    stage_gate_w(F, 0);
    const int tid = opaque_tid(), lane = tid & 63, wid = __builtin_amdgcn_readfirstlane(tid >> 6);
    const int gw = F.vcu * 8 + wid, NGW = F.G * 8;
    for (int r = gw; r < MT; r += NGW) {
        const float* src = r < MP ? ((const float*)F.in[0]) + (size_t)r * D : ((const float*)F.in[2]) + (size_t)(r - MP) * D;
        ln_row(F, lane, src, ((const float*)F.in[10]), ((const float*)F.in[11]), r, 0, nullptr);
    }
    __syncthreads();
}
DI void phase_ln(Frame& F, int l, int which) {
    const int lg = (which == 1 && l + 1 < DEPTH) ? l + 1 : -1;
    if (lg >= 0) stage_gate_w(F, lg);
    const float* gam = (const float*)(which ? F.in[27] : F.in[21]) + (size_t)l * D; const float* bet = (const float*)(which ? F.in[28] : F.in[22]) + (size_t)l * D;
    const bool last = (which == 1 && l == DEPTH - 1);
    const int tid = opaque_tid(), lane = tid & 63, wid = __builtin_amdgcn_readfirstlane(tid >> 6);
    const int gw = F.vcu * 8 + wid, NGW = F.G * 8;
    for (int r = gw; r < MT; r += NGW) {
        float* fin = last ? (r < MP ? F.out + O_YP + (size_t)r * D : F.out + O_YS + (size_t)(r - MP) * D) : nullptr;
        ln_row(F, lane, WSP(float, WS_T) + (size_t)r * D, gam, bet, r, lg, fin);
    }
    __syncthreads();
}

constexpr int MP_Q = 0, MP_K = 33792, MP_T2 = 67584, MP_VEC = 104448, MP_END = 104448 + 4 * 6 * 64 * 4;
static_assert(MP_END <= XCH_OFF, "mLSTM prep LDS map");
DI float log_sigmoid(float x) { return fminf(x, 0.f) - log1pf(expf(-fabsf(x))); }
DI void mlstm_prep_job(Frame& F, int l, int job) {
    const int b = job >> 5, hh = (job >> 3) & 3, c4 = job & 7;
    const int tid = opaque_tid(), lane = tid & 63, wid = __builtin_amdgcn_readfirstlane(tid >> 6), fr = lane & 15, fq = lane >> 4;
    LAS unsigned char* L = F.lds;
    LAS float* vecs = (LAS float*)(L + MP_VEC);
    const bf16* projb = WSP(bf16, WS_PROJ) + (size_t)b * SEQ * NPROJ;
    const size_t bh = (size_t)(b * NH + hh);
    bf16* PTg = WSP(bf16, WS_PT) + bh * 32 * 4096; bf16* KWg = WSP(bf16, WS_KWT) + bh * 32 * 16384; bf16* VTg = WSP(bf16, WS_VTT) + bh * 32 * 16384;
    float* GTg = WSP(float, WS_GT) + bh * 32 * 192;
    if (wid == 0) {
        const float* igfg = WSP(float, WS_IGFG) + (size_t)b * SEQ * 8;
        float mprev = 0.f; const int nch = 4 * c4 + 4;
#pragma unroll 4
        for (int ch = 0; ch < nch; ++ch) {
            const float igv = igfg[(size_t)(ch * 64 + lane) * 8 + hh], fgv = igfg[(size_t)(ch * 64 + lane) * 8 + 4 + hh];
            const float lf = log_sigmoid(fgv);
            float bb = lf;
#pragma unroll
            for (int o = 1; o < 64; o <<= 1) { const float t = __shfl_up(bb, o); if (lane >= o) bb += t; }
            const float a = igv - bb; float cm = a;
#pragma unroll
            for (int o = 1; o < 64; o <<= 1) { const float t = __shfl_up(cm, o); if (lane >= o) cm = fmaxf(cm, t); }
            const float mt = bb + fmaxf(mprev, cm);
            const float mL = __shfl(mt, 63), bL = __shfl(bb, 63);
            if (ch >= 4 * c4) {
                const int ci = ch - 4 * c4;
                LAS float* v = vecs + ci * 384;
                v[lane] = a; v[64 + lane] = bb; v[128 + lane] = mt; v[192 + lane] = expf(a + bL - mL);
                float* g = GTg + (size_t)ch * 192;
                g[lane] = expf(mprev + bb - mt); g[64 + lane] = expf(-mt);
                if (lane == 0) g[128] = expf(mprev + bL - mL);
            }
            mprev = mL;
        }
        if (c4 == 7 && lane == 0) F.out[O_PM + (l * NB + b) * NH + hh] = mprev;
    }
    u32x4 q4[4], k4[4], v4[4];
#define MP_LOAD(c) do { const bf16* pr = projb + (size_t)((c) * 64 + lane) * NPROJ + hh * 256 + wid * 32; \
        _Pragma("unroll") for (int i = 0; i < 4; ++i) { q4[i] = *(const u32x4*)(pr + C_Q + i * 8); k4[i] = *(const u32x4*)(pr + C_K + i * 8); v4[i] = *(const u32x4*)(pr + C_V + i * 8); } } while (0)
    MP_LOAD(4 * c4);
    __syncthreads();
    for (int ci = 0; ci < 4; ++ci) {
        const int c = 4 * c4 + ci;
        const LAS float* vec = vecs + ci * 384;
#pragma unroll
        for (int i = 0; i < 4; ++i) { *(LAS u32x4*)(L + MP_Q + lane * 528 + (wid * 32 + i * 8) * 2) = q4[i]; *(LAS u32x4*)(L + MP_K + lane * 528 + (wid * 32 + i * 8) * 2) = k4[i]; }
        { const float w = vec[192 + lane] * 0.0625f;
#pragma unroll
          for (int i = 0; i < 4; ++i) { float kf[8]; unpack8(k4[i], kf);
#pragma unroll
            for (int j = 0; j < 8; ++j) ((LAS unsigned short*)(L + MP_T2))[(wid * 32 + i * 8 + j) * 72 + lane] = (unsigned short)f2bf(kf[j] * w); } }
        u32x4 vc4[4];
#pragma unroll
        for (int i = 0; i < 4; ++i) vc4[i] = v4[i];
        __syncthreads();
        if (ci + 1 < 4) MP_LOAD(c + 1);
        { const int tt = wid >> 1;
#pragma unroll
          for (int si = 0; si < 2; ++si) { const int st = (wid & 1) * 2 + si;
            f32x4 acc = (f32x4){0.f, 0.f, 0.f, 0.f};
            if (st <= tt) {
#pragma unroll
                for (int kk = 0; kk < 8; ++kk) { const bf16x8 kf = *(const LAS bf16x8*)(L + MP_K + (st * 16 + fr) * 528 + (kk * 32 + fq * 8) * 2), qf = *(const LAS bf16x8*)(L + MP_Q + (tt * 16 + fr) * 528 + (kk * 32 + fq * 8) * 2);
                    acc = __builtin_amdgcn_mfma_f32_16x16x32_bf16(kf, qf, acc, 0, 0, 0); }
            }
            const int t = tt * 16 + fr, s0 = st * 16 + fq * 4; const float bt = vec[64 + t] - vec[128 + t];
            float p[4];
#pragma unroll
            for (int j = 0; j < 4; ++j) { const int s = s0 + j; p[j] = (s <= t) ? acc[j] * 0.0625f * __expf(vec[s] + bt) : 0.f; }
            u32x2 w; w.x = pk2(p[0], p[1]); w.y = pk2(p[2], p[3]); *(u32x2*)(PTg + (size_t)c * 4096 + t * 64 + s0) = w; } }
        { const int d = tid >> 1, hf = tid & 1; bf16* o = KWg + (size_t)c * 16384 + d * 64 + hf * 32;
#pragma unroll
          for (int i = 0; i < 4; ++i) *(u32x4*)(o + i * 8) = *(const LAS u32x4*)(L + MP_T2 + d * 144 + hf * 64 + i * 16); }
        __syncthreads();
#pragma unroll
        for (int i = 0; i < 4; ++i) { const unsigned ww[4] = {vc4[i].x, vc4[i].y, vc4[i].z, vc4[i].w};
#pragma unroll
            for (int j = 0; j < 4; ++j) { ((LAS unsigned short*)(L + MP_T2))[(wid * 32 + i * 8 + 2 * j) * 72 + lane] = (unsigned short)(ww[j] & 0xffffu); ((LAS unsigned short*)(L + MP_T2))[(wid * 32 + i * 8 + 2 * j + 1) * 72 + lane] = (unsigned short)(ww[j] >> 16); } }
        __syncthreads();
        { const int d = tid >> 1, hf = tid & 1; bf16* o = VTg + (size_t)c * 16384 + d * 64 + hf * 32;
#pragma unroll
          for (int i = 0; i < 4; ++i) *(u32x4*)(o + i * 8) = *(const LAS u32x4*)(L + MP_T2 + d * 144 + hf * 64 + i * 16); }
        __syncthreads();
    }
#undef MP_LOAD
}

constexpr int MR_CT = 0, MR_NUM = 25344, MR_DEN = 33536, MR_END = 34048;
DI void mlstm_rec_job(Frame& F, int l, int job) {
    const int b = job >> 5, hh = (job >> 3) & 3, sl = job & 7;
    const int tid = opaque_tid(), lane = tid & 63, wid = __builtin_amdgcn_readfirstlane(tid >> 6), fr = lane & 15, fq = lane >> 4;
    const int tt = wid >> 1, et = wid & 1, t = tt * 16 + fr;
    LAS unsigned char* L = F.lds;
    const size_t bh = (size_t)(b * NH + hh);
    const bf16* qp = WSP(bf16, WS_PROJ) + ((size_t)b * SEQ + t) * NPROJ + C_Q + hh * 256 + fq * 8;
    const bf16* pp = WSP(bf16, WS_PT) + bh * 32 * 4096 + t * 64 + fq * 8;
    const bf16* kp = WSP(bf16, WS_KWT) + bh * 32 * 16384 + (wid * 32 + fr) * 64 + fq * 8;
    const bf16* vp = WSP(bf16, WS_VTT) + bh * 32 * 16384 + (sl * 32 + fr) * 64 + fq * 8;
    const float* gp = WSP(float, WS_GT) + bh * 32 * 192;
    const int ht = tid >> 3, he0 = (tid & 7) * 4;
    const bf16* sop = WSP(bf16, WS_PROJ) + ((size_t)b * SEQ + ht) * NPROJ + C_O + hh * 256 + sl * 32 + he0;
    bf16* hc = WSP(bf16, WS_HC) + ((size_t)b * SEQ + ht) * D + hh * 256 + sl * 32 + he0;
    for (int i = tid; i < 25344 / 4; i += 512) ((LAS unsigned*)(L + MR_CT))[i] = 0u;
    f32x4 cacc[2][3];
#pragma unroll
    for (int i = 0; i < 2; ++i)
#pragma unroll
        for (int j = 0; j < 3; ++j) cacc[i][j] = (f32x4){0.f, 0.f, 0.f, 0.f};
    bf16x8 ones; { const short o = (fr == 0) ? (short)0x3F80 : (short)0;
#pragma unroll
        for (int j = 0; j < 8; ++j) ones[j] = o; }
    bf16x8 qf[8], pf[2], kf[2][2], vf[2][2]; float inter_l, enm_h, decay; u32x2 sor;
#define MR_LOAD(c) do { \
        _Pragma("unroll") for (int kk = 0; kk < 8; ++kk) qf[kk] = *(const bf16x8*)(qp + (size_t)(c) * 64 * NPROJ + kk * 32); \
        _Pragma("unroll") for (int ks = 0; ks < 2; ++ks) { pf[ks] = *(const bf16x8*)(pp + (size_t)(c) * 4096 + ks * 32); \
            _Pragma("unroll") for (int x = 0; x < 2; ++x) { kf[x][ks] = *(const bf16x8*)(kp + (size_t)(c) * 16384 + x * 1024 + ks * 32); vf[x][ks] = *(const bf16x8*)(vp + (size_t)(c) * 16384 + x * 1024 + ks * 32); } } \
        inter_l = gp[(c) * 192 + t]; enm_h = gp[(c) * 192 + 64 + ht]; decay = gp[(c) * 192 + 128]; sor = *(const u32x2*)(sop + (size_t)(c) * 64 * NPROJ); } while (0)
    MR_LOAD(0);
    __syncthreads();
    for (int c = 0; c < SEQ / 64; ++c) {
        bf16x8 cq[8], cp[2], ck[2][2], cv[2][2];
#pragma unroll
        for (int kk = 0; kk < 8; ++kk) cq[kk] = qf[kk];
#pragma unroll
        for (int ks = 0; ks < 2; ++ks) { cp[ks] = pf[ks]; ck[0][ks] = kf[0][ks]; ck[1][ks] = kf[1][ks]; cv[0][ks] = vf[0][ks]; cv[1][ks] = vf[1][ks]; }
        const float inter = inter_l, enm = enm_h, dec = decay; const u32x2 so_cur = sor;
        if (c + 1 < SEQ / 64) MR_LOAD(c + 1);
        { f32x4 aP = (f32x4){0.f, 0.f, 0.f, 0.f}, aC = aP, dP = aP, dC = aP;
#pragma unroll
          for (int ks = 0; ks < 2; ++ks) {
              if (et == 0) { aP = __builtin_amdgcn_mfma_f32_16x16x32_bf16(cv[0][ks], cp[ks], aP, 0, 0, 0); dP = __builtin_amdgcn_mfma_f32_16x16x32_bf16(ones, cp[ks], dP, 0, 0, 0); }
              else aP = __builtin_amdgcn_mfma_f32_16x16x32_bf16(cv[1][ks], cp[ks], aP, 0, 0, 0); }
#pragma unroll
          for (int kk = 0; kk < 8; ++kk) { const bf16x8 cf = *(const LAS bf16x8*)(L + MR_CT + (et * 16 + fr) * 528 + (kk * 32 + fq * 8) * 2);
              aC = __builtin_amdgcn_mfma_f32_16x16x32_bf16(cf, cq[kk], aC, 0, 0, 0);
              if ((kk >> 2) == et) { const bf16x8 c2 = *(const LAS bf16x8*)(L + MR_CT + (32 + fr) * 528 + (kk * 32 + fq * 8) * 2); dC = __builtin_amdgcn_mfma_f32_16x16x32_bf16(c2, cq[kk], dC, 0, 0, 0); } }
          *(LAS f32x4*)(L + MR_NUM + (t * 32 + et * 16 + fq * 4) * 4) = aP + aC * inter;
          if (fq == 0) ((LAS float*)(L + MR_DEN))[t * 2 + et] = dP.x + dC.x * inter; }
        __syncthreads();
        { const f32x4 nm = *(const LAS f32x4*)(L + MR_NUM + (ht * 32 + he0) * 4); const float den = ((LAS float*)(L + MR_DEN))[ht * 2] + ((LAS float*)(L + MR_DEN))[ht * 2 + 1];
          const float inv = 1.0f / fmaxf(fabsf(den), enm);
          u32x2 w; w.x = pk2(lo16(so_cur.x) * nm.x * inv, hi16(so_cur.x) * nm.y * inv); w.y = pk2(lo16(so_cur.y) * nm.z * inv, hi16(so_cur.y) * nm.w * inv);
          *(u32x2*)(hc + (size_t)c * 64 * D) = w; }
#pragma unroll
        for (int di = 0; di < 2; ++di) {
#pragma unroll
            for (int e3 = 0; e3 < 3; ++e3) { f32x4 a = cacc[di][e3] * dec;
#pragma unroll
                for (int ks = 0; ks < 2; ++ks) a = __builtin_amdgcn_mfma_f32_16x16x32_bf16(ck[di][ks], e3 == 2 ? ones : cv[e3 & 1][ks], a, 0, 0, 0);
                cacc[di][e3] = a;
                u32x2 w; w.x = pk2(a.x, a.y); w.y = pk2(a.z, a.w); *(LAS u32x2*)(L + MR_CT + (e3 * 16 + fr) * 528 + ((wid * 2 + di) * 16 + fq * 4) * 2) = w; } }
        __syncthreads();
    }
#undef MR_LOAD
    { float* pc = F.out + O_PC + ((size_t)((l * NB + b) * NH + hh)) * 65536;
#pragma unroll
      for (int di = 0; di < 2; ++di) { const int dt = wid * 2 + di;
#pragma unroll
        for (int e3 = 0; e3 < 2; ++e3)
#pragma unroll
            for (int j = 0; j < 4; ++j) pc[(size_t)(dt * 16 + fq * 4 + j) * 256 + sl * 32 + e3 * 16 + fr] = cacc[di][e3][j];
        if (sl == 0 && fr == 0) { float* pn = F.out + O_PN + ((size_t)((l * NB + b) * NH + hh)) * 256;
#pragma unroll
            for (int j = 0; j < 4; ++j) pn[dt * 16 + fq * 4 + j] = cacc[di][2][j]; } } }
    __syncthreads();
}

DI void mlstm_sample_job(Frame& F, int l, int job) {
    const int b = job >> 2, hh = job & 3; const int tid = opaque_tid(), lane = tid & 63, wid = __builtin_amdgcn_readfirstlane(tid >> 6);
    LAS float* qs = (LAS float*)F.lds;
    LAS float* kws = qs + 256; LAS float* red = qs + 512; LAS float* scal = qs + 512 + 2048;
    const bf16* prow = WSP(bf16, WS_PROJ) + (size_t)(MP + b) * NPROJ;
    const size_t sidx = (size_t)((l * MS + b) * NH + hh);
    const float* C = ((const float*)F.in[5]) + sidx * 65536; const float* nst = ((const float*)F.in[6]) + sidx * 256; float* Cn = F.out + O_SC + sidx * 65536;
    const float ig = WSP(float, WS_IGFG)[(size_t)(MP + b) * 8 + hh], fg = WSP(float, WS_IGFG)[(size_t)(MP + b) * 8 + 4 + hh];
    const float m0 = ((const float*)F.in[7])[sidx];
    const float lf = log_sigmoid(fg), mt = fmaxf(m0 + lf, ig), inter = expf(m0 + lf - mt), wsi = expf(ig - mt);
    if (tid < 256) {
        const float q = bf2f(prow[C_Q + hh * 256 + tid]), k = bf2f(prow[C_K + hh * 256 + tid]) * 0.0625f;
        qs[tid] = q; kws[tid] = k * wsi;
        const float n0 = nst[tid];
        F.out[O_SN + sidx * 256 + tid] = inter * n0 + k * wsi;
        float qk = q * k, qn = q * n0;
        qk = wave_sum(qk); qn = wave_sum(qn);
        if (lane == 0) { scal[wid * 2] = qk; scal[wid * 2 + 1] = qn; }
    }
    __syncthreads();
    const float qk = scal[0] + scal[2] + scal[4] + scal[6], qn = scal[1] + scal[3] + scal[5] + scal[7];
    const float s = qk * wsi, den = s + inter * qn, inv = 1.0f / fmaxf(fabsf(den), expf(-mt));
    const u32x2 vw = *(const u32x2*)(prow + C_V + hh * 256 + lane * 4);
    const f32x4 v4 = (f32x4){lo16(vw.x), hi16(vw.x), lo16(vw.y), hi16(vw.y)};
    f32x4 acc = (f32x4){0.f, 0.f, 0.f, 0.f};
#pragma unroll 8
    for (int i = 0; i < 32; ++i) { const int d = wid * 32 + i; const f32x4 c = *(const f32x4*)(C + (size_t)d * 256 + lane * 4);
        acc += c * qs[d]; *(f32x4*)(Cn + (size_t)d * 256 + lane * 4) = c * inter + v4 * kws[d]; }
    *(LAS f32x4*)(red + wid * 256 + lane * 4) = acc;
    __syncthreads();
    if (tid < 256) { float qc = 0.f;
#pragma unroll
        for (int w = 0; w < 8; ++w) qc += red[w * 256 + tid];
        const float v = bf2f(prow[C_V + hh * 256 + tid]), so = bf2f(prow[C_O + hh * 256 + tid]);
        const float h = (s * v + inter * qc) * inv;
        WSP(bf16, WS_HC)[(size_t)(MP + b) * D + hh * 256 + tid] = (bf16)f2bf(so * h); }
    if (tid == 0) F.out[O_SM + sidx] = mt;
    __syncthreads();
}

DI void xattn_sample_job(Frame& F, int l, int job) {
    const int b = job >> 1, hp = job & 1; const int tid = opaque_tid(), lane = tid & 63, wid = __builtin_amdgcn_readfirstlane(tid >> 6);
    LAS float* sc = (LAS float*)F.lds;
    const bf16* prow = WSP(bf16, WS_PROJ) + (size_t)(MP + b) * NPROJ + C_XQ + hp * 512;
    const float* Kc = ((const float*)F.in[3]) + ((size_t)(l * MS + b) * NMEM) * 1024 + hp * 512;
    const float* Vc = ((const float*)F.in[4]) + ((size_t)(l * MS + b) * NMEM) * 1024 + hp * 512;
    float q[8]; { const u32x4 w = *(const u32x4*)(prow + lane * 8); unpack8(w, q); }
#pragma unroll 4
    for (int i = 0; i < 32; ++i) { const int m = wid + 8 * i; const f32x4 k0 = *(const f32x4*)(Kc + (size_t)m * 1024 + lane * 8), k1 = *(const f32x4*)(Kc + (size_t)m * 1024 + lane * 8 + 4);
        float t = (q[0] * k0.x + q[1] * k0.y) + (q[2] * k0.z + q[3] * k0.w) + (q[4] * k1.x + q[5] * k1.y) + (q[6] * k1.z + q[7] * k1.w);
#pragma unroll
        for (int o = 1; o < 32; o <<= 1) t += __shfl_xor(t, o);
        if ((lane & 31) == 0) sc[(lane >> 5) * 256 + m] = t * 0.0625f; }
    __syncthreads();
    if (wid < 2) { float x[4]; float mx = -3.0e38f;
#pragma unroll
        for (int j = 0; j < 4; ++j) { x[j] = sc[wid * 256 + lane + 64 * j]; mx = fmaxf(mx, x[j]); }
#pragma unroll
        for (int o = 1; o < 64; o <<= 1) mx = fmaxf(mx, __shfl_xor(mx, o));
        float s = 0.f;
#pragma unroll
        for (int j = 0; j < 4; ++j) { x[j] = expf(x[j] - mx); s += x[j]; }
        s = wave_sum(s); const float inv = 1.0f / s;
#pragma unroll
        for (int j = 0; j < 4; ++j) sc[wid * 256 + lane + 64 * j] = x[j] * inv; }
    __syncthreads();
    { const int hsel = tid >> 8; float acc = 0.f;
#pragma unroll 8
      for (int m = 0; m < 256; ++m) acc += sc[hsel * 256 + m] * Vc[(size_t)m * 1024 + tid];
      WSP(bf16, WS_OX)[(size_t)(MP + b) * D + hp * 512 + tid] = (bf16)f2bf(acc); }
    __syncthreads();
}

DI void phase_pool_d(Frame& F, int l) {
    const bf16* proj = WSP(bf16, WS_PROJ); bf16* dp = WSP(bf16, WS_DP);
    const size_t gt = (size_t)F.vcu * 512 + opaque_tid(), gs = (size_t)F.G * 512;
    for (size_t it = gt; it < (size_t)MP * 128; it += gs) {
        const int row = (int)(it >> 7), cg = (int)(it & 127), t = row & (SEQ - 1), b = row >> 11, w = 2 << (cg >> 5), nw = (t + 1 < w) ? t + 1 : w;
        const bf16* up = proj + (size_t)row * NPROJ + C_U + cg * 8;
        float u0[8], sum[8]; { const u32x4 x = *(const u32x4*)up; unpack8(x, u0); }
#pragma unroll
        for (int j = 0; j < 8; ++j) sum[j] = u0[j];
        for (int i = 1; i < nw; ++i) { float f[8]; const u32x4 x = *(const u32x4*)(up - (size_t)i * NPROJ); unpack8(x, f);
#pragma unroll
            for (int j = 0; j < 8; ++j) sum[j] += f[j]; }
        const float inv = 1.0f / (float)nw;
        u32x4 o; o.x = pk2(sum[0] * inv - u0[0], sum[1] * inv - u0[1]); o.y = pk2(sum[2] * inv - u0[2], sum[3] * inv - u0[3]); o.z = pk2(sum[4] * inv - u0[4], sum[5] * inv - u0[5]); o.w = pk2(sum[6] * inv - u0[6], sum[7] * inv - u0[7]);
        *(u32x4*)(dp + (size_t)row * D + cg * 8) = o;
        if (t >= SEQ - 15) { float* pp = F.out + O_PPOOL + ((size_t)(l * NB + b) * 15 + (t - (SEQ - 15))) * 1024 + cg * 8;
            *(f32x4*)pp = (f32x4){u0[0], u0[1], u0[2], u0[3]}; *(f32x4*)(pp + 4) = (f32x4){u0[4], u0[5], u0[6], u0[7]}; }
    }
    for (size_t it = gt; it < (size_t)MS * 128; it += gs) {
        const int b = (int)(it >> 7), cg = (int)(it & 127), w = 2 << (cg >> 5);
        const float* sp = ((const float*)F.in[8]) + ((size_t)(l * MS + b) * 15) * 1024 + cg * 8;
        float u0[8], sum[8]; { const u32x4 x = *(const u32x4*)(proj + (size_t)(MP + b) * NPROJ + C_U + cg * 8); unpack8(x, u0); }
#pragma unroll
        for (int j = 0; j < 8; ++j) sum[j] = u0[j];
        for (int i = 1; i < w; ++i) { const f32x4 a = *(const f32x4*)(sp + (size_t)(15 - i) * 1024), c = *(const f32x4*)(sp + (size_t)(15 - i) * 1024 + 4);
            sum[0] += a.x; sum[1] += a.y; sum[2] += a.z; sum[3] += a.w; sum[4] += c.x; sum[5] += c.y; sum[6] += c.z; sum[7] += c.w; }
        const float inv = 1.0f / (float)w;
        u32x4 o; o.x = pk2(sum[0] * inv - u0[0], sum[1] * inv - u0[1]); o.y = pk2(sum[2] * inv - u0[2], sum[3] * inv - u0[3]); o.z = pk2(sum[4] * inv - u0[4], sum[5] * inv - u0[5]); o.w = pk2(sum[6] * inv - u0[6], sum[7] * inv - u0[7]);
        *(u32x4*)(dp + (size_t)(MP + b) * D + cg * 8) = o;
        float* so = F.out + O_SPOOL + ((size_t)(l * MS + b) * 15) * 1024 + cg * 8;
        for (int i = 0; i < 14; ++i) { *(f32x4*)(so + (size_t)i * 1024) = *(const f32x4*)(sp + (size_t)(i + 1) * 1024); *(f32x4*)(so + (size_t)i * 1024 + 4) = *(const f32x4*)(sp + (size_t)(i + 1) * 1024 + 4); }
        *(f32x4*)(so + (size_t)14 * 1024) = (f32x4){u0[0], u0[1], u0[2], u0[3]}; *(f32x4*)(so + (size_t)14 * 1024 + 4) = (f32x4){u0[4], u0[5], u0[6], u0[7]};
    }
}

DI void phase_headnorm(Frame& F, int l) {
    const bf16* hc = WSP(bf16, WS_HC); bf16* hn = WSP(bf16, WS_HN); const float* g = ((const float*)F.in[14]) + (size_t)l * D;
    const int tid = opaque_tid(), lane = tid & 63, wid = __builtin_amdgcn_readfirstlane(tid >> 6);
    const int gw = F.vcu * 8 + wid, NGW = F.G * 8;
    for (int it = gw; it < MT * 4; it += NGW) {
        const size_t off = (size_t)(it >> 2) * D + (it & 3) * 256 + lane * 4;
        const u32x2 w = *(const u32x2*)(hc + off);
        float x0 = lo16(w.x), x1 = hi16(w.x), x2 = lo16(w.y), x3 = hi16(w.y);
        const float mu = wave_sum((x0 + x1) + (x2 + x3)) * (1.f / 256.f);
        x0 -= mu; x1 -= mu; x2 -= mu; x3 -= mu;
        const float var = wave_sum((x0 * x0 + x1 * x1) + (x2 * x2 + x3 * x3)) * (1.f / 256.f);
        const float r = 1.f / sqrtf(var + LN_EPS);
        const f32x4 gg = *(const f32x4*)(g + (it & 3) * 256 + lane * 4);
        u32x2 o; o.x = pk2(x0 * r * gg.x, x1 * r * gg.y); o.y = pk2(x2 * r * gg.z, x3 * r * gg.w);
        *(u32x2*)(hn + off) = o;
    }
}

DI float gelu_tanh(float x) { return x * sigmoid_fast(1.5957691216057308f * (x + 0.044715f * x * x * x)); }
DI void conv8(const float (&h0)[8], const float (&h1)[8], const float (&h2)[8], const float* cw, const float* cb, int c, float (&o)[8]) {
    const f32x4 w0a = *(const f32x4*)(cw + c), w0b = *(const f32x4*)(cw + c + 4), w1a = *(const f32x4*)(cw + FF2 + c), w1b = *(const f32x4*)(cw + FF2 + c + 4), w2a = *(const f32x4*)(cw + 2 * FF2 + c), w2b = *(const f32x4*)(cw + 2 * FF2 + c + 4);
    const f32x4 ba = *(const f32x4*)(cb + c), bb = *(const f32x4*)(cb + c + 4);
    const float w0[8] = {w0a.x, w0a.y, w0a.z, w0a.w, w0b.x, w0b.y, w0b.z, w0b.w}, w1[8] = {w1a.x, w1a.y, w1a.z, w1a.w, w1b.x, w1b.y, w1b.z, w1b.w}, w2[8] = {w2a.x, w2a.y, w2a.z, w2a.w, w2b.x, w2b.y, w2b.z, w2b.w};
    const float bv[8] = {ba.x, ba.y, ba.z, ba.w, bb.x, bb.y, bb.z, bb.w};
#pragma unroll
    for (int j = 0; j < 8; ++j) o[j] = h0[j] * w0[j] + h1[j] * w1[j] + h2[j] * w2[j] + bv[j];
}
DI void phase_conv_act(Frame& F, int l) {
    const bf16* hup = WSP(bf16, WS_HUP); bf16* act = WSP(bf16, WS_ACT);
    const float* cw = ((const float*)F.in[24]) + (size_t)l * 3 * FF2; const float* cb = ((const float*)F.in[25]) + (size_t)l * FF2;
    const size_t gt = (size_t)F.vcu * 512 + opaque_tid(), gs = (size_t)F.G * 512;
    for (size_t it = gt; it < (size_t)MP * 352; it += gs) {
        const int row = (int)(it / 352), cg = (int)(it % 352), t = row & (SEQ - 1), b = row >> 11;
        float ha[3][8], hb[3][8];
#pragma unroll
        for (int i = 0; i < 3; ++i) {
            if (t - (2 - i) >= 0) { const bf16* p = hup + (size_t)(row - (2 - i)) * FF2 + cg * 8; const u32x4 xa = *(const u32x4*)p, xb = *(const u32x4*)(p + FF); unpack8(xa, ha[i]); unpack8(xb, hb[i]); }
            else {
#pragma unroll
                for (int j = 0; j < 8; ++j) { ha[i][j] = 0.f; hb[i][j] = 0.f; } }
        }
        float ca[8], cbv[8]; conv8(ha[0], ha[1], ha[2], cw, cb, cg * 8, ca); conv8(hb[0], hb[1], hb[2], cw, cb, FF + cg * 8, cbv);
        u32x4 o; o.x = pk2(gelu_tanh(ca[0]) * cbv[0], gelu_tanh(ca[1]) * cbv[1]); o.y = pk2(gelu_tanh(ca[2]) * cbv[2], gelu_tanh(ca[3]) * cbv[3]);
        o.z = pk2(gelu_tanh(ca[4]) * cbv[4], gelu_tanh(ca[5]) * cbv[5]); o.w = pk2(gelu_tanh(ca[6]) * cbv[6], gelu_tanh(ca[7]) * cbv[7]);
        *(u32x4*)(act + (size_t)row * FF + cg * 8) = o;
        if (t >= SEQ - 2) { float* pc = F.out + O_PCONV + ((size_t)(l * NB + b) * 2 + (t - (SEQ - 2))) * FF2 + cg * 8;
            *(f32x4*)pc = (f32x4){ha[2][0], ha[2][1], ha[2][2], ha[2][3]}; *(f32x4*)(pc + 4) = (f32x4){ha[2][4], ha[2][5], ha[2][6], ha[2][7]};
            *(f32x4*)(pc + FF) = (f32x4){hb[2][0], hb[2][1], hb[2][2], hb[2][3]}; *(f32x4*)(pc + FF + 4) = (f32x4){hb[2][4], hb[2][5], hb[2][6], hb[2][7]}; }
    }
    for (size_t it = gt; it < (size_t)MS * 352; it += gs) {
        const int b = (int)(it / 352), cg = (int)(it % 352);
        const float* sc = ((const float*)F.in[9]) + ((size_t)(l * MS + b) * 2) * FF2 + cg * 8;
        float ha[3][8], hb[3][8];
#pragma unroll
        for (int i = 0; i < 2; ++i) { const f32x4 a0 = *(const f32x4*)(sc + (size_t)i * FF2), a1 = *(const f32x4*)(sc + (size_t)i * FF2 + 4), b0 = *(const f32x4*)(sc + (size_t)i * FF2 + FF), b1 = *(const f32x4*)(sc + (size_t)i * FF2 + FF + 4);
            ha[i][0] = a0.x; ha[i][1] = a0.y; ha[i][2] = a0.z; ha[i][3] = a0.w; ha[i][4] = a1.x; ha[i][5] = a1.y; ha[i][6] = a1.z; ha[i][7] = a1.w;
            hb[i][0] = b0.x; hb[i][1] = b0.y; hb[i][2] = b0.z; hb[i][3] = b0.w; hb[i][4] = b1.x; hb[i][5] = b1.y; hb[i][6] = b1.z; hb[i][7] = b1.w; }
        { const bf16* p = hup + (size_t)(MP + b) * FF2 + cg * 8; const u32x4 xa = *(const u32x4*)p, xb = *(const u32x4*)(p + FF); unpack8(xa, ha[2]); unpack8(xb, hb[2]); }
        float ca[8], cbv[8]; conv8(ha[0], ha[1], ha[2], cw, cb, cg * 8, ca); conv8(hb[0], hb[1], hb[2], cw, cb, FF + cg * 8, cbv);
        u32x4 o; o.x = pk2(gelu_tanh(ca[0]) * cbv[0], gelu_tanh(ca[1]) * cbv[1]); o.y = pk2(gelu_tanh(ca[2]) * cbv[2], gelu_tanh(ca[3]) * cbv[3]);
        o.z = pk2(gelu_tanh(ca[4]) * cbv[4], gelu_tanh(ca[5]) * cbv[5]); o.w = pk2(gelu_tanh(ca[6]) * cbv[6], gelu_tanh(ca[7]) * cbv[7]);
        *(u32x4*)(act + (size_t)(MP + b) * FF + cg * 8) = o;
        float* so = F.out + O_SCONV + ((size_t)(l * MS + b) * 2) * FF2 + cg * 8;
#pragma unroll
        for (int i = 0; i < 2; ++i) { *(f32x4*)(so + (size_t)i * FF2) = (f32x4){ha[i + 1][0], ha[i + 1][1], ha[i + 1][2], ha[i + 1][3]}; *(f32x4*)(so + (size_t)i * FF2 + 4) = (f32x4){ha[i + 1][4], ha[i + 1][5], ha[i + 1][6], ha[i + 1][7]};
            *(f32x4*)(so + (size_t)i * FF2 + FF) = (f32x4){hb[i + 1][0], hb[i + 1][1], hb[i + 1][2], hb[i + 1][3]}; *(f32x4*)(so + (size_t)i * FF2 + FF + 4) = (f32x4){hb[i + 1][4], hb[i + 1][5], hb[i + 1][6], hb[i + 1][7]}; }
    }
}

constexpr int PH_PER_L = 11, PH_TOTAL = 2 + DEPTH * PH_PER_L;
struct Args { const float* in[29]; float* out; unsigned char* ws; int ph_lo, ph_hi, li, pad; };
__global__ void __launch_bounds__(512, 2) trunk_fwd(Args args) {
    extern __shared__ __attribute__((aligned(16))) unsigned char lds_raw[];
    Frame F0;
    F0.lds = (LAS unsigned char*)lds_raw;
    F0.G = gridDim.x; { const int bx = blockIdx.x; F0.vcu = (F0.G % 8 == 0) ? (bx % 8) * (F0.G / 8) + bx / 8 : bx; }
    F0.in = (in_tab_t)__builtin_amdgcn_kernarg_segment_ptr(); F0.out = args.out; F0.ws = args.ws;
    volatile LAS unsigned* MISC = (volatile LAS unsigned*)(F0.lds + MISC_OFF);
    if (threadIdx.x < 64) MISC[threadIdx.x] = 0u;
    __syncthreads();
    unsigned* ctl = (unsigned*)(args.ws + WS_CTL);
    XcdBarrier bar = xcd_barrier_post(ctl + CW_BAR + args.li * XCD_BAR_WORDS, MISC + 8);
    const int lo = args.ph_lo, hi = args.ph_hi;
#define IN(k) (lo <= (k) && (k) < hi)
#define PM(b) ((PHMASK >> (b)) & 1u)
#define SEAM(k) do { if (IN(k) && IN((k) + 1)) xcd_barrier(bar); } while (0)
    const int bx0 = (int)blockIdx.x;

    if (PM(0) && IN(0)) { PHASE_BEGIN(F); phase_convert(F); __syncthreads(); phase_ln_in(F); }
    SEAM(0);
    if (PM(1) && IN(1)) {
        PHASE_BEGIN(F);
        pg8::OrderMN S; S.init(WSP(bf16, WS_MEMB), D, WSP(bf16, WS_WKV), D, 2048, DEPTH * 2048, F.G, bx);
        pg8::EpiGran<GeKV> E{{F.out, WSP(bf16, WS_MK), WSP(bf16, WS_MVT)}};
        pg8::gemm_phase(F.lds, D, D, D, S, E);
    }
    SEAM(1);
    for (int l = 0; l < DEPTH; ++l) {
        const int p0 = 2 + l * PH_PER_L;
        _Pragma("unroll 1") for (int rep = 0; rep <= REP(0); ++rep) if (PM(2) && IN(p0 + 0)) { if (rep) xcd_barrier(bar);
            PHASE_BEGIN(F);
            const bf16* W = WSP(bf16, WS_WIN + l * SZ_WIN);
            pg8::OrderMN S; S.init(WSP(bf16, WS_XN), D, W, D, MP, NPROJ, F.G, bx);
            pg8::EpiGran<GeIn> E{{WSP(bf16, WS_PROJ), ((const float*)F.in[13]) + (size_t)l * INW}};
            pg8::gemm_phase(F.lds, D, D, D, S, E);
            skinny_gemm(F, WSP(bf16, WS_XN) + (size_t)MP * D, D, W, D, NPROJ, D, E.g);
        }
        SEAM(p0 + 0);
        _Pragma("unroll 1") for (int rep = 0; rep <= REP(1); ++rep) if (PM(3) && IN(p0 + 1)) { if (rep) xcd_barrier(bar);
            PHASE_BEGIN(F);
            _Pragma("unroll 1") for (int sr = 0; sr <= SREP(0); ++sr) if (SM(0)) for (int j = F.vcu; j < 256; j += F.G) mlstm_prep_job(F, l, j);
            _Pragma("unroll 1") for (int sr = 0; sr <= SREP(1); ++sr) if (SM(1)) {
                OrderAttn<(size_t)NPROJ * 2, (size_t)256 * 2, (size_t)256 * D * 2, (size_t)256 * 2> S{F.G, bx, (const char*)(WSP(bf16, WS_PROJ) + C_XQ), (const char*)(WSP(bf16, WS_MK) + (size_t)l * 2048 * D)};
                EpiSoftmax E{WSP(bf16, WS_PB), (LAS float*)(F.lds + XCH_OFF)};
                pg8::gemm_phase(F.lds, 256, NPROJ, D, S, E);
            }
            _Pragma("unroll 1") for (int sr = 0; sr <= SREP(2); ++sr) if (SM(2)) for (int j = F.vcu; j < MS * NH; j += F.G) mlstm_sample_job(F, l, j);
            _Pragma("unroll 1") for (int sr = 0; sr <= SREP(3); ++sr) if (SM(3)) for (int j = F.vcu; j < MS * 2; j += F.G) xattn_sample_job(F, l, j);
            _Pragma("unroll 1") for (int sr = 0; sr <= SREP(4); ++sr) if (SM(4)) phase_pool_d(F, l);
        }
        SEAM(p0 + 1);
        _Pragma("unroll 1") for (int rep = 0; rep <= REP(2); ++rep) if (PM(4) && IN(p0 + 2)) { if (rep) xcd_barrier(bar);
            PHASE_BEGIN(F);
            _Pragma("unroll 1") for (int sr = 0; sr <= SREP(5); ++sr) if (SM(5)) for (int j = F.vcu; j < 256; j += F.G) mlstm_rec_job(F, l, j);
            OrderAttn<(size_t)D * 2, (size_t)256 * 2, (size_t)256 * 2, (size_t)256 * 2048 * 2> S{F.G, bx, (const char*)WSP(bf16, WS_PB), (const char*)(WSP(bf16, WS_MVT) + (size_t)l * 1024 * 2048)};
            pg8::EpiGran<GeBf16> E{{WSP(bf16, WS_OX), D}};
            pg8::gemm_phase(F.lds, 256, D, 2048, S, E);
        }
        SEAM(p0 + 2);
        _Pragma("unroll 1") for (int rep = 0; rep <= REP(3); ++rep) if (PM(5) && IN(p0 + 3)) { if (rep) xcd_barrier(bar); PHASE_BEGIN(F); phase_headnorm(F, l); }
        SEAM(p0 + 3);
        _Pragma("unroll 1") for (int rep = 0; rep <= REP(4); ++rep) if (PM(6) && IN(p0 + 4)) { if (rep) xcd_barrier(bar);
            PHASE_BEGIN(F);
            const bf16* proj = WSP(bf16, WS_PROJ); float* mix = WSP(float, WS_MIX); bf16* mixb = WSP(bf16, WS_MIXB); const float* ps = ((const float*)F.in[17]) + (size_t)l * D;
            { const bf16* W = WSP(bf16, WS_WM + l * SZ_W1K); pg8::OrderMN S; S.init(WSP(bf16, WS_HN), D, W, D, MP, D, F.G, bx);
              pg8::EpiGran<GeMix<0>> E{{mix, mixb, proj, ps}}; pg8::gemm_phase(F.lds, D, D, D, S, E);
              skinny_gemm(F, WSP(bf16, WS_HN) + (size_t)MP * D, D, W, D, D, D, E.g); }
            { const bf16* W = WSP(bf16, WS_WP + l * SZ_WP); pg8::OrderMN S; S.init(WSP(bf16, WS_DP), D, W, 256, MP, D, F.G, bx, 512);
              pg8::EpiGran<GeMix<1>> E{{mix, mixb, proj, ps}}; pg8::gemm_phase(F.lds, 256, D, 256, S, E);
              for (int job = F.vcu; job < 32; job += F.G) { const int g = job >> 3;
                  skinny_job(F, WSP(bf16, WS_DP) + (size_t)MP * D + g * 256, D, W + (size_t)g * 65536 + (size_t)(job & 7) * 32 * 256, 256, 256, E.g, job * 32); } }
            { const bf16* W = WSP(bf16, WS_WX + l * SZ_W1K); pg8::OrderMN S; S.init(WSP(bf16, WS_OX), D, W, D, MP, D, F.G, bx);
              pg8::EpiGran<GeMix<2>> E{{mix, mixb, proj, ps}}; pg8::gemm_phase(F.lds, D, D, D, S, E);
              skinny_gemm(F, WSP(bf16, WS_OX) + (size_t)MP * D, D, W, D, D, D, E.g); }
        }
        SEAM(p0 + 4);
        _Pragma("unroll 1") for (int rep = 0; rep <= REP(5); ++rep) if (PM(7) && IN(p0 + 5)) { if (rep) xcd_barrier(bar);
            PHASE_BEGIN(F);
            const bf16* W = WSP(bf16, WS_WO + l * SZ_W1K); pg8::OrderMN S; S.init(WSP(bf16, WS_MIXB), D, W, D, MP, D, F.G, bx);
            pg8::EpiGran<GeRes> E{{WSP(float, WS_X), WSP(float, WS_T)}}; pg8::gemm_phase(F.lds, D, D, D, S, E);
            skinny_gemm(F, WSP(bf16, WS_MIXB) + (size_t)MP * D, D, W, D, D, D, E.g);
        }
        SEAM(p0 + 5);
        _Pragma("unroll 1") for (int rep = 0; rep <= REP(6); ++rep) if (PM(8) && IN(p0 + 6)) { if (rep) xcd_barrier(bar); PHASE_BEGIN(F); phase_ln(F, l, 0); }
        SEAM(p0 + 6);
        _Pragma("unroll 1") for (int rep = 0; rep <= REP(7); ++rep) if (PM(9) && IN(p0 + 7)) { if (rep) xcd_barrier(bar);
            PHASE_BEGIN(F);
            const bf16* W = WSP(bf16, WS_WUP + l * SZ_WUP); pg8::OrderMN S; S.init(WSP(bf16, WS_XN), D, W, D, MP, FF2, F.G, bx);
            pg8::EpiGran<GeBf16> E{{WSP(bf16, WS_HUP), FF2}}; pg8::gemm_phase(F.lds, D, D, D, S, E);
            skinny_gemm(F, WSP(bf16, WS_XN) + (size_t)MP * D, D, W, D, FF2, D, E.g);
        }
        SEAM(p0 + 7);
        _Pragma("unroll 1") for (int rep = 0; rep <= REP(8); ++rep) if (PM(10) && IN(p0 + 8)) { if (rep) xcd_barrier(bar); PHASE_BEGIN(F); phase_conv_act(F, l); }
        SEAM(p0 + 8);
        _Pragma("unroll 1") for (int rep = 0; rep <= REP(9); ++rep) if (PM(11) && IN(p0 + 9)) { if (rep) xcd_barrier(bar);
            PHASE_BEGIN(F);
            const bf16* W = WSP(bf16, WS_WDN + l * SZ_WDN); pg8::OrderMN S; S.init(WSP(bf16, WS_ACT), FF, W, FF, MP, D, F.G, bx);
            pg8::EpiGran<GeRes> E{{WSP(float, WS_X), WSP(float, WS_T)}}; pg8::gemm_phase(F.lds, FF, FF, FF, S, E);
            skinny_gemm(F, WSP(bf16, WS_ACT) + (size_t)MP * FF, FF, W, FF, D, FF, E.g);
        }
        SEAM(p0 + 9);
        _Pragma("unroll 1") for (int rep = 0; rep <= REP(10); ++rep) if (PM(12) && IN(p0 + 10)) { if (rep) xcd_barrier(bar); PHASE_BEGIN(F); phase_ln(F, l, 1); }
        SEAM(p0 + 10);
    }
#undef IN
#undef SEAM
}

extern "C" void kernel_launch(void* const* d_in, const int* in_sizes, int n_in, void* d_out, int out_size, void* d_ws, size_t ws_size, hipStream_t stream) {
    static int grid = 0;
    if (grid == 0) {
        if (n_in != 29 || (size_t)out_size != O_END || ws_size < WS_END) { fprintf(stderr, "kernel_launch: unexpected shapes (n_in %d, out %d, ws %zu; need ws >= %zu)\n", n_in, out_size, ws_size, (size_t)WS_END); grid = -1; return; }
        int dev = 0, cus = 0, per_cu = 0;
        if (hipGetDevice(&dev) != hipSuccess || hipDeviceGetAttribute(&cus, hipDeviceAttributeMultiprocessorCount, dev) != hipSuccess) { grid = -1; return; }
        if (hipFuncSetAttribute((const void*)trunk_fwd, hipFuncAttributeMaxDynamicSharedMemorySize, LDS_BYTES) != hipSuccess) { fprintf(stderr, "kernel_launch: hipFuncSetAttribute failed\n"); grid = -1; return; }
        if (hipOccupancyMaxActiveBlocksPerMultiprocessor(&per_cu, (const void*)trunk_fwd, 512, LDS_BYTES) != hipSuccess || per_cu < 1) fprintf(stderr, "kernel_launch: occupancy query reports %d\n", per_cu);
        (void)hipGetLastError();
        grid = cus;
    }
    if (grid < 0) return;
    (void)hipMemsetAsync((char*)d_ws + WS_CTL, 0, CTL_BYTES, stream);
    Args a{};
    for (int i = 0; i < 29; ++i) a.in[i] = (const float*)d_in[i];
    a.out = (float*)d_out; a.ws = (unsigned char*)d_ws; a.pad = 0;
#if MK_SPLIT
    for (int p = 0; p < PH_TOTAL; ++p) { a.ph_lo = p; a.ph_hi = p + 1; a.li = p; hipLaunchKernelGGL(trunk_fwd, dim3(grid), dim3(512), LDS_BYTES, stream, a); }
#else
    a.ph_lo = 0; a.ph_hi = PH_TOTAL; a.li = 0;
    hipLaunchKernelGGL(trunk_fwd, dim3(grid), dim3(512), LDS_BYTES, stream, a);
#endif
}
```

```cpp
#include <hip/hip_runtime.h>
#include <cstdio>
#include <cstdint>

#define LAS __attribute__((address_space(3)))
#define GAS __attribute__((address_space(1)))
typedef unsigned short bf16;
typedef short bf16x8 __attribute__((ext_vector_type(8)));
typedef float f32x4 __attribute__((ext_vector_type(4)));
typedef float f32x2 __attribute__((ext_vector_type(2)));
typedef unsigned u32x4 __attribute__((ext_vector_type(4)));
typedef unsigned u32x2 __attribute__((ext_vector_type(2)));
#define DI __device__ __forceinline__

#ifndef PHMASK
#define PHMASK 0xFFFFFFFFu
#endif
#ifndef SUBMASK
#define SUBMASK 0xFFFFFFFFu
#endif
#define SM(b) ((SUBMASK >> (b)) & 1u)
#ifndef REPMASK
#define REPMASK 0u
#endif
#ifndef SUBREP
#define SUBREP 0u
#endif
#define REP(k) ((int)((REPMASK >> (k)) & 1u))
#define SREP(k) ((int)((SUBREP >> (k)) & 1u))
#ifndef MK_SPLIT
#define MK_SPLIT 0
#endif

constexpr int D = 1024, NB = 8, SEQ = 2048, MP = NB * SEQ, MS = 128, MT = MP + MS, MTP = MP + 256, DEPTH = 4;
constexpr int NPROJ = 9216, INW = 9224;
constexpr int C_Q = 0, C_K = 1024, C_V = 2048, C_O = 3072, C_U = 4096, C_XQ = 5120, C_G = 6144;
constexpr int FF = 2816, FF2 = 5632, NMEM = 256, HD = 256, NH = 4;
constexpr float LN_EPS = 1e-5f;
constexpr float ALPHA = 1.681792830507429f;
constexpr int PAST_LEN = 16384;

constexpr size_t O_YP = 0, O_YS = 16777216, O_PC = 16908288, O_PN = 25296896, O_PM = 25329664, O_PPOOL = 25329792, O_PCONV = 25821312,
                 O_PMK = 26181760, O_PMV = 34570368, O_SC = 42958976, O_SN = 177176704, O_SM = 177700992, O_SPOOL = 177703040, O_SCONV = 185567360, O_END = 191334528;

constexpr size_t al256(size_t x) { return (x + 255) & ~(size_t)255; }
constexpr size_t WS_CTL = 0, CTL_BYTES = 2u << 20;
constexpr size_t WS_WIN = CTL_BYTES;                                        constexpr size_t SZ_WIN = (size_t)NPROJ * D * 2;
constexpr size_t WS_WM = WS_WIN + DEPTH * SZ_WIN;                           constexpr size_t SZ_W1K = (size_t)D * D * 2;
constexpr size_t WS_WX = WS_WM + DEPTH * SZ_W1K;
constexpr size_t WS_WO = WS_WX + DEPTH * SZ_W1K;
constexpr size_t WS_WP = WS_WO + DEPTH * SZ_W1K;                            constexpr size_t SZ_WP = (size_t)4 * 256 * 256 * 2;
constexpr size_t WS_WKV = WS_WP + DEPTH * SZ_WP;                            constexpr size_t SZ_WKV = (size_t)2048 * D * 2;
constexpr size_t WS_WUP = WS_WKV + DEPTH * SZ_WKV;                          constexpr size_t SZ_WUP = (size_t)FF2 * D * 2;
constexpr size_t WS_WDN = WS_WUP + DEPTH * SZ_WUP;                          constexpr size_t SZ_WDN = (size_t)D * FF * 2;
constexpr size_t WS_X = al256(WS_WDN + DEPTH * SZ_WDN);
constexpr size_t WS_T = WS_X + (size_t)MTP * D * 4;
constexpr size_t WS_MIX = WS_T + (size_t)MTP * D * 4;
constexpr size_t WS_XN = WS_MIX + (size_t)MTP * D * 4;
constexpr size_t WS_PROJ = WS_XN + (size_t)MTP * D * 2;
constexpr size_t WS_HC = WS_PROJ + (size_t)MTP * NPROJ * 2;
constexpr size_t WS_HN = WS_HC + (size_t)MTP * D * 2;
constexpr size_t WS_DP = WS_HN + (size_t)MTP * D * 2;
constexpr size_t WS_PB = WS_DP + (size_t)MTP * D * 2;
constexpr size_t WS_OX = WS_PB + (size_t)MTP * D * 2;
constexpr size_t WS_MIXB = WS_OX + (size_t)MTP * D * 2;
constexpr size_t WS_HUP = WS_MIXB + (size_t)MTP * D * 2;
constexpr size_t WS_ACT = WS_HUP + (size_t)MTP * FF2 * 2;
constexpr size_t WS_IGFG = WS_ACT + (size_t)MTP * FF * 2;
constexpr size_t WS_MEMB = WS_IGFG + (size_t)MTP * 8 * 4;
constexpr size_t WS_MK = WS_MEMB + (size_t)2048 * D * 2;
constexpr size_t WS_MVT = WS_MK + (size_t)DEPTH * 2048 * D * 2;
constexpr size_t WS_PT = WS_MVT + (size_t)DEPTH * 2048 * D * 2;
constexpr size_t WS_KWT = WS_PT + (size_t)32 * 32 * 4096 * 2;
constexpr size_t WS_VTT = WS_KWT + (size_t)32 * 32 * 16384 * 2;
constexpr size_t WS_GT = WS_VTT + (size_t)32 * 32 * 16384 * 2;
constexpr size_t WS_XQ = WS_GT + (size_t)32 * 32 * 192 * 4;
constexpr size_t WS_END = WS_XQ + (size_t)MTP * D * 2;
static_assert(WS_END <= 2147483648ull, "workspace map exceeds 2 GiB");
constexpr int CW_BAR = 4096;

constexpr int LDS_BYTES = 147456;
constexpr int XCH_OFF = 131072;
constexpr int MISC_OFF = LDS_BYTES - 256;

DI float bf2f(unsigned v) { return __uint_as_float(v << 16); }
DI unsigned f2bf(float f) { unsigned u = __float_as_uint(f); return (u + 0x7fffu + ((u >> 16) & 1u)) >> 16; }
DI unsigned pk2(float lo, float hi) { return f2bf(lo) | (f2bf(hi) << 16); }
DI float lo16(unsigned w) { return __uint_as_float(w << 16); }
DI float hi16(unsigned w) { return __uint_as_float(w & 0xffff0000u); }
DI float sigmoid_fast(float x) { return __builtin_amdgcn_rcpf(1.0f + __expf(-x)); }
DI float wave_sum(float v) {
#pragma unroll
    for (int o = 1; o < 64; o <<= 1) v += __shfl_xor(v, o);
    return v;
}
DI void unpack8(const u32x4 w, float (&f)[8]) { f[0] = lo16(w.x); f[1] = hi16(w.x); f[2] = lo16(w.y); f[3] = hi16(w.y); f[4] = lo16(w.z); f[5] = hi16(w.z); f[6] = lo16(w.w); f[7] = hi16(w.w); }
DI int opaque_tid() { int t = threadIdx.x; asm volatile("" : "+v"(t)); return t; }
#define LDS_WAIT() asm volatile("s_waitcnt lgkmcnt(0)" ::: "memory")
#define VM_WAIT() asm volatile("s_waitcnt vmcnt(0)" ::: "memory")

namespace pg8 {
constexpr int BM = 256, BK = 64, HALF = 128, HTB = HALF * BK * 2, STAGE_BYTES = 8 * HTB, NXCD = 8, WGM = 8;
__host__ __device__ __forceinline__ int lds_byte(int r, int c) { const int st = (r >> 4) * 2 + (c >> 5), rr = r & 15, cc = c & 31, ob = rr * 64 + cc * 2; return st * 1024 + (ob ^ (((ob >> 9) & 1) << 5)); }
__host__ __device__ __forceinline__ void stage_rc(int b, int& R, int& C) { const int st = b / 1024, sb = b % 1024, swz = sb ^ (((sb >> 9) & 1) << 5); R = (st >> 1) * 16 + swz / 64; C = (st & 1) * 32 + (swz % 64) / 2; }

struct Unit { const char* a; const char* b; int pm, pn; };

struct OrderMN {
    int nM, nN, nwg, G, c; const char* A; const char* Bt; size_t astep, bstep, apn;
    DI void init(const bf16* A_, int lda, const bf16* Bt_, int ldb, int M, int N, int G_, int c_, int apn_ = 0) { nM = M / BM; nN = N / BM; nwg = nM * nN; G = G_; c = c_; A = (const char*)A_; Bt = (const char*)Bt_; astep = (size_t)BM * lda * 2; bstep = (size_t)BM * ldb * 2; apn = (size_t)apn_; }
    DI bool next(int i, Unit& u) const {
        const long L = (long)i * G + c; if (L >= nwg) return false;
        int wgid = (int)L; { const int q = nwg / NXCD, r = nwg % NXCD, xcd = wgid % NXCD, off = wgid / NXCD; wgid = (xcd < r ? xcd * (q + 1) : r * (q + 1) + (xcd - r) * q) + off; }
        const int nig = WGM * nN, gid = wgid / nig, fm = gid * WGM, gsz = (nM - fm) < WGM ? (nM - fm) : WGM;
        u.pm = fm + ((wgid % nig) % gsz); u.pn = (wgid % nig) / gsz; u.a = A + (size_t)u.pm * astep + (size_t)u.pn * apn; u.b = Bt + (size_t)u.pn * bstep; return true;
    }
};

template <class Epi, class Sched>
DI void gemm_phase(LAS unsigned char* lds, const int K, const int lda, const int ldb, const Sched& S, const Epi& E) {
    const int tid = opaque_tid(), wid = __builtin_amdgcn_readfirstlane(tid >> 6), lane = tid & 63, wr = wid >> 2, wc = wid & 3, fr = lane & 15, fq = lane >> 4;
    const int nt = K / BK;
    unsigned voffA[2], voffB[2];
#pragma unroll
    for (int i = 0; i < 2; ++i) { int R, C; stage_rc(tid * 16 + i * 8192, R, C); voffA[i] = (unsigned)(R * lda + C) * 2u; voffB[i] = (unsigned)(R * ldb + C) * 2u; }
    const size_t kstep = (size_t)(BK * 2);
    const size_t hstepA = (size_t)HALF * lda * 2, hstepB = (size_t)HALF * ldb * 2;
    const unsigned ldsw = (unsigned)wid * 1024u;
    const int aoff = lds_byte(wr * 64 + fr, fq * 8), boff = lds_byte(wc * 32 + fr, fq * 8);
#define PG8_SA(b, h) (((b) * 2 + (h)) * HTB)
#define PG8_SB(b, h) ((4 + (b) * 2 + (h)) * HTB)
#define PG8_STAGE(bufoff, gbase, voff) do { _Pragma("unroll") for (int _i = 0; _i < 2; ++_i) \
        __builtin_amdgcn_global_load_lds((const unsigned*)((const char*)(gbase) + (voff)[_i]), (LAS unsigned*)(lds + (bufoff) + ldsw + _i * 8192), 16, 0, 0); } while (0)
#define PG8_LDA(dst, b, h) do { _Pragma("unroll") for (int m = 0; m < 4; ++m) _Pragma("unroll") for (int k = 0; k < 2; ++k) dst[m][k] = *(const LAS bf16x8*)(lds + PG8_SA(b, h) + aoff + m * 2048 + k * 1024); } while (0)
#define PG8_LDB(dst, b, h) do { _Pragma("unroll") for (int n = 0; n < 2; ++n) _Pragma("unroll") for (int k = 0; k < 2; ++k) dst[n][k] = *(const LAS bf16x8*)(lds + PG8_SB(b, h) + boff + n * 2048 + k * 1024); } while (0)
#define PG8_MMA(ai, bj, At, Bt) do { __builtin_amdgcn_s_setprio(1); _Pragma("unroll") for (int m = 0; m < 4; ++m) _Pragma("unroll") for (int n = 0; n < 2; ++n) _Pragma("unroll") for (int k = 0; k < 2; ++k) \
        acc[ai][bj][m][n] = __builtin_amdgcn_mfma_f32_16x16x32_bf16(Bt[n][k], At[m][k], acc[ai][bj][m][n], 0, 0, 0); __builtin_amdgcn_s_setprio(0); } while (0)
#define PG8_WAIT_V(n) asm volatile("s_waitcnt vmcnt(" #n ")" ::: "memory")
#define PG8_WAIT_L(n) asm volatile("s_waitcnt lgkmcnt(" #n ")" ::: "memory")
#define PG8_BAR __builtin_amdgcn_s_barrier()
#define PG8_SCHED __builtin_amdgcn_sched_barrier(0)
    Unit cur, nxt; int ui = 0;
    if (!S.next(0, cur)) return;
    f32x4 acc[2][2][4][2];
#pragma unroll
    for (int a = 0; a < 2; ++a)
#pragma unroll
        for (int b = 0; b < 2; ++b)
#pragma unroll
            for (int m = 0; m < 4; ++m)
#pragma unroll
                for (int n = 0; n < 2; ++n) acc[a][b][m][n] = (f32x4){0.f, 0.f, 0.f, 0.f};
    bf16x8 At[4][2], B0[2][2], B1[2][2];
    const char* cA = cur.a; const char* cB = cur.b;
    PG8_STAGE(PG8_SB(0, 0), cB, voffB); PG8_STAGE(PG8_SB(0, 1), cB + hstepB, voffB); PG8_STAGE(PG8_SA(0, 0), cA, voffA); PG8_STAGE(PG8_SA(0, 1), cA + hstepA, voffA);
    if (wr == 1) PG8_BAR;
    PG8_WAIT_V(2); PG8_BAR;
    PG8_STAGE(PG8_SB(1, 0), cB + kstep, voffB); PG8_STAGE(PG8_SA(1, 0), cA + kstep, voffA); PG8_STAGE(PG8_SB(1, 1), cB + hstepB + kstep, voffB);
    PG8_WAIT_V(6); PG8_BAR;
    for (;;) {
        const bool has_next = S.next(ui + 1, nxt);
        const char* nA = has_next ? nxt.a : cA; const char* nB = has_next ? nxt.b : cB;
#pragma unroll 1
        for (int t = 0; t < nt; t += 2) {
            const bool last = (t == nt - 2);
            const char* a1 = cA + (size_t)(t + 1) * kstep;
            const char* a2 = last ? nA : cA + (size_t)(t + 2) * kstep; const char* b2 = last ? nB : cB + (size_t)(t + 2) * kstep;
            const char* a3 = a2 + kstep; const char* b3 = b2 + kstep;
            PG8_LDB(B0, 0, 0); PG8_LDB(B1, 0, 1); PG8_SCHED; PG8_LDA(At, 0, 0); PG8_STAGE(PG8_SA(1, 1), a1 + hstepA, voffA);
            PG8_WAIT_V(8); PG8_WAIT_L(0); PG8_BAR; PG8_MMA(0, 0, At, B0); PG8_MMA(0, 1, At, B1); PG8_BAR; PG8_SCHED;
            PG8_LDA(At, 0, 1); PG8_STAGE(PG8_SB(0, 0), b2, voffB); PG8_STAGE(PG8_SB(0, 1), b2 + hstepB, voffB); PG8_STAGE(PG8_SA(0, 0), a2, voffA);
            PG8_WAIT_V(8); PG8_WAIT_L(0); PG8_BAR; PG8_MMA(1, 0, At, B0); PG8_MMA(1, 1, At, B1); PG8_BAR; PG8_SCHED;
            PG8_LDB(B0, 1, 0); PG8_LDB(B1, 1, 1); PG8_SCHED; PG8_LDA(At, 1, 0); PG8_STAGE(PG8_SA(0, 1), a2 + hstepA, voffA);
            PG8_WAIT_V(8); PG8_WAIT_L(0); PG8_BAR; PG8_MMA(0, 0, At, B0); PG8_MMA(0, 1, At, B1); PG8_BAR; PG8_SCHED;
            PG8_LDA(At, 1, 1); PG8_STAGE(PG8_SB(1, 0), b3, voffB); PG8_STAGE(PG8_SB(1, 1), b3 + hstepB, voffB); PG8_STAGE(PG8_SA(1, 0), a3, voffA);
            PG8_WAIT_V(8); PG8_WAIT_L(0); PG8_BAR; PG8_MMA(1, 0, At, B0); PG8_MMA(1, 1, At, B1); PG8_BAR; PG8_SCHED;
        }
        if (wr == 0) PG8_BAR;
        E(acc, cur, wr, wc, fr, fq);
        if (!has_next) break;
#pragma unroll
        for (int a = 0; a < 2; ++a)
#pragma unroll
            for (int b = 0; b < 2; ++b)
#pragma unroll
                for (int m = 0; m < 4; ++m)
#pragma unroll
                    for (int n = 0; n < 2; ++n) acc[a][b][m][n] = (f32x4){0.f, 0.f, 0.f, 0.f};
        cur = nxt; cA = nA; cB = nB; ++ui;
        if (wr == 1) PG8_BAR;
    }
    PG8_WAIT_V(0);
    PG8_BAR;
#undef PG8_SA
#undef PG8_SB
#undef PG8_STAGE
#undef PG8_LDA
#undef PG8_LDB
#undef PG8_MMA
#undef PG8_WAIT_V
#undef PG8_WAIT_L
#undef PG8_BAR
#undef PG8_SCHED
}

template <class GE> struct EpiGran {
    GE g;
    DI void operator()(f32x4 (&acc)[2][2][4][2], const Unit& u, int wr, int wc, int fr, int fq) const {
        const int row0 = u.pm * BM + wr * 64 + fr, col0 = u.pn * BM + wc * 32 + 4 * fq;
#pragma unroll
        for (int ai = 0; ai < 2; ++ai)
#pragma unroll
            for (int m = 0; m < 4; ++m)
#pragma unroll
                for (int bj = 0; bj < 2; ++bj)
#pragma unroll
                    for (int n = 0; n < 2; ++n) g(row0 + ai * HALF + m * 16, col0 + bj * HALF + n * 16, acc[ai][bj][m][n]);
    }
};
}

#define XB_TMO      128
#define XB_XCNT(j)  (256  + 64 * (j))
#define XB_XSUB(j)  (1280 + 64 * (j))
#define XB_XGEN(j)  (2304 + 64 * (j))
#define XB_TOP      3328
#define XB_TOPGEN   3392
#define XCD_BAR_WORDS 3456
#define XB_SPIN_CAP (1u << 22)
DI unsigned xb_ld(unsigned* p)              { return __hip_atomic_load(p, __ATOMIC_RELAXED, __HIP_MEMORY_SCOPE_AGENT); }
DI unsigned xb_add(unsigned* p, unsigned v) { return __hip_atomic_fetch_add(p, v, __ATOMIC_RELAXED, __HIP_MEMORY_SCOPE_AGENT); }
DI unsigned xb_xcc_id() { return (unsigned)__builtin_amdgcn_s_getreg((3 << 11) | 20) & 0xFu; }
#define XB_SPIN(cond, bar) do { unsigned _sp = 0; while (cond) { __builtin_amdgcn_s_sleep(1); \
    if ((++_sp & 255u) == 0u) { if (xb_ld(&(bar)[XB_TMO])) break; if (_sp > XB_SPIN_CAP) { atomicAdd(&(bar)[XB_TMO], 1u); break; } } } } while (0)
struct XcdBarrier { unsigned* bar; unsigned x; volatile LAS unsigned* st; };
DI XcdBarrier xcd_barrier_post(unsigned* bar, volatile LAS unsigned* st) {
    XcdBarrier b; b.bar = bar; b.x = xb_xcc_id(); b.st = st;
    if (threadIdx.x == 0) (void)xb_add(&bar[XB_XCNT(b.x)], 1u);
    return b;
}
DI void xcd_barrier_complete(unsigned* bar, unsigned x, unsigned& nloc, unsigned& nx) {
    const unsigned G = gridDim.x * gridDim.y * gridDim.z;
    unsigned sum, cnt, mine, sp = 0u;
    for (;;) {
        sum = 0u; cnt = 0u; mine = 0u;
#pragma unroll
        for (unsigned j = 0; j < 16; ++j) { const unsigned c = xb_ld(&bar[XB_XCNT(j)]); sum += c; cnt += (c > 0u) ? 1u : 0u; mine = (j == x) ? c : mine; }
        if (sum == G) break;
        __builtin_amdgcn_s_sleep(1);
        if ((++sp & 255u) == 0u) { if (xb_ld(&bar[XB_TMO])) break; if (sp > XB_SPIN_CAP) { atomicAdd(&bar[XB_TMO], 1u); break; } }
    }
    nloc = mine > 0u ? mine : 1u; nx = cnt > 0u ? cnt : 1u;
}
DI void xcd_barrier(const XcdBarrier& b) {
    asm volatile("s_waitcnt vmcnt(0)" ::: "memory");
    __syncthreads();
    if (threadIdx.x == 0) {
        unsigned* bar = b.bar;
        __builtin_amdgcn_s_waitcnt(0);
        unsigned nloc = b.st[0], nx = b.st[1];
        if (nloc == 0u) { xcd_barrier_complete(bar, b.x, nloc, nx); b.st[0] = nloc; b.st[1] = nx; }
        const unsigned old = xb_add(&bar[XB_XSUB(b.x)], 1u);
        const unsigned gen = old / nloc;
        if (old + 1u == (gen + 1u) * nloc) {
            __builtin_amdgcn_fence(__ATOMIC_RELEASE, "agent");
            asm volatile("s_waitcnt vmcnt(0)" ::: "memory");
            const unsigned og = xb_add(&bar[XB_TOP], 1u);
            const unsigned tg = og / nx;
            if (og + 1u == (tg + 1u) * nx) xb_add(&bar[XB_TOPGEN], 1u);
            else XB_SPIN(xb_ld(&bar[XB_TOPGEN]) == tg, bar);
            __builtin_amdgcn_fence(__ATOMIC_ACQUIRE, "agent");
            xb_add(&bar[XB_XGEN(b.x)], 1u);
            asm volatile("s_waitcnt vmcnt(0)" ::: "memory");
        } else {
            XB_SPIN(xb_ld(&bar[XB_XGEN(b.x)]) == gen, bar);
            __builtin_amdgcn_fence(__ATOMIC_ACQUIRE, "agent");
            asm volatile("s_waitcnt vmcnt(0)" ::: "memory");
        }
    }
    __syncthreads();
}

typedef const GAS float* fptr_t;
typedef const __attribute__((address_space(4))) fptr_t* in_tab_t;
struct Frame {
    LAS unsigned char* lds;
    int vcu, G;
    in_tab_t in; float* out; unsigned char* ws;
};
#define PHASE_BEGIN(F) Frame F = F0; int bx = bx0; { unsigned long long _a = (unsigned long long)F0.in, _b = (unsigned long long)F0.out, _c = (unsigned long long)F0.ws; int _g = F0.G, _v = F0.vcu; \
    asm volatile("" : "+s"(_a), "+s"(_b), "+s"(_c), "+s"(_g), "+s"(_v), "+s"(bx)); \
    F.in = (in_tab_t)_a; F.out = (float*)(GAS float*)_b; F.ws = (unsigned char*)(GAS unsigned char*)_c; F.G = _g; F.vcu = _v; }
#define WSP(T, off) ((T*)(F.ws + (off)))

struct GeIn {
    bf16* proj; const float* bias; bf16* xqb;
    DI void operator()(int row, int col, const f32x4& a) const {
        const int bc = col + (col >= 4096 ? 8 : 0);
        const f32x4 bv = *(const f32x4*)(bias + bc);
        f32x4 v = a + bv;
        const bool sg = (col >= C_O && col < C_U) || col >= C_G;
        if (sg) { v.x = sigmoid_fast(v.x); v.y = sigmoid_fast(v.y); v.z = sigmoid_fast(v.z); v.w = sigmoid_fast(v.w); }
        u32x2 w; w.x = pk2(v.x, v.y); w.y = pk2(v.z, v.w);
        if (col >= C_XQ && col < C_G) *(u32x2*)(xqb + (size_t)row * D + (col - C_XQ)) = w;
        else *(u32x2*)(proj + (size_t)row * NPROJ + col) = w;
    }
};
struct GeKV {
    float* out; bf16* mk; bf16* mvt;
    DI void operator()(int row, int col, const f32x4& a) const {
        const int l = col >> 11, c = col & 2047;
        if (c < 1024) {
            *(f32x4*)(out + O_PMK + ((size_t)l * 2048 + row) * 1024 + c) = a;
            u32x2 w; w.x = pk2(a.x, a.y); w.y = pk2(a.z, a.w);
            *(u32x2*)(mk + ((size_t)l * 2048 + row) * 1024 + c) = w;
        } else {
            const int cc = c - 1024;
            *(f32x4*)(out + O_PMV + ((size_t)l * 2048 + row) * 1024 + cc) = a;
            bf16* t = mvt + ((size_t)l * 1024 + cc) * 2048 + row;
            t[0] = (bf16)f2bf(a.x); t[2048] = (bf16)f2bf(a.y); t[4096] = (bf16)f2bf(a.z); t[6144] = (bf16)f2bf(a.w);
        }
    }
};
struct GeBf16 {
    bf16* o; int ldc;
    DI void operator()(int row, int col, const f32x4& a) const { u32x2 w; w.x = pk2(a.x, a.y); w.y = pk2(a.z, a.w); *(u32x2*)(o + (size_t)row * ldc + col) = w; }
};
template <int MODE> struct GeMix {
    float* mix; bf16* mixb; const bf16* proj; const float* ps;
    DI void operator()(int row, int col, const f32x4& a) const {
        const u32x2 gw = *(const u32x2*)(proj + (size_t)row * NPROJ + C_G + MODE * 1024 + col);
        const f32x4 g = (f32x4){lo16(gw.x), hi16(gw.x), lo16(gw.y), hi16(gw.y)};
        float* mp = mix + (size_t)row * D + col;
        if (MODE == 0) { *(f32x4*)mp = g * a; }
        else if (MODE == 1) { const f32x4 s = *(const f32x4*)(ps + col); *(f32x4*)mp = *(const f32x4*)mp + g * s * a; }
        else { const f32x4 v = *(const f32x4*)mp + g * a; u32x2 w; w.x = pk2(v.x, v.y); w.y = pk2(v.z, v.w); *(u32x2*)(mixb + (size_t)row * D + col) = w; }
    }
};
struct GeRes {
    const float* x; float* t;
    DI void operator()(int row, int col, const f32x4& a) const { const size_t o = (size_t)row * D + col; *(f32x4*)(t + o) = *(const f32x4*)(x + o) * ALPHA + a; }
};

struct EpiSoftmax {
    bf16* P; LAS float* X;
    DI void operator()(f32x4 (&acc)[2][2][4][2], const pg8::Unit& u, int wr, int wc, int fr, int fq) const {
        const float sc = 0.0625f * 1.4426950408889634f;
        LAS float* XM = X; LAS float* XS = X + 1024;
#pragma unroll
        for (int ai = 0; ai < 2; ++ai)
#pragma unroll
            for (int m = 0; m < 4; ++m) {
                float v = -3.0e38f;
#pragma unroll
                for (int bj = 0; bj < 2; ++bj)
#pragma unroll
                    for (int n = 0; n < 2; ++n) { const f32x4 x = acc[ai][bj][m][n]; v = fmaxf(v, fmaxf(fmaxf(x.x, x.y), fmaxf(x.z, x.w))); }
                v = fmaxf(v, __shfl_xor(v, 16)); v = fmaxf(v, __shfl_xor(v, 32));
                if (fq == 0) XM[(ai * 128 + wr * 64 + m * 16 + fr) * 4 + wc] = v;
            }
        LDS_WAIT(); __builtin_amdgcn_s_barrier(); asm volatile("" ::: "memory");
#pragma unroll
        for (int ai = 0; ai < 2; ++ai)
#pragma unroll
            for (int m = 0; m < 4; ++m) {
                const int r = ai * 128 + wr * 64 + m * 16 + fr;
                const f32x4 mm = *(const LAS f32x4*)(XM + r * 4);
                const float mx = fmaxf(fmaxf(mm.x, mm.y), fmaxf(mm.z, mm.w)) * sc;
                float s = 0.f;
#pragma unroll
                for (int bj = 0; bj < 2; ++bj)
#pragma unroll
                    for (int n = 0; n < 2; ++n) { f32x4 x = acc[ai][bj][m][n];
                        x.x = __builtin_amdgcn_exp2f(x.x * sc - mx); x.y = __builtin_amdgcn_exp2f(x.y * sc - mx); x.z = __builtin_amdgcn_exp2f(x.z * sc - mx); x.w = __builtin_amdgcn_exp2f(x.w * sc - mx);
                        acc[ai][bj][m][n] = x; s += (x.x + x.y) + (x.z + x.w); }
                s += __shfl_xor(s, 16); s += __shfl_xor(s, 32);
                if (fq == 0) XS[r * 4 + wc] = s;
                asm volatile("" ::: "memory");
            }
        LDS_WAIT(); __builtin_amdgcn_s_barrier(); asm volatile("" ::: "memory");
#pragma unroll
        for (int ai = 0; ai < 2; ++ai)
#pragma unroll
            for (int m = 0; m < 4; ++m) {
                const int r = ai * 128 + wr * 64 + m * 16 + fr;
                const f32x4 ss = *(const LAS f32x4*)(XS + r * 4);
                const float inv = 1.0f / ((ss.x + ss.y) + (ss.z + ss.w));
                bf16* rowp = P + (size_t)(u.pm * 256 + r) * D + u.pn * 256 + wc * 32 + 4 * fq;
#pragma unroll
                for (int bj = 0; bj < 2; ++bj)
#pragma unroll
                    for (int n = 0; n < 2; ++n) { const f32x4 x = acc[ai][bj][m][n] * inv; u32x2 w; w.x = pk2(x.x, x.y); w.y = pk2(x.z, x.w); *(u32x2*)(rowp + bj * 128 + n * 16) = w; }
                asm volatile("" ::: "memory");
            }
        LDS_WAIT(); __builtin_amdgcn_s_barrier(); asm volatile("" ::: "memory");
    }
};

template <size_t AROW, size_t AH, size_t BB, size_t BH>
struct OrderAttn {
    int G, c; const char* A; const char* Bt;
    DI bool next(int i, pg8::Unit& u) const {
        const long L = (long)i * G + c; if (L >= 256) return false;
        const int b = (int)L >> 5, h = ((int)L >> 3) & 3, rb = (int)L & 7;
        u.pm = b * 8 + rb; u.pn = h;
        u.a = A + (size_t)u.pm * 256 * AROW + (size_t)h * AH;
        u.b = Bt + (size_t)b * BB + (size_t)h * BH; return true;
    }
};

template <class GE>
DI void skinny_job(Frame& F, const bf16* A, int lda, const bf16* Bt, int ldb, int K, const GE& ge, int col_out) {
    const int tid = opaque_tid(), lane = tid & 63, wid = __builtin_amdgcn_readfirstlane(tid >> 6), fr = lane & 15, fq = lane >> 4, row = wid * 16 + fr;
    const bf16* ap = A + (size_t)row * lda + fq * 8;
    const bf16* b0 = Bt + (size_t)fr * ldb + fq * 8; const bf16* b1 = b0 + (size_t)16 * ldb;
    f32x4 acc0 = (f32x4){0.f, 0.f, 0.f, 0.f}, acc1 = acc0;
#pragma unroll 8
    for (int k0 = 0; k0 < K; k0 += 32) {
        const bf16x8 a = *(const bf16x8*)(ap + k0), x0 = *(const bf16x8*)(b0 + k0), x1 = *(const bf16x8*)(b1 + k0);
        acc0 = __builtin_amdgcn_mfma_f32_16x16x32_bf16(x0, a, acc0, 0, 0, 0);
        acc1 = __builtin_amdgcn_mfma_f32_16x16x32_bf16(x1, a, acc1, 0, 0, 0);
    }
    ge(MP + row, col_out + fq * 4, acc0); ge(MP + row, col_out + 16 + fq * 4, acc1);
}
template <class GE>
DI void skinny_gemm(Frame& F, const bf16* A, int lda, const bf16* Bt, int ldb, int N, int K, const GE& ge) {
    for (int job = F.vcu; job < N / 32; job += F.G) skinny_job(F, A, lda, Bt + (size_t)job * 32 * ldb, ldb, K, ge, job * 32);
}

DI void transpose_item(const float* W, int ldw, int K, bf16* WT, int k0, int n0src, int n0dst, LAS float* scr, int lane) {
#pragma unroll 16
    for (int k = 0; k < 64; ++k) scr[k * 65 + lane] = W[(size_t)(k0 + k) * ldw + n0src + lane];
    LDS_WAIT(); asm volatile("" ::: "memory");
    const int c = lane & 7;
#pragma unroll
    for (int j = 0; j < 8; ++j) { const int n = (lane >> 3) + 8 * j; const LAS float* sp = scr + (8 * c) * 65 + n;
        u32x4 o; o.x = pk2(sp[0 * 65], sp[1 * 65]); o.y = pk2(sp[2 * 65], sp[3 * 65]); o.z = pk2(sp[4 * 65], sp[5 * 65]); o.w = pk2(sp[6 * 65], sp[7 * 65]);
        *(u32x4*)(WT + (size_t)(n0dst + n) * K + k0 + 8 * c) = o; }
    LDS_WAIT(); asm volatile("" ::: "memory");
}
DI void mat_item(const float* W, int ldw, int K, int N, bf16* WT, int item, LAS float* scr, int lane, int shift_at) {
    const int nblk = N / 64, kb = item / nblk, nb = item % nblk, n0 = 64 * nb;
    transpose_item(W, ldw, K, WT, 64 * kb, n0 + (n0 >= shift_at ? 8 : 0), n0, scr, lane);
}
DI void phase_convert(Frame& F) {
    const int tid = opaque_tid(), lane = tid & 63, wid = __builtin_amdgcn_readfirstlane(tid >> 6);
    LAS float* scr = (LAS float*)(F.lds + wid * 16640);
    const int gw = F.vcu * 8 + wid, NGW = F.G * 8;
    constexpr int I_IN = 16 * 144, I_SQ = 16 * 16, I_KV = 16 * 32, I_UP = 16 * 88, I_DN = 44 * 16, I_P = 4 * 4;
    constexpr int PER_L = I_IN + 3 * I_SQ + I_KV + I_UP + I_DN + 4 * I_P;
    for (int it = gw; it < DEPTH * PER_L; it += NGW) {
        const int l = it / PER_L; int r = it % PER_L;
        if (r < I_IN) { mat_item(((const float*)F.in[12]) + (size_t)l * D * INW, INW, D, NPROJ, WSP(bf16, WS_WIN + l * SZ_WIN), r, scr, lane, 4096); continue; } r -= I_IN;
        if (r < I_SQ) { mat_item(((const float*)F.in[15]) + (size_t)l * D * D, D, D, D, WSP(bf16, WS_WM + l * SZ_W1K), r, scr, lane, 1 << 30); continue; } r -= I_SQ;
        if (r < I_SQ) { mat_item(((const float*)F.in[19]) + (size_t)l * D * D, D, D, D, WSP(bf16, WS_WX + l * SZ_W1K), r, scr, lane, 1 << 30); continue; } r -= I_SQ;
        if (r < I_SQ) { mat_item(((const float*)F.in[20]) + (size_t)l * D * D, D, D, D, WSP(bf16, WS_WO + l * SZ_W1K), r, scr, lane, 1 << 30); continue; } r -= I_SQ;
        if (r < I_KV) { mat_item(((const float*)F.in[18]) + (size_t)l * D * 2048, 2048, D, 2048, WSP(bf16, WS_WKV + l * SZ_WKV), r, scr, lane, 1 << 30); continue; } r -= I_KV;
        if (r < I_UP) { mat_item(((const float*)F.in[23]) + (size_t)l * D * FF2, FF2, D, FF2, WSP(bf16, WS_WUP + l * SZ_WUP), r, scr, lane, 1 << 30); continue; } r -= I_UP;
        if (r < I_DN) { mat_item(((const float*)F.in[26]) + (size_t)l * FF * D, D, FF, D, WSP(bf16, WS_WDN + l * SZ_WDN), r, scr, lane, 1 << 30); continue; } r -= I_DN;
        { const int g = r / I_P, ri = r % I_P; mat_item(((const float*)F.in[16]) + ((size_t)l * 4 + g) * 65536, 256, 256, 256, WSP(bf16, WS_WP + l * SZ_WP) + (size_t)g * 65536, ri, scr, lane, 1 << 30); }
    }
    { const float* mem = ((const float*)F.in[1]); bf16* mb = WSP(bf16, WS_MEMB);
      for (size_t i = ((size_t)F.vcu * 512 + tid) * 8; i < (size_t)2048 * D; i += (size_t)F.G * 512 * 8) {
          const f32x4 a = *(const f32x4*)(mem + i), b = *(const f32x4*)(mem + i + 4);
          u32x4 o; o.x = pk2(a.x, a.y); o.y = pk2(a.z, a.w); o.z = pk2(b.x, b.y); o.w = pk2(b.z, b.w); *(u32x4*)(mb + i) = o; } }
}

DI void stage_gate_w(Frame& F, int l) {
    LAS float* wg = (LAS float*)F.lds;
    const float* w = ((const float*)F.in[12]) + (size_t)l * D * INW + 4096;
    for (int i = opaque_tid(); i < 8192; i += 512) { const int k = i >> 3, j = i & 7; wg[j * 1024 + k] = w[(size_t)k * INW + j]; }
    __syncthreads();
}
DI void ln_row(Frame& F, const int lane, const float* src, const float* gam, const float* bet, int row, int lg, float* fin) {
    const f32x4* xr = (const f32x4*)src + lane;
    f32x4 v[4]; float s = 0.f;
#pragma unroll
    for (int j = 0; j < 4; ++j) { v[j] = xr[64 * j]; s += (v[j].x + v[j].y) + (v[j].z + v[j].w); }
    const float mean = wave_sum(s) * (1.f / D); float s2 = 0.f;
#pragma unroll
    for (int j = 0; j < 4; ++j) { v[j] = v[j] - mean; s2 += (v[j].x * v[j].x + v[j].y * v[j].y) + (v[j].z * v[j].z + v[j].w * v[j].w); }
    const float rstd = 1.f / sqrtf(wave_sum(s2) * (1.f / D) + LN_EPS);
    f32x4* xo = (f32x4*)(WSP(float, WS_X) + (size_t)row * D) + lane;
    u32x2* no = (u32x2*)(WSP(bf16, WS_XN) + (size_t)row * D) + lane;
#pragma unroll
    for (int j = 0; j < 4; ++j) {
        const f32x4 g = ((const f32x4*)gam)[lane + 64 * j], b = ((const f32x4*)bet)[lane + 64 * j];
        v[j] = v[j] * rstd * g + b;
        xo[64 * j] = v[j];
        u32x2 w; w.x = pk2(v[j].x, v[j].y); w.y = pk2(v[j].z, v[j].w); no[64 * j] = w;
        if (fin) ((f32x4*)fin)[lane + 64 * j] = v[j];
    }
    if (lg >= 0) {
        const LAS float* wg = (const LAS float*)F.lds;
        float a[8];
#pragma unroll
        for (int q = 0; q < 8; ++q) { float t = 0.f;
#pragma unroll
            for (int j = 0; j < 4; ++j) { const f32x4 w = *(const LAS f32x4*)(wg + q * 1024 + 4 * lane + 256 * j); t += (v[j].x * w.x + v[j].y * w.y) + (v[j].z * w.z + v[j].w * w.w); }
            a[q] = wave_sum(t); }
        if (lane == 0) { const float* bb = ((const float*)F.in[13]) + (size_t)lg * INW + 4096; float* o = WSP(float, WS_IGFG) + (size_t)row * 8;
#pragma unroll
            for (int q = 0; q < 8; ++q) o[q] = a[q] + bb[q]; }
    }
}
DI void phase_ln_in(Frame& F) {
    stage_gate_w(F, 0);
    const int tid = opaque_tid(), lane = tid & 63, wid = __builtin_amdgcn_readfirstlane(tid >> 6);
    const int gw = F.vcu * 8 + wid, NGW = F.G * 8;
    for (int r = gw; r < MT; r += NGW) {
        const float* src = r < MP ? ((const float*)F.in[0]) + (size_t)r * D : ((const float*)F.in[2]) + (size_t)(r - MP) * D;
        ln_row(F, lane, src, ((const float*)F.in[10]), ((const float*)F.in[11]), r, 0, nullptr);
    }
    __syncthreads();
}
DI void phase_ln(Frame& F, int l, int which) {
    const int lg = (which == 1 && l + 1 < DEPTH) ? l + 1 : -1;
    if (lg >= 0) stage_gate_w(F, lg);
    const float* gam = (const float*)(which ? F.in[27] : F.in[21]) + (size_t)l * D; const float* bet = (const float*)(which ? F.in[28] : F.in[22]) + (size_t)l * D;
    const bool last = (which == 1 && l == DEPTH - 1);
    const int tid = opaque_tid(), lane = tid & 63, wid = __builtin_amdgcn_readfirstlane(tid >> 6);
    const int gw = F.vcu * 8 + wid, NGW = F.G * 8;
    for (int r = gw; r < MT; r += NGW) {
        float* fin = last ? (r < MP ? F.out + O_YP + (size_t)r * D : F.out + O_YS + (size_t)(r - MP) * D) : nullptr;
        ln_row(F, lane, WSP(float, WS_T) + (size_t)r * D, gam, bet, r, lg, fin);
    }
    __syncthreads();
}

constexpr int MP_Q = 0, MP_K = 33792, MP_T2 = 67584, MP_VEC = 104448, MP_END = 104448 + 4 * 6 * 64 * 4;
static_assert(MP_END <= XCH_OFF, "mLSTM prep LDS map");
DI float log_sigmoid(float x) { return fminf(x, 0.f) - log1pf(expf(-fabsf(x))); }
#define DPP_F(oldv, src, ctrl, rmask, bc) __builtin_bit_cast(float, __builtin_amdgcn_update_dpp(__builtin_bit_cast(int, (float)(oldv)), __builtin_bit_cast(int, (float)(src)), ctrl, rmask, 0xf, bc))
DI float wave_scan_add(float v) {
    v += DPP_F(0.f, v, 0x111, 0xf, true); v += DPP_F(0.f, v, 0x112, 0xf, true); v += DPP_F(0.f, v, 0x114, 0xf, true); v += DPP_F(0.f, v, 0x118, 0xf, true);
    v += DPP_F(0.f, v, 0x142, 0xa, true); v += DPP_F(0.f, v, 0x143, 0xc, true); return v; }
DI float wave_scan_max(float v) {
    v = fmaxf(v, DPP_F(v, v, 0x111, 0xf, false)); v = fmaxf(v, DPP_F(v, v, 0x112, 0xf, false)); v = fmaxf(v, DPP_F(v, v, 0x114, 0xf, false)); v = fmaxf(v, DPP_F(v, v, 0x118, 0xf, false));
    v = fmaxf(v, DPP_F(v, v, 0x142, 0xa, false)); v = fmaxf(v, DPP_F(v, v, 0x143, 0xc, false)); return v; }
DI void mlstm_prep_job(Frame& F, int l, int job) {
    const int b = job >> 5, hh = (job >> 3) & 3, c4 = job & 7;
    const int tid = opaque_tid(), lane = tid & 63, wid = __builtin_amdgcn_readfirstlane(tid >> 6), fr = lane & 15, fq = lane >> 4;
    LAS unsigned char* L = F.lds;
    LAS float* vecs = (LAS float*)(L + MP_VEC);
    const bf16* projb = WSP(bf16, WS_PROJ) + (size_t)b * SEQ * NPROJ;
    const size_t bh = (size_t)(b * NH + hh);
    bf16* PTg = WSP(bf16, WS_PT) + bh * 32 * 4096; bf16* KWg = WSP(bf16, WS_KWT) + bh * 32 * 16384; bf16* VTg = WSP(bf16, WS_VTT) + bh * 32 * 16384;
    float* GTg = WSP(float, WS_GT) + bh * 32 * 192;
    if (wid == 0) {
        const float* igfg = WSP(float, WS_IGFG) + (size_t)b * SEQ * 8;
        float mprev = 0.f; const int nch = 4 * c4 + 4;
#pragma unroll 4
        for (int ch = 0; ch < nch; ++ch) {
            const float igv = igfg[(size_t)(ch * 64 + lane) * 8 + hh], fgv = igfg[(size_t)(ch * 64 + lane) * 8 + 4 + hh];
            const float lf = log_sigmoid(fgv);
            const float bb = wave_scan_add(lf);
            const float a = igv - bb; const float cm = wave_scan_max(a);
            const float mt = bb + fmaxf(mprev, cm);
            const float mL = __builtin_bit_cast(float, __builtin_amdgcn_readlane(__builtin_bit_cast(int, mt), 63)), bL = __builtin_bit_cast(float, __builtin_amdgcn_readlane(__builtin_bit_cast(int, bb), 63));
            if (ch >= 4 * c4) {
                const int ci = ch - 4 * c4;
                LAS float* v = vecs + ci * 384;
                v[lane] = a; v[64 + lane] = bb; v[128 + lane] = mt; v[192 + lane] = expf(a + bL - mL);
                float* g = GTg + (size_t)ch * 192;
                g[lane] = expf(mprev + bb - mt); g[64 + lane] = expf(-mt);
                if (lane == 0) g[128] = expf(mprev + bL - mL);
            }
            mprev = mL;
        }
        if (c4 == 7 && lane == 0) F.out[O_PM + (l * NB + b) * NH + hh] = mprev;
    }
    u32x4 q4[4], k4[4], v4[4];
#define MP_LOAD(c) do { const bf16* pr = projb + (size_t)((c) * 64 + lane) * NPROJ + hh * 256 + wid * 32; \
        _Pragma("unroll") for (int i = 0; i < 4; ++i) { q4[i] = *(const u32x4*)(pr + C_Q + i * 8); k4[i] = *(const u32x4*)(pr + C_K + i * 8); v4[i] = *(const u32x4*)(pr + C_V + i * 8); } } while (0)
    MP_LOAD(4 * c4);
    __syncthreads();
    for (int ci = 0; ci < 4; ++ci) {
        const int c = 4 * c4 + ci;
        const LAS float* vec = vecs + ci * 384;
#pragma unroll
        for (int i = 0; i < 4; ++i) { *(LAS u32x4*)(L + MP_Q + lane * 528 + (wid * 32 + i * 8) * 2) = q4[i]; *(LAS u32x4*)(L + MP_K + lane * 528 + (wid * 32 + i * 8) * 2) = k4[i]; }
        { const float w = vec[192 + lane] * 0.0625f;
#pragma unroll
          for (int i = 0; i < 4; ++i) { float kf[8]; unpack8(k4[i], kf);
#pragma unroll
            for (int j = 0; j < 8; ++j) ((LAS unsigned short*)(L + MP_T2))[(wid * 32 + i * 8 + j) * 72 + lane] = (unsigned short)f2bf(kf[j] * w); } }
        u32x4 vc4[4];
#pragma unroll
        for (int i = 0; i < 4; ++i) vc4[i] = v4[i];
        __syncthreads();
        if (ci + 1 < 4) MP_LOAD(c + 1);
        { const int tt = wid >> 1;
#pragma unroll
          for (int si = 0; si < 2; ++si) { const int st = (wid & 1) * 2 + si;
            f32x4 acc = (f32x4){0.f, 0.f, 0.f, 0.f};
            if (st <= tt) {
#pragma unroll
                for (int kk = 0; kk < 8; ++kk) { const bf16x8 kf = *(const LAS bf16x8*)(L + MP_K + (st * 16 + fr) * 528 + (kk * 32 + fq * 8) * 2), qf = *(const LAS bf16x8*)(L + MP_Q + (tt * 16 + fr) * 528 + (kk * 32 + fq * 8) * 2);
                    acc = __builtin_amdgcn_mfma_f32_16x16x32_bf16(kf, qf, acc, 0, 0, 0); }
            }
            const int t = tt * 16 + fr, s0 = st * 16 + fq * 4; const float bt = vec[64 + t] - vec[128 + t];
            float p[4];
#pragma unroll
            for (int j = 0; j < 4; ++j) { const int s = s0 + j; p[j] = (s <= t) ? acc[j] * 0.0625f * __expf(vec[s] + bt) : 0.f; }
            u32x2 w; w.x = pk2(p[0], p[1]); w.y = pk2(p[2], p[3]); *(u32x2*)(PTg + (size_t)c * 4096 + t * 64 + s0) = w; } }
        { const int d = tid >> 1, hf = tid & 1; bf16* o = KWg + (size_t)c * 16384 + d * 64 + hf * 32;
#pragma unroll
          for (int i = 0; i < 4; ++i) *(u32x4*)(o + i * 8) = *(const LAS u32x4*)(L + MP_T2 + d * 144 + hf * 64 + i * 16); }
        __syncthreads();
#pragma unroll
        for (int i = 0; i < 4; ++i) { const unsigned ww[4] = {vc4[i].x, vc4[i].y, vc4[i].z, vc4[i].w};
#pragma unroll
            for (int j = 0; j < 4; ++j) { ((LAS unsigned short*)(L + MP_T2))[(wid * 32 + i * 8 + 2 * j) * 72 + lane] = (unsigned short)(ww[j] & 0xffffu); ((LAS unsigned short*)(L + MP_T2))[(wid * 32 + i * 8 + 2 * j + 1) * 72 + lane] = (unsigned short)(ww[j] >> 16); } }
        __syncthreads();
        { const int d = tid >> 1, hf = tid & 1; bf16* o = VTg + (size_t)c * 16384 + d * 64 + hf * 32;
#pragma unroll
          for (int i = 0; i < 4; ++i) *(u32x4*)(o + i * 8) = *(const LAS u32x4*)(L + MP_T2 + d * 144 + hf * 64 + i * 16); }
        __syncthreads();
    }
#undef MP_LOAD
}

constexpr int MR_CT = 0, MR_NUM = 25344, MR_DEN = 33536, MR_END = 34048;
DI void mlstm_rec_job(Frame& F, int l, int job) {
    const int b = job >> 5, hh = (job >> 3) & 3, sl = job & 7;
    const int tid = opaque_tid(), lane = tid & 63, wid = __builtin_amdgcn_readfirstlane(tid >> 6), fr = lane & 15, fq = lane >> 4;
    const int tt = wid >> 1, et = wid & 1, t = tt * 16 + fr;
    LAS unsigned char* L = F.lds;
    const size_t bh = (size_t)(b * NH + hh);
    const bf16* qp = WSP(bf16, WS_PROJ) + ((size_t)b * SEQ + t) * NPROJ + C_Q + hh * 256 + fq * 8;
    const bf16* pp = WSP(bf16, WS_PT) + bh * 32 * 4096 + t * 64 + fq * 8;
    const bf16* kp = WSP(bf16, WS_KWT) + bh * 32 * 16384 + (wid * 32 + fr) * 64 + fq * 8;
    const bf16* vp = WSP(bf16, WS_VTT) + bh * 32 * 16384 + (sl * 32 + fr) * 64 + fq * 8;
    const float* gp = WSP(float, WS_GT) + bh * 32 * 192;
    const int ht = tid >> 3, he0 = (tid & 7) * 4;
    const bf16* sop = WSP(bf16, WS_PROJ) + ((size_t)b * SEQ + ht) * NPROJ + C_O + hh * 256 + sl * 32 + he0;
    bf16* hc = WSP(bf16, WS_HC) + ((size_t)b * SEQ + ht) * D + hh * 256 + sl * 32 + he0;
    for (int i = tid; i < 25344 / 4; i += 512) ((LAS unsigned*)(L + MR_CT))[i] = 0u;
    f32x4 cacc[2][3];
#pragma unroll
    for (int i = 0; i < 2; ++i)
#pragma unroll
        for (int j = 0; j < 3; ++j) cacc[i][j] = (f32x4){0.f, 0.f, 0.f, 0.f};
    bf16x8 ones; { const short o = (fr == 0) ? (short)0x3F80 : (short)0;
#pragma unroll
        for (int j = 0; j < 8; ++j) ones[j] = o; }
    bf16x8 qf[8], pf[2], kfA[2][2], vfA[2][2], kfB[2][2], vfB[2][2]; float interA, enmA, decA, interB, enmB, decB; u32x2 soA, soB;
#define MR_LOADQP(c) do { \
        _Pragma("unroll") for (int kk = 0; kk < 8; ++kk) qf[kk] = *(const bf16x8*)(qp + (size_t)(c) * 64 * NPROJ + kk * 32); \
        _Pragma("unroll") for (int ks = 0; ks < 2; ++ks) pf[ks] = *(const bf16x8*)(pp + (size_t)(c) * 4096 + ks * 32); } while (0)
#define MR_LOADKV(S, c) do { \
        _Pragma("unroll") for (int ks = 0; ks < 2; ++ks) { \
            _Pragma("unroll") for (int x = 0; x < 2; ++x) { kf##S[x][ks] = *(const bf16x8*)(kp + (size_t)(c) * 16384 + x * 1024 + ks * 32); vf##S[x][ks] = *(const bf16x8*)(vp + (size_t)(c) * 16384 + x * 1024 + ks * 32); } } \
        inter##S = gp[(c) * 192 + t]; enm##S = gp[(c) * 192 + 64 + ht]; dec##S = gp[(c) * 192 + 128]; so##S = *(const u32x2*)(sop + (size_t)(c) * 64 * NPROJ); } while (0)
#define MR_BODY(S, N, c) do { \
          \
        f32x4 aP = (f32x4){0.f, 0.f, 0.f, 0.f}, aC0 = aP, aC1 = aP, dP = aP, dC = aP; \
        bf16x8 cf[8], c2[4]; \
        _Pragma("unroll") for (int kk = 0; kk < 8; ++kk) cf[kk] = *(const LAS bf16x8*)(L + MR_CT + (et * 16 + fr) * 528 + (kk * 32 + fq * 8) * 2); \
        _Pragma("unroll") for (int kk = 0; kk < 4; ++kk) c2[kk] = *(const LAS bf16x8*)(L + MR_CT + (32 + fr) * 528 + ((et * 4 + kk) * 32 + fq * 8) * 2); \
        if (et == 0) { _Pragma("unroll") for (int ks = 0; ks < 2; ++ks) { aP = __builtin_amdgcn_mfma_f32_16x16x32_bf16(vf##S[0][ks], pf[ks], aP, 0, 0, 0); dP = __builtin_amdgcn_mfma_f32_16x16x32_bf16(ones, pf[ks], dP, 0, 0, 0); } \
            _Pragma("unroll") for (int kk = 0; kk < 4; ++kk) dC = __builtin_amdgcn_mfma_f32_16x16x32_bf16(c2[kk], qf[kk], dC, 0, 0, 0); } \
        else { _Pragma("unroll") for (int ks = 0; ks < 2; ++ks) aP = __builtin_amdgcn_mfma_f32_16x16x32_bf16(vf##S[1][ks], pf[ks], aP, 0, 0, 0); \
            _Pragma("unroll") for (int kk = 0; kk < 4; ++kk) dC = __builtin_amdgcn_mfma_f32_16x16x32_bf16(c2[kk], qf[4 + kk], dC, 0, 0, 0); } \
        _Pragma("unroll") for (int kk = 0; kk < 8; kk += 2) { aC0 = __builtin_amdgcn_mfma_f32_16x16x32_bf16(cf[kk], qf[kk], aC0, 0, 0, 0); aC1 = __builtin_amdgcn_mfma_f32_16x16x32_bf16(cf[kk + 1], qf[kk + 1], aC1, 0, 0, 0); } \
        __builtin_amdgcn_sched_barrier(0); \
        if ((c) + 1 < SEQ / 64) { MR_LOADQP((c) + 1); MR_LOADKV(N, (c) + 1); } \
        __builtin_amdgcn_sched_barrier(0); \
        *(LAS f32x4*)(L + MR_NUM + (t * 32 + et * 16 + fq * 4) * 4) = aP + (aC0 + aC1) * inter##S; \
        if (fq == 0) ((LAS float*)(L + MR_DEN))[t * 2 + et] = dP.x + dC.x * inter##S; \
        __syncthreads();                                                      \
          \
        { const f32x4 nm = *(const LAS f32x4*)(L + MR_NUM + (ht * 32 + he0) * 4); const float den = ((LAS float*)(L + MR_DEN))[ht * 2] + ((LAS float*)(L + MR_DEN))[ht * 2 + 1]; \
          const float inv = 1.0f / fmaxf(fabsf(den), enm##S); \
          u32x2 w; w.x = pk2(lo16(so##S.x) * nm.x * inv, hi16(so##S.x) * nm.y * inv); w.y = pk2(lo16(so##S.y) * nm.z * inv, hi16(so##S.y) * nm.w * inv); \
          *(u32x2*)(hc + (size_t)(c) * 64 * D) = w; } \
          \
        _Pragma("unroll") for (int di = 0; di < 2; ++di) { \
            _Pragma("unroll") for (int e3 = 0; e3 < 3; ++e3) { f32x4 a = cacc[di][e3] * dec##S; \
                _Pragma("unroll") for (int ks = 0; ks < 2; ++ks) a = __builtin_amdgcn_mfma_f32_16x16x32_bf16(kf##S[di][ks], e3 == 2 ? ones : vf##S[e3 & 1][ks], a, 0, 0, 0); \
                cacc[di][e3] = a; \
                u32x2 w; w.x = pk2(a.x, a.y); w.y = pk2(a.z, a.w); *(LAS u32x2*)(L + MR_CT + (e3 * 16 + fr) * 528 + ((wid * 2 + di) * 16 + fq * 4) * 2) = w; } } \
        __syncthreads();                                                      \
    } while (0)
    MR_LOADQP(0); MR_LOADKV(A, 0);
    __syncthreads();
#pragma unroll 1
    for (int c = 0; c < SEQ / 64; c += 2) { MR_BODY(A, B, c); MR_BODY(B, A, c + 1); }
#undef MR_BODY
#undef MR_LOADKV
#undef MR_LOADQP
    { float* pc = F.out + O_PC + ((size_t)((l * NB + b) * NH + hh)) * 65536;
#pragma unroll
      for (int di = 0; di < 2; ++di) { const int dt = wid * 2 + di;
#pragma unroll
        for (int e3 = 0; e3 < 2; ++e3)
#pragma unroll
            for (int j = 0; j < 4; ++j) pc[(size_t)(dt * 16 + fq * 4 + j) * 256 + sl * 32 + e3 * 16 + fr] = cacc[di][e3][j];
        if (sl == 0 && fr == 0) { float* pn = F.out + O_PN + ((size_t)((l * NB + b) * NH + hh)) * 256;
#pragma unroll
            for (int j = 0; j < 4; ++j) pn[dt * 16 + fq * 4 + j] = cacc[di][2][j]; } } }
    __syncthreads();
}

DI void mlstm_sample_job(Frame& F, int l, int job) {
    const int b = job >> 2, hh = job & 3; const int tid = opaque_tid(), lane = tid & 63, wid = __builtin_amdgcn_readfirstlane(tid >> 6);
    LAS float* qs = (LAS float*)F.lds;
    LAS float* kws = qs + 256; LAS float* red = qs + 512; LAS float* scal = qs + 512 + 2048;
    const bf16* prow = WSP(bf16, WS_PROJ) + (size_t)(MP + b) * NPROJ;
    const size_t sidx = (size_t)((l * MS + b) * NH + hh);
    const float* C = ((const float*)F.in[5]) + sidx * 65536; const float* nst = ((const float*)F.in[6]) + sidx * 256; float* Cn = F.out + O_SC + sidx * 65536;
    const float ig = WSP(float, WS_IGFG)[(size_t)(MP + b) * 8 + hh], fg = WSP(float, WS_IGFG)[(size_t)(MP + b) * 8 + 4 + hh];
    const float m0 = ((const float*)F.in[7])[sidx];
    const float lf = log_sigmoid(fg), mt = fmaxf(m0 + lf, ig), inter = expf(m0 + lf - mt), wsi = expf(ig - mt);
    if (tid < 256) {
        const float q = bf2f(prow[C_Q + hh * 256 + tid]), k = bf2f(prow[C_K + hh * 256 + tid]) * 0.0625f;
        qs[tid] = q; kws[tid] = k * wsi;
        const float n0 = nst[tid];
        F.out[O_SN + sidx * 256 + tid] = inter * n0 + k * wsi;
        float qk = q * k, qn = q * n0;
        qk = wave_sum(qk); qn = wave_sum(qn);
        if (lane == 0) { scal[wid * 2] = qk; scal[wid * 2 + 1] = qn; }
    }
    __syncthreads();
    const float qk = scal[0] + scal[2] + scal[4] + scal[6], qn = scal[1] + scal[3] + scal[5] + scal[7];
    const float s = qk * wsi, den = s + inter * qn, inv = 1.0f / fmaxf(fabsf(den), expf(-mt));
    const u32x2 vw = *(const u32x2*)(prow + C_V + hh * 256 + lane * 4);
    const f32x4 v4 = (f32x4){lo16(vw.x), hi16(vw.x), lo16(vw.y), hi16(vw.y)};
    f32x4 acc = (f32x4){0.f, 0.f, 0.f, 0.f};
#pragma unroll 8
    for (int i = 0; i < 32; ++i) { const int d = wid * 32 + i; const f32x4 c = *(const f32x4*)(C + (size_t)d * 256 + lane * 4);
        acc += c * qs[d]; *(f32x4*)(Cn + (size_t)d * 256 + lane * 4) = c * inter + v4 * kws[d]; }
    *(LAS f32x4*)(red + wid * 256 + lane * 4) = acc;
    __syncthreads();
    if (tid < 256) { float qc = 0.f;
#pragma unroll
        for (int w = 0; w < 8; ++w) qc += red[w * 256 + tid];
        const float v = bf2f(prow[C_V + hh * 256 + tid]), so = bf2f(prow[C_O + hh * 256 + tid]);
        const float h = (s * v + inter * qc) * inv;
        WSP(bf16, WS_HC)[(size_t)(MP + b) * D + hh * 256 + tid] = (bf16)f2bf(so * h); }
    if (tid == 0) F.out[O_SM + sidx] = mt;
    __syncthreads();
}

DI void xattn_sample_job(Frame& F, int l, int job) {
    const int b = job >> 1, hp = job & 1; const int tid = opaque_tid(), lane = tid & 63, wid = __builtin_amdgcn_readfirstlane(tid >> 6);
    LAS float* sc = (LAS float*)F.lds;
    const bf16* prow = WSP(bf16, WS_XQ) + (size_t)(MP + b) * D + hp * 512;
    const float* Kc = ((const float*)F.in[3]) + ((size_t)(l * MS + b) * NMEM) * 1024 + hp * 512;
    const float* Vc = ((const float*)F.in[4]) + ((size_t)(l * MS + b) * NMEM) * 1024 + hp * 512;
    float q[8]; { const u32x4 w = *(const u32x4*)(prow + lane * 8); unpack8(w, q); }
#pragma unroll 8
    for (int i = 0; i < 32; ++i) { const int m = wid + 8 * i; const f32x4 k0 = *(const f32x4*)(Kc + (size_t)m * 1024 + lane * 8), k1 = *(const f32x4*)(Kc + (size_t)m * 1024 + lane * 8 + 4);
        float t = (q[0] * k0.x + q[1] * k0.y) + (q[2] * k0.z + q[3] * k0.w) + (q[4] * k1.x + q[5] * k1.y) + (q[6] * k1.z + q[7] * k1.w);
#pragma unroll
        for (int o = 1; o < 32; o <<= 1) t += __shfl_xor(t, o);
        if ((lane & 31) == 0) sc[(lane >> 5) * 256 + m] = t * 0.0625f; }
    __syncthreads();
    if (wid < 2) { float x[4]; float mx = -3.0e38f;
#pragma unroll
        for (int j = 0; j < 4; ++j) { x[j] = sc[wid * 256 + lane + 64 * j]; mx = fmaxf(mx, x[j]); }
#pragma unroll
        for (int o = 1; o < 64; o <<= 1) mx = fmaxf(mx, __shfl_xor(mx, o));
        float s = 0.f;
#pragma unroll
        for (int j = 0; j < 4; ++j) { x[j] = expf(x[j] - mx); s += x[j]; }
        s = wave_sum(s); const float inv = 1.0f / s;
#pragma unroll
        for (int j = 0; j < 4; ++j) sc[wid * 256 + lane + 64 * j] = x[j] * inv; }
    __syncthreads();
    {
      const int kg = tid >> 7, c4 = (tid & 127) * 4, hsel = c4 >> 8; f32x4 acc = (f32x4){0.f, 0.f, 0.f, 0.f};
#pragma unroll 16
      for (int i = 0; i < 64; ++i) { const int m = kg * 64 + i; acc += *(const f32x4*)(Vc + (size_t)m * 1024 + c4) * sc[hsel * 256 + m]; }
      LAS f32x4* red = (LAS f32x4*)(sc + 512);
      red[kg * 128 + (tid & 127)] = acc;
      __syncthreads();
      if (tid < 128) { const f32x4 r = (red[tid] + red[128 + tid]) + (red[256 + tid] + red[384 + tid]);
          u32x2 w; w.x = pk2(r.x, r.y); w.y = pk2(r.z, r.w); *(u32x2*)(WSP(bf16, WS_OX) + (size_t)(MP + b) * D + hp * 512 + tid * 4) = w; } }
    __syncthreads();
}

DI void phase_pool_d(Frame& F, int l) {
    const bf16* proj = WSP(bf16, WS_PROJ); bf16* dp = WSP(bf16, WS_DP);
    const int gt = F.vcu * 512 + opaque_tid(), gs = F.G * 512;
    for (int it = gt; it < (MP / 16) * 128; it += gs) {
        const int rb = (int)(it >> 7), cg = (int)(it & 127), row0 = rb * 16, t0 = row0 & (SEQ - 1), b = row0 >> 11, w = 2 << (cg >> 5);
        const bf16* up = proj + (size_t)row0 * NPROJ + C_U + cg * 8;
        float sum[8];
#pragma unroll
        for (int j = 0; j < 8; ++j) sum[j] = 0.f;
        for (int i = 1; i < w; ++i) if (t0 - i >= 0) { float f[8]; unpack8(*(const u32x4*)(up - (size_t)i * NPROJ), f);
#pragma unroll
            for (int j = 0; j < 8; ++j) sum[j] += f[j]; }
#pragma unroll 4
        for (int r = 0; r < 16; ++r) {
            const int t = t0 + r; float u0[8]; unpack8(*(const u32x4*)(up + (size_t)r * NPROJ), u0);
#pragma unroll
            for (int j = 0; j < 8; ++j) sum[j] += u0[j];
            const int nw = (t + 1 < w) ? t + 1 : w; const float inv = 1.0f / (float)nw;
            u32x4 o; o.x = pk2(sum[0] * inv - u0[0], sum[1] * inv - u0[1]); o.y = pk2(sum[2] * inv - u0[2], sum[3] * inv - u0[3]); o.z = pk2(sum[4] * inv - u0[4], sum[5] * inv - u0[5]); o.w = pk2(sum[6] * inv - u0[6], sum[7] * inv - u0[7]);
            *(u32x4*)(dp + (size_t)(row0 + r) * D + cg * 8) = o;
            if (t >= SEQ - 15) { float* pp = F.out + O_PPOOL + ((size_t)(l * NB + b) * 15 + (t - (SEQ - 15))) * 1024 + cg * 8;
                *(f32x4*)pp = (f32x4){u0[0], u0[1], u0[2], u0[3]}; *(f32x4*)(pp + 4) = (f32x4){u0[4], u0[5], u0[6], u0[7]}; }
            if (t - (w - 1) >= 0) { float f[8]; unpack8(*(const u32x4*)(up + (size_t)(r - (w - 1)) * NPROJ), f);
#pragma unroll
                for (int j = 0; j < 8; ++j) sum[j] -= f[j]; }
        }
    }
    for (int it = gt; it < MS * 128; it += gs) {
        const int b = (int)(it >> 7), cg = (int)(it & 127), w = 2 << (cg >> 5);
        const float* sp = ((const float*)F.in[8]) + ((size_t)(l * MS + b) * 15) * 1024 + cg * 8;
        float u0[8], sum[8]; { const u32x4 x = *(const u32x4*)(proj + (size_t)(MP + b) * NPROJ + C_U + cg * 8); unpack8(x, u0); }
#pragma unroll
        for (int j = 0; j < 8; ++j) sum[j] = u0[j];
        for (int i = 1; i < w; ++i) { const f32x4 a = *(const f32x4*)(sp + (size_t)(15 - i) * 1024), c = *(const f32x4*)(sp + (size_t)(15 - i) * 1024 + 4);
            sum[0] += a.x; sum[1] += a.y; sum[2] += a.z; sum[3] += a.w; sum[4] += c.x; sum[5] += c.y; sum[6] += c.z; sum[7] += c.w; }
        const float inv = 1.0f / (float)w;
        u32x4 o; o.x = pk2(sum[0] * inv - u0[0], sum[1] * inv - u0[1]); o.y = pk2(sum[2] * inv - u0[2], sum[3] * inv - u0[3]); o.z = pk2(sum[4] * inv - u0[4], sum[5] * inv - u0[5]); o.w = pk2(sum[6] * inv - u0[6], sum[7] * inv - u0[7]);
        *(u32x4*)(dp + (size_t)(MP + b) * D + cg * 8) = o;
        float* so = F.out + O_SPOOL + ((size_t)(l * MS + b) * 15) * 1024 + cg * 8;
        for (int i = 0; i < 14; ++i) { *(f32x4*)(so + (size_t)i * 1024) = *(const f32x4*)(sp + (size_t)(i + 1) * 1024); *(f32x4*)(so + (size_t)i * 1024 + 4) = *(const f32x4*)(sp + (size_t)(i + 1) * 1024 + 4); }
        *(f32x4*)(so + (size_t)14 * 1024) = (f32x4){u0[0], u0[1], u0[2], u0[3]}; *(f32x4*)(so + (size_t)14 * 1024 + 4) = (f32x4){u0[4], u0[5], u0[6], u0[7]};
    }
}

DI void phase_headnorm(Frame& F, int l) {
    const bf16* hc = WSP(bf16, WS_HC); bf16* hn = WSP(bf16, WS_HN); const float* g = ((const float*)F.in[14]) + (size_t)l * D;
    const int tid = opaque_tid(), lane = tid & 63, wid = __builtin_amdgcn_readfirstlane(tid >> 6);
    const int gw = F.vcu * 8 + wid, NGW = F.G * 8;
    for (int it = gw; it < MT * 4; it += NGW) {
        const size_t off = (size_t)(it >> 2) * D + (it & 3) * 256 + lane * 4;
        const u32x2 w = *(const u32x2*)(hc + off);
        float x0 = lo16(w.x), x1 = hi16(w.x), x2 = lo16(w.y), x3 = hi16(w.y);
        const float mu = wave_sum((x0 + x1) + (x2 + x3)) * (1.f / 256.f);
        x0 -= mu; x1 -= mu; x2 -= mu; x3 -= mu;
        const float var = wave_sum((x0 * x0 + x1 * x1) + (x2 * x2 + x3 * x3)) * (1.f / 256.f);
        const float r = 1.f / sqrtf(var + LN_EPS);
        const f32x4 gg = *(const f32x4*)(g + (it & 3) * 256 + lane * 4);
        u32x2 o; o.x = pk2(x0 * r * gg.x, x1 * r * gg.y); o.y = pk2(x2 * r * gg.z, x3 * r * gg.w);
        *(u32x2*)(hn + off) = o;
    }
}

DI float gelu_tanh(float x) { return x * sigmoid_fast(1.5957691216057308f * (x + 0.044715f * x * x * x)); }
DI void conv8(const float (&h0)[8], const float (&h1)[8], const float (&h2)[8], const float* cw, const float* cb, int c, float (&o)[8]) {
    const f32x4 w0a = *(const f32x4*)(cw + c), w0b = *(const f32x4*)(cw + c + 4), w1a = *(const f32x4*)(cw + FF2 + c), w1b = *(const f32x4*)(cw + FF2 + c + 4), w2a = *(const f32x4*)(cw + 2 * FF2 + c), w2b = *(const f32x4*)(cw + 2 * FF2 + c + 4);
    const f32x4 ba = *(const f32x4*)(cb + c), bb = *(const f32x4*)(cb + c + 4);
    const float w0[8] = {w0a.x, w0a.y, w0a.z, w0a.w, w0b.x, w0b.y, w0b.z, w0b.w}, w1[8] = {w1a.x, w1a.y, w1a.z, w1a.w, w1b.x, w1b.y, w1b.z, w1b.w}, w2[8] = {w2a.x, w2a.y, w2a.z, w2a.w, w2b.x, w2b.y, w2b.z, w2b.w};
    const float bv[8] = {ba.x, ba.y, ba.z, ba.w, bb.x, bb.y, bb.z, bb.w};
#pragma unroll
    for (int j = 0; j < 8; ++j) o[j] = h0[j] * w0[j] + h1[j] * w1[j] + h2[j] * w2[j] + bv[j];
}
DI void ld8(const float* p, float (&o)[8]) { const f32x4 a = *(const f32x4*)p, b = *(const f32x4*)(p + 4); o[0] = a.x; o[1] = a.y; o[2] = a.z; o[3] = a.w; o[4] = b.x; o[5] = b.y; o[6] = b.z; o[7] = b.w; }
DI void phase_conv_act(Frame& F, int l) {
    const bf16* hup = WSP(bf16, WS_HUP); bf16* act = WSP(bf16, WS_ACT);
    const float* cw = ((const float*)F.in[24]) + (size_t)l * 3 * FF2; const float* cb = ((const float*)F.in[25]) + (size_t)l * FF2;
    const int gt = F.vcu * 512 + opaque_tid(), gs = F.G * 512;
    for (int it = gt; it < (MP / 8) * 352; it += gs) {
        const int rb = (int)(it / 352), cg = (int)(it % 352), row0 = rb * 8, t0 = row0 & (SEQ - 1), b = row0 >> 11;
        float wa[3][8], wb[3][8], ba[8], bb[8];
#pragma unroll
        for (int i = 0; i < 3; ++i) { ld8(cw + (size_t)i * FF2 + cg * 8, wa[i]); ld8(cw + (size_t)i * FF2 + FF + cg * 8, wb[i]); }
        ld8(cb + cg * 8, ba); ld8(cb + FF + cg * 8, bb);
        float a2[8], a1[8], b2[8], b1[8];
        if (t0 != 0) { const bf16* p = hup + (size_t)(row0 - 2) * FF2 + cg * 8; unpack8(*(const u32x4*)p, a2); unpack8(*(const u32x4*)(p + FF), b2); unpack8(*(const u32x4*)(p + FF2), a1); unpack8(*(const u32x4*)(p + FF2 + FF), b1); }
        else {
#pragma unroll
            for (int j = 0; j < 8; ++j) { a2[j] = 0.f; a1[j] = 0.f; b2[j] = 0.f; b1[j] = 0.f; } }
#pragma unroll
        for (int r = 0; r < 8; ++r) {
            const bf16* p = hup + (size_t)(row0 + r) * FF2 + cg * 8; float a0[8], b0[8]; unpack8(*(const u32x4*)p, a0); unpack8(*(const u32x4*)(p + FF), b0);
            float o[8];
#pragma unroll
            for (int j = 0; j < 8; ++j) { const float ca = a2[j] * wa[0][j] + a1[j] * wa[1][j] + a0[j] * wa[2][j] + ba[j], cbv = b2[j] * wb[0][j] + b1[j] * wb[1][j] + b0[j] * wb[2][j] + bb[j]; o[j] = gelu_tanh(ca) * cbv; }
            u32x4 w; w.x = pk2(o[0], o[1]); w.y = pk2(o[2], o[3]); w.z = pk2(o[4], o[5]); w.w = pk2(o[6], o[7]);
            *(u32x4*)(act + (size_t)(row0 + r) * FF + cg * 8) = w;
            if (t0 + r >= SEQ - 2) { float* pc = F.out + O_PCONV + ((size_t)(l * NB + b) * 2 + (t0 + r - (SEQ - 2))) * FF2 + cg * 8;
                *(f32x4*)pc = (f32x4){a0[0], a0[1], a0[2], a0[3]}; *(f32x4*)(pc + 4) = (f32x4){a0[4], a0[5], a0[6], a0[7]};
                *(f32x4*)(pc + FF) = (f32x4){b0[0], b0[1], b0[2], b0[3]}; *(f32x4*)(pc + FF + 4) = (f32x4){b0[4], b0[5], b0[6], b0[7]}; }
#pragma unroll
            for (int j = 0; j < 8; ++j) { a2[j] = a1[j]; a1[j] = a0[j]; b2[j] = b1[j]; b1[j] = b0[j]; }
        }
    }
    for (int it = gt; it < MS * 352; it += gs) {
        const int b = (int)(it / 352), cg = (int)(it % 352);
        const float* sc = ((const float*)F.in[9]) + ((size_t)(l * MS + b) * 2) * FF2 + cg * 8;
        float ha[3][8], hb[3][8];
#pragma unroll
        for (int i = 0; i < 2; ++i) { const f32x4 a0 = *(const f32x4*)(sc + (size_t)i * FF2), a1 = *(const f32x4*)(sc + (size_t)i * FF2 + 4), b0 = *(const f32x4*)(sc + (size_t)i * FF2 + FF), b1 = *(const f32x4*)(sc + (size_t)i * FF2 + FF + 4);
            ha[i][0] = a0.x; ha[i][1] = a0.y; ha[i][2] = a0.z; ha[i][3] = a0.w; ha[i][4] = a1.x; ha[i][5] = a1.y; ha[i][6] = a1.z; ha[i][7] = a1.w;
            hb[i][0] = b0.x; hb[i][1] = b0.y; hb[i][2] = b0.z; hb[i][3] = b0.w; hb[i][4] = b1.x; hb[i][5] = b1.y; hb[i][6] = b1.z; hb[i][7] = b1.w; }
        { const bf16* p = hup + (size_t)(MP + b) * FF2 + cg * 8; const u32x4 xa = *(const u32x4*)p, xb = *(const u32x4*)(p + FF); unpack8(xa, ha[2]); unpack8(xb, hb[2]); }
        float ca[8], cbv[8]; conv8(ha[0], ha[1], ha[2], cw, cb, cg * 8, ca); conv8(hb[0], hb[1], hb[2], cw, cb, FF + cg * 8, cbv);
        u32x4 o; o.x = pk2(gelu_tanh(ca[0]) * cbv[0], gelu_tanh(ca[1]) * cbv[1]); o.y = pk2(gelu_tanh(ca[2]) * cbv[2], gelu_tanh(ca[3]) * cbv[3]);
        o.z = pk2(gelu_tanh(ca[4]) * cbv[4], gelu_tanh(ca[5]) * cbv[5]); o.w = pk2(gelu_tanh(ca[6]) * cbv[6], gelu_tanh(ca[7]) * cbv[7]);
        *(u32x4*)(act + (size_t)(MP + b) * FF + cg * 8) = o;
        float* so = F.out + O_SCONV + ((size_t)(l * MS + b) * 2) * FF2 + cg * 8;
#pragma unroll
        for (int i = 0; i < 2; ++i) { *(f32x4*)(so + (size_t)i * FF2) = (f32x4){ha[i + 1][0], ha[i + 1][1], ha[i + 1][2], ha[i + 1][3]}; *(f32x4*)(so + (size_t)i * FF2 + 4) = (f32x4){ha[i + 1][4], ha[i + 1][5], ha[i + 1][6], ha[i + 1][7]};
            *(f32x4*)(so + (size_t)i * FF2 + FF) = (f32x4){hb[i + 1][0], hb[i + 1][1], hb[i + 1][2], hb[i + 1][3]}; *(f32x4*)(so + (size_t)i * FF2 + FF + 4) = (f32x4){hb[i + 1][4], hb[i + 1][5], hb[i + 1][6], hb[i + 1][7]}; }
    }
}

constexpr int PH_PER_L = 11, PH_TOTAL = 2 + DEPTH * PH_PER_L;
struct Args { const float* in[29]; float* out; unsigned char* ws; int ph_lo, ph_hi, li, pad; };
__global__ void __launch_bounds__(512, 2) trunk_fwd(Args args) {
    extern __shared__ __attribute__((aligned(16))) unsigned char lds_raw[];
    Frame F0;
    F0.lds = (LAS unsigned char*)lds_raw;
    F0.G = gridDim.x; { const int bx = blockIdx.x; F0.vcu = (F0.G % 8 == 0) ? (bx % 8) * (F0.G / 8) + bx / 8 : bx; }
    F0.in = (in_tab_t)__builtin_amdgcn_kernarg_segment_ptr(); F0.out = args.out; F0.ws = args.ws;
    volatile LAS unsigned* MISC = (volatile LAS unsigned*)(F0.lds + MISC_OFF);
    if (threadIdx.x < 64) MISC[threadIdx.x] = 0u;
    __syncthreads();
    unsigned* ctl = (unsigned*)(args.ws + WS_CTL);
    XcdBarrier bar = xcd_barrier_post(ctl + CW_BAR + args.li * XCD_BAR_WORDS, MISC + 8);
    const int lo = args.ph_lo, hi = args.ph_hi;
#define IN(k) (lo <= (k) && (k) < hi)
#define PM(b) ((PHMASK >> (b)) & 1u)
#define SEAM(k) do { if (IN(k) && IN((k) + 1)) xcd_barrier(bar); } while (0)
    const int bx0 = (int)blockIdx.x;

    if (PM(0) && IN(0)) { PHASE_BEGIN(F); phase_convert(F); __syncthreads(); phase_ln_in(F); }
    SEAM(0);
    if (PM(1) && IN(1)) {
        PHASE_BEGIN(F);
        pg8::OrderMN S; S.init(WSP(bf16, WS_MEMB), D, WSP(bf16, WS_WKV), D, 2048, DEPTH * 2048, F.G, bx);
        pg8::EpiGran<GeKV> E{{F.out, WSP(bf16, WS_MK), WSP(bf16, WS_MVT)}};
        pg8::gemm_phase(F.lds, D, D, D, S, E);
    }
    SEAM(1);
    for (int l = 0; l < DEPTH; ++l) {
        const int p0 = 2 + l * PH_PER_L;
        _Pragma("unroll 1") for (int rep = 0; rep <= REP(0); ++rep) if (PM(2) && IN(p0 + 0)) { if (rep) xcd_barrier(bar);
            PHASE_BEGIN(F);
            const bf16* W = WSP(bf16, WS_WIN + l * SZ_WIN);
            pg8::OrderMN S; S.init(WSP(bf16, WS_XN), D, W, D, MP, NPROJ, F.G, bx);
            pg8::EpiGran<GeIn> E{{WSP(bf16, WS_PROJ), ((const float*)F.in[13]) + (size_t)l * INW, WSP(bf16, WS_XQ)}};
            pg8::gemm_phase(F.lds, D, D, D, S, E);
            skinny_gemm(F, WSP(bf16, WS_XN) + (size_t)MP * D, D, W, D, NPROJ, D, E.g);
        }
        SEAM(p0 + 0);
        _Pragma("unroll 1") for (int rep = 0; rep <= REP(1); ++rep) if (PM(3) && IN(p0 + 1)) { if (rep) xcd_barrier(bar);
            PHASE_BEGIN(F);
            _Pragma("unroll 1") for (int sr = 0; sr <= SREP(0); ++sr) if (SM(0)) for (int j = F.vcu; j < 256; j += F.G) mlstm_prep_job(F, l, j);
            _Pragma("unroll 1") for (int sr = 0; sr <= SREP(1); ++sr) if (SM(1)) {
                OrderAttn<(size_t)D * 2, (size_t)256 * 2, (size_t)256 * D * 2, (size_t)256 * 2> S{F.G, bx, (const char*)WSP(bf16, WS_XQ), (const char*)(WSP(bf16, WS_MK) + (size_t)l * 2048 * D)};
                EpiSoftmax E{WSP(bf16, WS_PB), (LAS float*)(F.lds + XCH_OFF)};
                pg8::gemm_phase(F.lds, 256, D, D, S, E);
            }
            _Pragma("unroll 1") for (int sr = 0; sr <= SREP(2); ++sr) if (SM(2)) for (int j = F.vcu; j < MS * NH; j += F.G) mlstm_sample_job(F, l, j);
            _Pragma("unroll 1") for (int sr = 0; sr <= SREP(3); ++sr) if (SM(3)) for (int j = F.vcu; j < MS * 2; j += F.G) xattn_sample_job(F, l, j);
            _Pragma("unroll 1") for (int sr = 0; sr <= SREP(4); ++sr) if (SM(4)) phase_pool_d(F, l);
        }
        SEAM(p0 + 1);
        _Pragma("unroll 1") for (int rep = 0; rep <= REP(2); ++rep) if (PM(4) && IN(p0 + 2)) { if (rep) xcd_barrier(bar);
            PHASE_BEGIN(F);
            _Pragma("unroll 1") for (int sr = 0; sr <= SREP(5); ++sr) if (SM(5)) for (int j = F.vcu; j < 256; j += F.G) mlstm_rec_job(F, l, j);
            OrderAttn<(size_t)D * 2, (size_t)256 * 2, (size_t)256 * 2, (size_t)256 * 2048 * 2> S{F.G, bx, (const char*)WSP(bf16, WS_PB), (const char*)(WSP(bf16, WS_MVT) + (size_t)l * 1024 * 2048)};
            pg8::EpiGran<GeBf16> E{{WSP(bf16, WS_OX), D}};
            pg8::gemm_phase(F.lds, 256, D, 2048, S, E);
        }
        SEAM(p0 + 2);
        _Pragma("unroll 1") for (int rep = 0; rep <= REP(3); ++rep) if (PM(5) && IN(p0 + 3)) { if (rep) xcd_barrier(bar); PHASE_BEGIN(F); phase_headnorm(F, l); }
        SEAM(p0 + 3);
        _Pragma("unroll 1") for (int rep = 0; rep <= REP(4); ++rep) if (PM(6) && IN(p0 + 4)) { if (rep) xcd_barrier(bar);
            PHASE_BEGIN(F);
            const bf16* proj = WSP(bf16, WS_PROJ); float* mix = WSP(float, WS_MIX); bf16* mixb = WSP(bf16, WS_MIXB); const float* ps = ((const float*)F.in[17]) + (size_t)l * D;
            { const bf16* W = WSP(bf16, WS_WM + l * SZ_W1K); pg8::OrderMN S; S.init(WSP(bf16, WS_HN), D, W, D, MP, D, F.G, bx);
              pg8::EpiGran<GeMix<0>> E{{mix, mixb, proj, ps}}; pg8::gemm_phase(F.lds, D, D, D, S, E);
              skinny_gemm(F, WSP(bf16, WS_HN) + (size_t)MP * D, D, W, D, D, D, E.g); }
            { const bf16* W = WSP(bf16, WS_WP + l * SZ_WP); pg8::OrderMN S; S.init(WSP(bf16, WS_DP), D, W, 256, MP, D, F.G, bx, 512);
              pg8::EpiGran<GeMix<1>> E{{mix, mixb, proj, ps}}; pg8::gemm_phase(F.lds, 256, D, 256, S, E);
              for (int job = F.vcu; job < 32; job += F.G) { const int g = job >> 3;
                  skinny_job(F, WSP(bf16, WS_DP) + (size_t)MP * D + g * 256, D, W + (size_t)g * 65536 + (size_t)(job & 7) * 32 * 256, 256, 256, E.g, job * 32); } }
            { const bf16* W = WSP(bf16, WS_WX + l * SZ_W1K); pg8::OrderMN S; S.init(WSP(bf16, WS_OX), D, W, D, MP, D, F.G, bx);
              pg8::EpiGran<GeMix<2>> E{{mix, mixb, proj, ps}}; pg8::gemm_phase(F.lds, D, D, D, S, E);
              skinny_gemm(F, WSP(bf16, WS_OX) + (size_t)MP * D, D, W, D, D, D, E.g); }
        }
        SEAM(p0 + 4);
        _Pragma("unroll 1") for (int rep = 0; rep <= REP(5); ++rep) if (PM(7) && IN(p0 + 5)) { if (rep) xcd_barrier(bar);
            PHASE_BEGIN(F);
            const bf16* W = WSP(bf16, WS_WO + l * SZ_W1K); pg8::OrderMN S; S.init(WSP(bf16, WS_MIXB), D, W, D, MP, D, F.G, bx);
            pg8::EpiGran<GeRes> E{{WSP(float, WS_X), WSP(float, WS_T)}}; pg8::gemm_phase(F.lds, D, D, D, S, E);
            skinny_gemm(F, WSP(bf16, WS_MIXB) + (size_t)MP * D, D, W, D, D, D, E.g);
        }
        SEAM(p0 + 5);
        _Pragma("unroll 1") for (int rep = 0; rep <= REP(6); ++rep) if (PM(8) && IN(p0 + 6)) { if (rep) xcd_barrier(bar); PHASE_BEGIN(F); phase_ln(F, l, 0); }
        SEAM(p0 + 6);
        _Pragma("unroll 1") for (int rep = 0; rep <= REP(7); ++rep) if (PM(9) && IN(p0 + 7)) { if (rep) xcd_barrier(bar);
            PHASE_BEGIN(F);
            const bf16* W = WSP(bf16, WS_WUP + l * SZ_WUP); pg8::OrderMN S; S.init(WSP(bf16, WS_XN), D, W, D, MP, FF2, F.G, bx);
            pg8::EpiGran<GeBf16> E{{WSP(bf16, WS_HUP), FF2}}; pg8::gemm_phase(F.lds, D, D, D, S, E);
            skinny_gemm(F, WSP(bf16, WS_XN) + (size_t)MP * D, D, W, D, FF2, D, E.g);
        }
        SEAM(p0 + 7);
        _Pragma("unroll 1") for (int rep = 0; rep <= REP(8); ++rep) if (PM(10) && IN(p0 + 8)) { if (rep) xcd_barrier(bar); PHASE_BEGIN(F); phase_conv_act(F, l); }
        SEAM(p0 + 8);
        _Pragma("unroll 1") for (int rep = 0; rep <= REP(9); ++rep) if (PM(11) && IN(p0 + 9)) { if (rep) xcd_barrier(bar);
            PHASE_BEGIN(F);
            const bf16* W = WSP(bf16, WS_WDN + l * SZ_WDN); pg8::OrderMN S; S.init(WSP(bf16, WS_ACT), FF, W, FF, MP, D, F.G, bx);
            pg8::EpiGran<GeRes> E{{WSP(float, WS_X), WSP(float, WS_T)}}; pg8::gemm_phase(F.lds, FF, FF, FF, S, E);
            skinny_gemm(F, WSP(bf16, WS_ACT) + (size_t)MP * FF, FF, W, FF, D, FF, E.g);
        }
        SEAM(p0 + 9);
        _Pragma("unroll 1") for (int rep = 0; rep <= REP(10); ++rep) if (PM(12) && IN(p0 + 10)) { if (rep) xcd_barrier(bar); PHASE_BEGIN(F); phase_ln(F, l, 1); }
        SEAM(p0 + 10);
    }
#undef IN
#undef SEAM
}

extern "C" void kernel_launch(void* const* d_in, const int* in_sizes, int n_in, void* d_out, int out_size, void* d_ws, size_t ws_size, hipStream_t stream) {
    static int grid = 0;
    if (grid == 0) {
        if (n_in != 29 || (size_t)out_size != O_END || ws_size < WS_END) { fprintf(stderr, "kernel_launch: unexpected shapes (n_in %d, out %d, ws %zu; need ws >= %zu)\n", n_in, out_size, ws_size, (size_t)WS_END); grid = -1; return; }
        int dev = 0, cus = 0, per_cu = 0;
        if (hipGetDevice(&dev) != hipSuccess || hipDeviceGetAttribute(&cus, hipDeviceAttributeMultiprocessorCount, dev) != hipSuccess) { grid = -1; return; }
        if (hipFuncSetAttribute((const void*)trunk_fwd, hipFuncAttributeMaxDynamicSharedMemorySize, LDS_BYTES) != hipSuccess) { fprintf(stderr, "kernel_launch: hipFuncSetAttribute failed\n"); grid = -1; return; }
        if (hipOccupancyMaxActiveBlocksPerMultiprocessor(&per_cu, (const void*)trunk_fwd, 512, LDS_BYTES) != hipSuccess || per_cu < 1) fprintf(stderr, "kernel_launch: occupancy query reports %d\n", per_cu);
        (void)hipGetLastError();
        grid = cus;
    }
    if (grid < 0) return;
    (void)hipMemsetAsync((char*)d_ws + WS_CTL, 0, CTL_BYTES, stream);
    Args a{};
    for (int i = 0; i < 29; ++i) a.in[i] = (const float*)d_in[i];
    a.out = (float*)d_out; a.ws = (unsigned char*)d_ws; a.pad = 0;
#if MK_SPLIT
    for (int p = 0; p < PH_TOTAL; ++p) { a.ph_lo = p; a.ph_hi = p + 1; a.li = p; hipLaunchKernelGGL(trunk_fwd, dim3(grid), dim3(512), LDS_BYTES, stream, a); }
#else
    a.ph_lo = 0; a.ph_hi = PH_TOTAL; a.li = 0;
    hipLaunchKernelGGL(trunk_fwd, dim3(grid), dim3(512), LDS_BYTES, stream, a);
#endif
}
```

```cpp
#include <hip/hip_runtime.h>
#include <cstdio>
#include <cstdint>

#define LAS __attribute__((address_space(3)))
#define GAS __attribute__((address_space(1)))
typedef unsigned short bf16;
typedef short bf16x8 __attribute__((ext_vector_type(8)));
typedef float f32x4 __attribute__((ext_vector_type(4)));
typedef float f32x2 __attribute__((ext_vector_type(2)));
typedef unsigned u32x4 __attribute__((ext_vector_type(4)));
typedef unsigned u32x2 __attribute__((ext_vector_type(2)));
#define DI __device__ __forceinline__

#ifndef PHMASK
#define PHMASK 0xFFFFFFFFu
#endif
#ifndef SUBMASK
#define SUBMASK 0xFFFFFFFFu
#endif
#define SM(b) ((SUBMASK >> (b)) & 1u)
#ifndef REPMASK
#define REPMASK 0u
#endif
#ifndef SUBREP
#define SUBREP 0u
#endif
#define REP(k) ((int)((REPMASK >> (k)) & 1u))
#define SREP(k) ((int)((SUBREP >> (k)) & 1u))
#ifndef MK_SPLIT
#define MK_SPLIT 0
#endif

constexpr int D = 1024, NB = 8, SEQ = 2048, MP = NB * SEQ, MS = 128, MT = MP + MS, MTP = MP + 256, DEPTH = 4;
constexpr int NPROJ = 9216, INW = 9224;
constexpr int C_Q = 0, C_K = 1024, C_V = 2048, C_O = 3072, C_U = 4096, C_XQ = 5120, C_G = 6144;
constexpr int FF = 2816, FF2 = 5632, NMEM = 256, HD = 256, NH = 4;
constexpr float LN_EPS = 1e-5f;
constexpr float ALPHA = 1.681792830507429f;
constexpr int PAST_LEN = 16384;

constexpr size_t O_YP = 0, O_YS = 16777216, O_PC = 16908288, O_PN = 25296896, O_PM = 25329664, O_PPOOL = 25329792, O_PCONV = 25821312,
                 O_PMK = 26181760, O_PMV = 34570368, O_SC = 42958976, O_SN = 177176704, O_SM = 177700992, O_SPOOL = 177703040, O_SCONV = 185567360, O_END = 191334528;

constexpr size_t al256(size_t x) { return (x + 255) & ~(size_t)255; }
constexpr size_t WS_CTL = 0, CTL_BYTES = 2u << 20;
constexpr size_t WS_WIN = CTL_BYTES;                                        constexpr size_t SZ_WIN = (size_t)NPROJ * D * 2;
constexpr size_t WS_WM = WS_WIN + DEPTH * SZ_WIN;                           constexpr size_t SZ_W1K = (size_t)D * D * 2;
constexpr size_t WS_WX = WS_WM + DEPTH * SZ_W1K;
constexpr size_t WS_WO = WS_WX + DEPTH * SZ_W1K;
constexpr size_t WS_WP = WS_WO + DEPTH * SZ_W1K;                            constexpr size_t SZ_WP = (size_t)4 * 256 * 256 * 2;
constexpr size_t WS_WKV = WS_WP + DEPTH * SZ_WP;                            constexpr size_t SZ_WKV = (size_t)2048 * D * 2;
constexpr size_t WS_WUP = WS_WKV + DEPTH * SZ_WKV;                          constexpr size_t SZ_WUP = (size_t)FF2 * D * 2;
constexpr size_t WS_WDN = WS_WUP + DEPTH * SZ_WUP;                          constexpr size_t SZ_WDN = (size_t)D * FF * 2;
constexpr size_t WS_X = al256(WS_WDN + DEPTH * SZ_WDN);
constexpr size_t WS_T = WS_X + (size_t)MTP * D * 4;
constexpr size_t WS_MIX = WS_T + (size_t)MTP * D * 4;
constexpr size_t WS_XN = WS_MIX + (size_t)MTP * D * 4;
constexpr size_t WS_PROJ = WS_XN + (size_t)MTP * D * 2;
constexpr size_t WS_HC = WS_PROJ + (size_t)MTP * NPROJ * 2;
constexpr size_t WS_HN = WS_HC + (size_t)MTP * D * 2;
constexpr size_t WS_DP = WS_HN + (size_t)MTP * D * 2;
constexpr size_t WS_PB = WS_DP + (size_t)MTP * D * 2;
constexpr size_t WS_OX = WS_PB + (size_t)MTP * D * 2;
constexpr size_t WS_MIXB = WS_OX + (size_t)MTP * D * 2;
constexpr size_t WS_HUP = WS_MIXB + (size_t)MTP * D * 2;
constexpr size_t WS_ACT = WS_HUP + (size_t)MTP * FF2 * 2;
constexpr size_t WS_IGFG = WS_ACT + (size_t)MTP * FF * 2;
constexpr size_t WS_MEMB = WS_IGFG + (size_t)MTP * 8 * 4;
constexpr size_t WS_MK = WS_MEMB + (size_t)2048 * D * 2;
constexpr size_t WS_MVT = WS_MK + (size_t)DEPTH * 2048 * D * 2;
constexpr size_t WS_PT = WS_MVT + (size_t)DEPTH * 2048 * D * 2;
constexpr size_t WS_KWT = WS_PT + (size_t)32 * 32 * 4096 * 2;
constexpr size_t WS_VTT = WS_KWT + (size_t)32 * 32 * 16384 * 2;
constexpr size_t WS_GT = WS_VTT + (size_t)32 * 32 * 16384 * 2;
constexpr size_t WS_XQ = WS_GT + (size_t)32 * 32 * 192 * 4;
constexpr size_t WS_HALO = WS_XQ + (size_t)MTP * D * 2;
constexpr size_t WS_END = WS_HALO + (size_t)64 * 4 * FF2 * 4;
static_assert(WS_END <= 2147483648ull, "workspace map exceeds 2 GiB");
constexpr int CW_BAR = 4096;

constexpr int LDS_BYTES = 147456;
constexpr int XCH_OFF = 131072;
constexpr int MISC_OFF = LDS_BYTES - 256;

DI float bf2f(unsigned v) { return __uint_as_float(v << 16); }
DI unsigned f2bf(float f) { unsigned u = __float_as_uint(f); return (u + 0x7fffu + ((u >> 16) & 1u)) >> 16; }
DI unsigned pk2(float lo, float hi) { return f2bf(lo) | (f2bf(hi) << 16); }
DI float lo16(unsigned w) { return __uint_as_float(w << 16); }
DI float hi16(unsigned w) { return __uint_as_float(w & 0xffff0000u); }
DI float sigmoid_fast(float x) { return __builtin_amdgcn_rcpf(1.0f + __expf(-x)); }
DI float wave_sum(float v) {
#pragma unroll
    for (int o = 1; o < 64; o <<= 1) v += __shfl_xor(v, o);
    return v;
}
DI void unpack8(const u32x4 w, float (&f)[8]) { f[0] = lo16(w.x); f[1] = hi16(w.x); f[2] = lo16(w.y); f[3] = hi16(w.y); f[4] = lo16(w.z); f[5] = hi16(w.z); f[6] = lo16(w.w); f[7] = hi16(w.w); }
DI int opaque_tid() { int t = threadIdx.x; asm volatile("" : "+v"(t)); return t; }
#define LDS_WAIT() asm volatile("s_waitcnt lgkmcnt(0)" ::: "memory")
#define VM_WAIT() asm volatile("s_waitcnt vmcnt(0)" ::: "memory")

namespace pg8 {
constexpr int BM = 256, BK = 64, HALF = 128, HTB = HALF * BK * 2, STAGE_BYTES = 8 * HTB, NXCD = 8, WGM = 8;
__host__ __device__ __forceinline__ int lds_byte(int r, int c) { const int st = (r >> 4) * 2 + (c >> 5), rr = r & 15, cc = c & 31, ob = rr * 64 + cc * 2; return st * 1024 + (ob ^ (((ob >> 9) & 1) << 5)); }
__host__ __device__ __forceinline__ void stage_rc(int b, int& R, int& C) { const int st = b / 1024, sb = b % 1024, swz = sb ^ (((sb >> 9) & 1) << 5); R = (st >> 1) * 16 + swz / 64; C = (st & 1) * 32 + (swz % 64) / 2; }

struct Unit { const char* a; const char* b; int pm, pn; };

struct OrderMN {
    int nM, nN, nwg, G, c; const char* A; const char* Bt; size_t astep, bstep, apn;
    DI void init(const bf16* A_, int lda, const bf16* Bt_, int ldb, int M, int N, int G_, int c_, int apn_ = 0) { nM = M / BM; nN = N / BM; nwg = nM * nN; G = G_; c = c_; A = (const char*)A_; Bt = (const char*)Bt_; astep = (size_t)BM * lda * 2; bstep = (size_t)BM * ldb * 2; apn = (size_t)apn_; }
    DI bool next(int i, Unit& u) const {
        const long L = (long)i * G + c; if (L >= nwg) return false;
        int wgid = (int)L; { const int q = nwg / NXCD, r = nwg % NXCD, xcd = wgid % NXCD, off = wgid / NXCD; wgid = (xcd < r ? xcd * (q + 1) : r * (q + 1) + (xcd - r) * q) + off; }
        const int nig = WGM * nN, gid = wgid / nig, fm = gid * WGM, gsz = (nM - fm) < WGM ? (nM - fm) : WGM;
        u.pm = fm + ((wgid % nig) % gsz); u.pn = (wgid % nig) / gsz; u.a = A + (size_t)u.pm * astep + (size_t)u.pn * apn; u.b = Bt + (size_t)u.pn * bstep; return true;
    }
};

template <class Epi, class Sched>
DI void gemm_phase(LAS unsigned char* lds, const int K, const int lda, const int ldb, const Sched& S, const Epi& E) {
    const int tid = opaque_tid(), wid = __builtin_amdgcn_readfirstlane(tid >> 6), lane = tid & 63, wr = wid >> 2, wc = wid & 3, fr = lane & 15, fq = lane >> 4;
    const int nt = K / BK;
    unsigned voffA[2], voffB[2];
#pragma unroll
    for (int i = 0; i < 2; ++i) { int R, C; stage_rc(tid * 16 + i * 8192, R, C); voffA[i] = (unsigned)(R * lda + C) * 2u; voffB[i] = (unsigned)(R * ldb + C) * 2u; }
    const size_t kstep = (size_t)(BK * 2);
    const size_t hstepA = (size_t)HALF * lda * 2, hstepB = (size_t)HALF * ldb * 2;
    const unsigned ldsw = (unsigned)wid * 1024u;
    const int aoff = lds_byte(wr * 64 + fr, fq * 8), boff = lds_byte(wc * 32 + fr, fq * 8);
#define PG8_SA(b, h) (((b) * 2 + (h)) * HTB)
#define PG8_SB(b, h) ((4 + (b) * 2 + (h)) * HTB)
#define PG8_STAGE(bufoff, gbase, voff) do { _Pragma("unroll") for (int _i = 0; _i < 2; ++_i) \
        __builtin_amdgcn_global_load_lds((const unsigned*)((const char*)(gbase) + (voff)[_i]), (LAS unsigned*)(lds + (bufoff) + ldsw + _i * 8192), 16, 0, 0); } while (0)
#define PG8_LDA(dst, b, h) do { _Pragma("unroll") for (int m = 0; m < 4; ++m) _Pragma("unroll") for (int k = 0; k < 2; ++k) dst[m][k] = *(const LAS bf16x8*)(lds + PG8_SA(b, h) + aoff + m * 2048 + k * 1024); } while (0)
#define PG8_LDB(dst, b, h) do { _Pragma("unroll") for (int n = 0; n < 2; ++n) _Pragma("unroll") for (int k = 0; k < 2; ++k) dst[n][k] = *(const LAS bf16x8*)(lds + PG8_SB(b, h) + boff + n * 2048 + k * 1024); } while (0)
#define PG8_MMA(ai, bj, At, Bt) do { __builtin_amdgcn_s_setprio(1); _Pragma("unroll") for (int m = 0; m < 4; ++m) _Pragma("unroll") for (int n = 0; n < 2; ++n) _Pragma("unroll") for (int k = 0; k < 2; ++k) \
        acc[ai][bj][m][n] = __builtin_amdgcn_mfma_f32_16x16x32_bf16(Bt[n][k], At[m][k], acc[ai][bj][m][n], 0, 0, 0); __builtin_amdgcn_s_setprio(0); } while (0)
#define PG8_WAIT_V(n) asm volatile("s_waitcnt vmcnt(" #n ")" ::: "memory")
#define PG8_WAIT_L(n) asm volatile("s_waitcnt lgkmcnt(" #n ")" ::: "memory")
#define PG8_BAR __builtin_amdgcn_s_barrier()
#define PG8_SCHED __builtin_amdgcn_sched_barrier(0)
    Unit cur, nxt; int ui = 0;
    if (!S.next(0, cur)) return;
    f32x4 acc[2][2][4][2];
#pragma unroll
    for (int a = 0; a < 2; ++a)
#pragma unroll
        for (int b = 0; b < 2; ++b)
#pragma unroll
            for (int m = 0; m < 4; ++m)
#pragma unroll
                for (int n = 0; n < 2; ++n) acc[a][b][m][n] = (f32x4){0.f, 0.f, 0.f, 0.f};
    bf16x8 At[4][2], B0[2][2], B1[2][2];
    const char* cA = cur.a; const char* cB = cur.b;
    PG8_STAGE(PG8_SB(0, 0), cB, voffB); PG8_STAGE(PG8_SB(0, 1), cB + hstepB, voffB); PG8_STAGE(PG8_SA(0, 0), cA, voffA); PG8_STAGE(PG8_SA(0, 1), cA + hstepA, voffA);
    if (wr == 1) PG8_BAR;
    PG8_WAIT_V(2); PG8_BAR;
    PG8_STAGE(PG8_SB(1, 0), cB + kstep, voffB); PG8_STAGE(PG8_SA(1, 0), cA + kstep, voffA); PG8_STAGE(PG8_SB(1, 1), cB + hstepB + kstep, voffB);
    PG8_WAIT_V(6); PG8_BAR;
    for (;;) {
        const bool has_next = S.next(ui + 1, nxt);
        const char* nA = has_next ? nxt.a : cA; const char* nB = has_next ? nxt.b : cB;
#pragma unroll 1
        for (int t = 0; t < nt; t += 2) {
            const bool last = (t == nt - 2);
            const char* a1 = cA + (size_t)(t + 1) * kstep;
            const char* a2 = last ? nA : cA + (size_t)(t + 2) * kstep; const char* b2 = last ? nB : cB + (size_t)(t + 2) * kstep;
            const char* a3 = a2 + kstep; const char* b3 = b2 + kstep;
            PG8_LDB(B0, 0, 0); PG8_LDB(B1, 0, 1); PG8_SCHED; PG8_LDA(At, 0, 0); PG8_STAGE(PG8_SA(1, 1), a1 + hstepA, voffA);
            PG8_WAIT_V(8); PG8_WAIT_L(0); PG8_BAR; PG8_MMA(0, 0, At, B0); PG8_MMA(0, 1, At, B1); PG8_BAR; PG8_SCHED;
            PG8_LDA(At, 0, 1); PG8_STAGE(PG8_SB(0, 0), b2, voffB); PG8_STAGE(PG8_SB(0, 1), b2 + hstepB, voffB); PG8_STAGE(PG8_SA(0, 0), a2, voffA);
            PG8_WAIT_V(8); PG8_WAIT_L(0); PG8_BAR; PG8_MMA(1, 0, At, B0); PG8_MMA(1, 1, At, B1); PG8_BAR; PG8_SCHED;
            PG8_LDB(B0, 1, 0); PG8_LDB(B1, 1, 1); PG8_SCHED; PG8_LDA(At, 1, 0); PG8_STAGE(PG8_SA(0, 1), a2 + hstepA, voffA);
            PG8_WAIT_V(8); PG8_WAIT_L(0); PG8_BAR; PG8_MMA(0, 0, At, B0); PG8_MMA(0, 1, At, B1); PG8_BAR; PG8_SCHED;
            PG8_LDA(At, 1, 1); PG8_STAGE(PG8_SB(1, 0), b3, voffB); PG8_STAGE(PG8_SB(1, 1), b3 + hstepB, voffB); PG8_STAGE(PG8_SA(1, 0), a3, voffA);
            PG8_WAIT_V(8); PG8_WAIT_L(0); PG8_BAR; PG8_MMA(1, 0, At, B0); PG8_MMA(1, 1, At, B1); PG8_BAR; PG8_SCHED;
        }
        if (wr == 0) PG8_BAR;
        E(acc, cur, wr, wc, fr, fq);
        if (!has_next) break;
#pragma unroll
        for (int a = 0; a < 2; ++a)
#pragma unroll
            for (int b = 0; b < 2; ++b)
#pragma unroll
                for (int m = 0; m < 4; ++m)
#pragma unroll
                    for (int n = 0; n < 2; ++n) acc[a][b][m][n] = (f32x4){0.f, 0.f, 0.f, 0.f};
        cur = nxt; cA = nA; cB = nB; ++ui;
        if (wr == 1) PG8_BAR;
    }
    PG8_WAIT_V(0);
    PG8_BAR;
#undef PG8_SA
#undef PG8_SB
#undef PG8_STAGE
#undef PG8_LDA
#undef PG8_LDB
#undef PG8_MMA
#undef PG8_WAIT_V
#undef PG8_WAIT_L
#undef PG8_BAR
#undef PG8_SCHED
}

template <class GE> struct EpiGran {
    GE g;
    DI void operator()(f32x4 (&acc)[2][2][4][2], const Unit& u, int wr, int wc, int fr, int fq) const {
        const int row0 = u.pm * BM + wr * 64 + fr, col0 = u.pn * BM + wc * 32 + 4 * fq;
#pragma unroll
        for (int ai = 0; ai < 2; ++ai)
#pragma unroll
            for (int m = 0; m < 4; ++m)
#pragma unroll
                for (int bj = 0; bj < 2; ++bj)
#pragma unroll
                    for (int n = 0; n < 2; ++n) g(row0 + ai * HALF + m * 16, col0 + bj * HALF + n * 16, acc[ai][bj][m][n]);
    }
};
}

#define XB_TMO      128
#define XB_XCNT(j)  (256  + 64 * (j))
#define XB_XSUB(j)  (1280 + 64 * (j))
#define XB_XGEN(j)  (2304 + 64 * (j))
#define XB_TOP      3328
#define XB_TOPGEN   3392
#define XCD_BAR_WORDS 3456
#define XB_SPIN_CAP (1u << 22)
DI unsigned xb_ld(unsigned* p)              { return __hip_atomic_load(p, __ATOMIC_RELAXED, __HIP_MEMORY_SCOPE_AGENT); }
DI unsigned xb_add(unsigned* p, unsigned v) { return __hip_atomic_fetch_add(p, v, __ATOMIC_RELAXED, __HIP_MEMORY_SCOPE_AGENT); }
DI unsigned xb_xcc_id() { return (unsigned)__builtin_amdgcn_s_getreg((3 << 11) | 20) & 0xFu; }
#define XB_SPIN(cond, bar) do { unsigned _sp = 0; while (cond) { __builtin_amdgcn_s_sleep(1); \
    if ((++_sp & 255u) == 0u) { if (xb_ld(&(bar)[XB_TMO])) break; if (_sp > XB_SPIN_CAP) { atomicAdd(&(bar)[XB_TMO], 1u); break; } } } } while (0)
struct XcdBarrier { unsigned* bar; unsigned x; volatile LAS unsigned* st; };
DI XcdBarrier xcd_barrier_post(unsigned* bar, volatile LAS unsigned* st) {
    XcdBarrier b; b.bar = bar; b.x = xb_xcc_id(); b.st = st;
    if (threadIdx.x == 0) (void)xb_add(&bar[XB_XCNT(b.x)], 1u);
    return b;
}
DI void xcd_barrier_complete(unsigned* bar, unsigned x, unsigned& nloc, unsigned& nx) {
    const unsigned G = gridDim.x * gridDim.y * gridDim.z;
    unsigned sum, cnt, mine, sp = 0u;
    for (;;) {
        sum = 0u; cnt = 0u; mine = 0u;
#pragma unroll
        for (unsigned j = 0; j < 16; ++j) { const unsigned c = xb_ld(&bar[XB_XCNT(j)]); sum += c; cnt += (c > 0u) ? 1u : 0u; mine = (j == x) ? c : mine; }
        if (sum == G) break;
        __builtin_amdgcn_s_sleep(1);
        if ((++sp & 255u) == 0u) { if (xb_ld(&bar[XB_TMO])) break; if (sp > XB_SPIN_CAP) { atomicAdd(&bar[XB_TMO], 1u); break; } }
    }
    nloc = mine > 0u ? mine : 1u; nx = cnt > 0u ? cnt : 1u;
}
DI void xcd_barrier(const XcdBarrier& b) {
    asm volatile("s_waitcnt vmcnt(0)" ::: "memory");
    __syncthreads();
    if (threadIdx.x == 0) {
        unsigned* bar = b.bar;
        __builtin_amdgcn_s_waitcnt(0);
        unsigned nloc = b.st[0], nx = b.st[1];
        if (nloc == 0u) { xcd_barrier_complete(bar, b.x, nloc, nx); b.st[0] = nloc; b.st[1] = nx; }
        const unsigned old = xb_add(&bar[XB_XSUB(b.x)], 1u);
        const unsigned gen = old / nloc;
        if (old + 1u == (gen + 1u) * nloc) {
            __builtin_amdgcn_fence(__ATOMIC_RELEASE, "agent");
            asm volatile("s_waitcnt vmcnt(0)" ::: "memory");
            const unsigned og = xb_add(&bar[XB_TOP], 1u);
            const unsigned tg = og / nx;
            if (og + 1u == (tg + 1u) * nx) xb_add(&bar[XB_TOPGEN], 1u);
            else XB_SPIN(xb_ld(&bar[XB_TOPGEN]) == tg, bar);
            __builtin_amdgcn_fence(__ATOMIC_ACQUIRE, "agent");
            xb_add(&bar[XB_XGEN(b.x)], 1u);
            asm volatile("s_waitcnt vmcnt(0)" ::: "memory");
        } else {
            XB_SPIN(xb_ld(&bar[XB_XGEN(b.x)]) == gen, bar);
            __builtin_amdgcn_fence(__ATOMIC_ACQUIRE, "agent");
            asm volatile("s_waitcnt vmcnt(0)" ::: "memory");
        }
    }
    __syncthreads();
}

typedef const GAS float* fptr_t;
typedef const __attribute__((address_space(4))) fptr_t* in_tab_t;
struct Frame {
    LAS unsigned char* lds;
    int vcu, G;
    in_tab_t in; float* out; unsigned char* ws;
};
#define PHASE_BEGIN(F) Frame F = F0; int bx = bx0; { unsigned long long _a = (unsigned long long)F0.in, _b = (unsigned long long)F0.out, _c = (unsigned long long)F0.ws; int _g = F0.G, _v = F0.vcu; \
    asm volatile("" : "+s"(_a), "+s"(_b), "+s"(_c), "+s"(_g), "+s"(_v), "+s"(bx)); \
    F.in = (in_tab_t)_a; F.out = (float*)(GAS float*)_b; F.ws = (unsigned char*)(GAS unsigned char*)_c; F.G = _g; F.vcu = _v; }
#define WSP(T, off) ((T*)(F.ws + (off)))

struct GeIn {
    bf16* proj; const float* bias; bf16* xqb;
    DI void operator()(int row, int col, const f32x4& a) const {
        const int bc = col + (col >= 4096 ? 8 : 0);
        const f32x4 bv = *(const f32x4*)(bias + bc);
        f32x4 v = a + bv;
        const bool sg = (col >= C_O && col < C_U) || col >= C_G;
        if (sg) { v.x = sigmoid_fast(v.x); v.y = sigmoid_fast(v.y); v.z = sigmoid_fast(v.z); v.w = sigmoid_fast(v.w); }
        u32x2 w; w.x = pk2(v.x, v.y); w.y = pk2(v.z, v.w);
        if (col >= C_XQ && col < C_G) *(u32x2*)(xqb + (size_t)row * D + (col - C_XQ)) = w;
        else *(u32x2*)(proj + (size_t)row * NPROJ + col) = w;
    }
};
struct GeKV {
    float* out; bf16* mk; bf16* mvt;
    DI void operator()(int row, int col, const f32x4& a) const {
        const int l = col >> 11, c = col & 2047;
        if (c < 1024) {
            *(f32x4*)(out + O_PMK + ((size_t)l * 2048 + row) * 1024 + c) = a;
            u32x2 w; w.x = pk2(a.x, a.y); w.y = pk2(a.z, a.w);
            *(u32x2*)(mk + ((size_t)l * 2048 + row) * 1024 + c) = w;
        } else {
            const int cc = c - 1024;
            *(f32x4*)(out + O_PMV + ((size_t)l * 2048 + row) * 1024 + cc) = a;
            bf16* t = mvt + ((size_t)l * 1024 + cc) * 2048 + row;
            t[0] = (bf16)f2bf(a.x); t[2048] = (bf16)f2bf(a.y); t[4096] = (bf16)f2bf(a.z); t[6144] = (bf16)f2bf(a.w);
        }
    }
};
struct GeBf16 {
    bf16* o; int ldc;
    DI void operator()(int row, int col, const f32x4& a) const { u32x2 w; w.x = pk2(a.x, a.y); w.y = pk2(a.z, a.w); *(u32x2*)(o + (size_t)row * ldc + col) = w; }
};
template <int MODE> struct GeMix {
    float* mix; bf16* mixb; const bf16* proj; const float* ps;
    DI void operator()(int row, int col, const f32x4& a) const {
        const u32x2 gw = *(const u32x2*)(proj + (size_t)row * NPROJ + C_G + MODE * 1024 + col);
        const f32x4 g = (f32x4){lo16(gw.x), hi16(gw.x), lo16(gw.y), hi16(gw.y)};
        float* mp = mix + (size_t)row * D + col;
        if (MODE == 0) { *(f32x4*)mp = g * a; }
        else if (MODE == 1) { const f32x4 s = *(const f32x4*)(ps + col); *(f32x4*)mp = *(const f32x4*)mp + g * s * a; }
        else { const f32x4 v = *(const f32x4*)mp + g * a; u32x2 w; w.x = pk2(v.x, v.y); w.y = pk2(v.z, v.w); *(u32x2*)(mixb + (size_t)row * D + col) = w; }
    }
};
struct GeRes {
    const float* x; float* t;
    DI void operator()(int row, int col, const f32x4& a) const { const size_t o = (size_t)row * D + col; *(f32x4*)(t + o) = *(const f32x4*)(x + o) * ALPHA + a; }
};

struct EpiSoftmax {
    bf16* P; LAS float* X;
    DI void operator()(f32x4 (&acc)[2][2][4][2], const pg8::Unit& u, int wr, int wc, int fr, int fq) const {
        const float sc = 0.0625f * 1.4426950408889634f;
        LAS float* XM = X; LAS float* XS = X + 1024;
#pragma unroll
        for (int ai = 0; ai < 2; ++ai)
#pragma unroll
            for (int m = 0; m < 4; ++m) {
                float v = -3.0e38f;
#pragma unroll
                for (int bj = 0; bj < 2; ++bj)
#pragma unroll
                    for (int n = 0; n < 2; ++n) { const f32x4 x = acc[ai][bj][m][n]; v = fmaxf(v, fmaxf(fmaxf(x.x, x.y), fmaxf(x.z, x.w))); }
                v = fmaxf(v, __shfl_xor(v, 16)); v = fmaxf(v, __shfl_xor(v, 32));
                if (fq == 0) XM[(ai * 128 + wr * 64 + m * 16 + fr) * 4 + wc] = v;
            }
        LDS_WAIT(); __builtin_amdgcn_s_barrier(); asm volatile("" ::: "memory");
#pragma unroll
        for (int ai = 0; ai < 2; ++ai)
#pragma unroll
            for (int m = 0; m < 4; ++m) {
                const int r = ai * 128 + wr * 64 + m * 16 + fr;
                const f32x4 mm = *(const LAS f32x4*)(XM + r * 4);
                const float mx = fmaxf(fmaxf(mm.x, mm.y), fmaxf(mm.z, mm.w)) * sc;
                float s = 0.f;
#pragma unroll
                for (int bj = 0; bj < 2; ++bj)
#pragma unroll
                    for (int n = 0; n < 2; ++n) { f32x4 x = acc[ai][bj][m][n];
                        x.x = __builtin_amdgcn_exp2f(x.x * sc - mx); x.y = __builtin_amdgcn_exp2f(x.y * sc - mx); x.z = __builtin_amdgcn_exp2f(x.z * sc - mx); x.w = __builtin_amdgcn_exp2f(x.w * sc - mx);
                        acc[ai][bj][m][n] = x; s += (x.x + x.y) + (x.z + x.w); }
                s += __shfl_xor(s, 16); s += __shfl_xor(s, 32);
                if (fq == 0) XS[r * 4 + wc] = s;
                asm volatile("" ::: "memory");
            }
        LDS_WAIT(); __builtin_amdgcn_s_barrier(); asm volatile("" ::: "memory");
#pragma unroll
        for (int ai = 0; ai < 2; ++ai)
#pragma unroll
            for (int m = 0; m < 4; ++m) {
                const int r = ai * 128 + wr * 64 + m * 16 + fr;
                const f32x4 ss = *(const LAS f32x4*)(XS + r * 4);
                const float inv = 1.0f / ((ss.x + ss.y) + (ss.z + ss.w));
                bf16* rowp = P + (size_t)(u.pm * 256 + r) * D + u.pn * 256 + wc * 32 + 4 * fq;
#pragma unroll
                for (int bj = 0; bj < 2; ++bj)
#pragma unroll
                    for (int n = 0; n < 2; ++n) { const f32x4 x = acc[ai][bj][m][n] * inv; u32x2 w; w.x = pk2(x.x, x.y); w.y = pk2(x.z, x.w); *(u32x2*)(rowp + bj * 128 + n * 16) = w; }
                asm volatile("" ::: "memory");
            }
        LDS_WAIT(); __builtin_amdgcn_s_barrier(); asm volatile("" ::: "memory");
    }
};

#define ROR_F(x, n) __builtin_bit_cast(float, __builtin_amdgcn_update_dpp(0, __builtin_bit_cast(int, (float)(x)), 0x120 + (n), 0xf, 0xf, false))
DI float gelu_tanh(float x) { return x * sigmoid_fast(1.5957691216057308f * (x + 0.044715f * x * x * x)); }
struct EpiConv {
    bf16* act; float* halo; float* out; const float* cw; const float* cb; LAS float* X; int l;
    DI void operator()(f32x4 (&acc)[2][2][4][2], const pg8::Unit& u, int wr, int wc, int fr, int fq) const {
        if (fr >= 14) {
#pragma unroll
            for (int ai = 0; ai < 2; ++ai)
#pragma unroll
                for (int bj = 0; bj < 2; ++bj)
#pragma unroll
                    for (int n = 0; n < 2; ++n) *(LAS f32x4*)(X + (((ai * 2 + wr) * 2 + (fr - 14)) * 256 + bj * 128 + wc * 32 + n * 16 + fq * 4)) = acc[ai][bj][3][n];
        }
        LDS_WAIT(); __builtin_amdgcn_s_barrier(); asm volatile("" ::: "memory");
        if (wr == 0 && fr < 2) {
#pragma unroll
            for (int h = 0; h < 2; ++h)
#pragma unroll
                for (int n = 0; n < 2; ++n) *(f32x4*)(halo + ((size_t)u.pm * 4 + fr) * FF2 + h * FF + u.pn * 128 + wc * 32 + n * 16 + fq * 4) = acc[0][h][0][n];
        }
        if (wr == 1 && fr >= 14) {
#pragma unroll
            for (int h = 0; h < 2; ++h)
#pragma unroll
                for (int n = 0; n < 2; ++n) { const int ca = u.pn * 128 + wc * 32 + n * 16 + fq * 4;
                    *(f32x4*)(halo + ((size_t)u.pm * 4 + 2 + (fr - 14)) * FF2 + h * FF + ca) = acc[1][h][3][n];
                    if ((u.pm & 7) == 7) *(f32x4*)(out + O_PCONV + ((size_t)(l * NB + (u.pm >> 3)) * 2 + (fr - 14)) * FF2 + h * FF + ca) = acc[1][h][3][n]; }
        }
        const bool p1own = fr >= 1, p2own = fr >= 2;
#pragma unroll
        for (int n = 0; n < 2; ++n) {
            asm volatile("" ::: "memory");
            const int ca = u.pn * 128 + wc * 32 + n * 16 + fq * 4;
            f32x4 w[2][3], bsv[2];
#pragma unroll
            for (int h = 0; h < 2; ++h) {
#pragma unroll
                for (int i = 0; i < 3; ++i) w[h][i] = *(const f32x4*)(cw + (size_t)i * FF2 + h * FF + ca);
                bsv[h] = *(const f32x4*)(cb + h * FF + ca); }
            bf16* ap = act + (size_t)(u.pm * 256 + wr * 64 + fr) * FF + ca;
#pragma unroll
            for (int ai = 0; ai < 2; ++ai)
#pragma unroll
                for (int m = 3; m >= 0; --m) {
                    f32x4 c[2];
#pragma unroll
                    for (int h = 0; h < 2; ++h) {
                        const f32x4 cur = acc[ai][h][m][n];
                        f32x4 g;
                        if (m > 0) g = acc[ai][h][m - 1][n];
                        else { g = (f32x4){0.f, 0.f, 0.f, 0.f};
                            if (fr >= 14 && (wr == 1 || ai == 1)) { const int sa = (wr == 1) ? ai : 0, sw = (wr == 1) ? 0 : 1; g = *(const LAS f32x4*)(X + (((sa * 2 + sw) * 2 + (fr - 14)) * 256 + h * 128 + wc * 32 + n * 16 + fq * 4)); } }
                        f32x4 p1, p2;
#pragma unroll
                        for (int j = 0; j < 4; ++j) { const float a1 = ROR_F(cur[j], 1), b1 = ROR_F(g[j], 1), a2 = ROR_F(cur[j], 2), b2 = ROR_F(g[j], 2); p1[j] = p1own ? a1 : b1; p2[j] = p2own ? a2 : b2; }
                        c[h] = p2 * w[h][0] + p1 * w[h][1] + cur * w[h][2] + bsv[h];
                    }
                    const f32x4 o = (f32x4){gelu_tanh(c[0].x) * c[1].x, gelu_tanh(c[0].y) * c[1].y, gelu_tanh(c[0].z) * c[1].z, gelu_tanh(c[0].w) * c[1].w};
                    u32x2 wv; wv.x = pk2(o.x, o.y); wv.y = pk2(o.z, o.w);
                    *(u32x2*)(ap + (size_t)(ai * 128 + m * 16) * FF) = wv;
                }
        }
        LDS_WAIT(); __builtin_amdgcn_s_barrier(); asm volatile("" ::: "memory");
    }
};
DI void conv_fixup(Frame& F, int l, int pm) {
    const float* halo = WSP(float, WS_HALO); bf16* act = WSP(bf16, WS_ACT);
    const float* cw = ((const float*)F.in[24]) + (size_t)l * 3 * FF2; const float* cb = ((const float*)F.in[25]) + (size_t)l * FF2;
    const bool first = (pm & 7) == 0;
    for (int it = opaque_tid(); it < FF / 4; it += 512) {
        const int ca = it * 4; f32x4 c0[2], c1[2];
#pragma unroll
        for (int h = 0; h < 2; ++h) {
            const size_t co = (size_t)h * FF + ca;
            const f32x4 r0 = *(const f32x4*)(halo + ((size_t)pm * 4 + 0) * FF2 + co), r1 = *(const f32x4*)(halo + ((size_t)pm * 4 + 1) * FF2 + co);
            f32x4 q2 = (f32x4){0.f, 0.f, 0.f, 0.f}, q1 = q2;
            if (!first) { q2 = *(const f32x4*)(halo + ((size_t)(pm - 1) * 4 + 2) * FF2 + co); q1 = *(const f32x4*)(halo + ((size_t)(pm - 1) * 4 + 3) * FF2 + co); }
            const f32x4 w0 = *(const f32x4*)(cw + co), w1 = *(const f32x4*)(cw + FF2 + co), w2 = *(const f32x4*)(cw + 2 * FF2 + co), bv = *(const f32x4*)(cb + co);
            c0[h] = q2 * w0 + q1 * w1 + r0 * w2 + bv; c1[h] = q1 * w0 + r0 * w1 + r1 * w2 + bv; }
        u32x2 wv; wv.x = pk2(gelu_tanh(c0[0].x) * c0[1].x, gelu_tanh(c0[0].y) * c0[1].y); wv.y = pk2(gelu_tanh(c0[0].z) * c0[1].z, gelu_tanh(c0[0].w) * c0[1].w);
        *(u32x2*)(act + (size_t)(pm * 256) * FF + ca) = wv;
        wv.x = pk2(gelu_tanh(c1[0].x) * c1[1].x, gelu_tanh(c1[0].y) * c1[1].y); wv.y = pk2(gelu_tanh(c1[0].z) * c1[1].z, gelu_tanh(c1[0].w) * c1[1].w);
        *(u32x2*)(act + (size_t)(pm * 256 + 1) * FF + ca) = wv;
    }
}
DI void skinny_up_conv(Frame& F, int l, const bf16* W) {
    const int tid = opaque_tid(), lane = tid & 63, wid = __builtin_amdgcn_readfirstlane(tid >> 6), fr = lane & 15, fq = lane >> 4, b = wid * 16 + fr;
    const bf16* ap = WSP(bf16, WS_XN) + (size_t)(MP + b) * D + fq * 8;
    const float* cw = ((const float*)F.in[24]) + (size_t)l * 3 * FF2; const float* cb = ((const float*)F.in[25]) + (size_t)l * FF2;
    const float* sc = ((const float*)F.in[9]) + ((size_t)(l * MS + b) * 2) * FF2; float* so = F.out + O_SCONV + ((size_t)(l * MS + b) * 2) * FF2;
    for (int job = F.vcu; job < FF / 16; job += F.G) {
        const int uu = job >> 3, cc = (job & 7) * 16;
        const bf16* b0 = W + (size_t)(uu * 256 + cc + fr) * D + fq * 8; const bf16* b1 = b0 + (size_t)128 * D;
        f32x4 acc[2] = {(f32x4){0.f, 0.f, 0.f, 0.f}, (f32x4){0.f, 0.f, 0.f, 0.f}};
#pragma unroll 8
        for (int k0 = 0; k0 < D; k0 += 32) { const bf16x8 a = *(const bf16x8*)(ap + k0), x0 = *(const bf16x8*)(b0 + k0), x1 = *(const bf16x8*)(b1 + k0);
            acc[0] = __builtin_amdgcn_mfma_f32_16x16x32_bf16(x0, a, acc[0], 0, 0, 0); acc[1] = __builtin_amdgcn_mfma_f32_16x16x32_bf16(x1, a, acc[1], 0, 0, 0); }
        const int ca = job * 16 + fq * 4; f32x4 c[2];
#pragma unroll
        for (int h = 0; h < 2; ++h) { const size_t co = (size_t)h * FF + ca;
            const f32x4 s0 = *(const f32x4*)(sc + co), s1 = *(const f32x4*)(sc + FF2 + co);
            c[h] = s0 * *(const f32x4*)(cw + co) + s1 * *(const f32x4*)(cw + FF2 + co) + acc[h] * *(const f32x4*)(cw + 2 * FF2 + co) + *(const f32x4*)(cb + co);
            *(f32x4*)(so + co) = s1; *(f32x4*)(so + FF2 + co) = acc[h]; }
        u32x2 wv; wv.x = pk2(gelu_tanh(c[0].x) * c[1].x, gelu_tanh(c[0].y) * c[1].y); wv.y = pk2(gelu_tanh(c[0].z) * c[1].z, gelu_tanh(c[0].w) * c[1].w);
        *(u32x2*)(WSP(bf16, WS_ACT) + (size_t)(MP + b) * FF + ca) = wv;
    }
}

template <size_t AROW, size_t AH, size_t BB, size_t BH>
struct OrderAttn {
    int G, c; const char* A; const char* Bt;
    DI bool next(int i, pg8::Unit& u) const {
        const long L = (long)i * G + c; if (L >= 256) return false;
        const int b = (int)L >> 5, h = ((int)L >> 3) & 3, rb = (int)L & 7;
        u.pm = b * 8 + rb; u.pn = h;
        u.a = A + (size_t)u.pm * 256 * AROW + (size_t)h * AH;
        u.b = Bt + (size_t)b * BB + (size_t)h * BH; return true;
    }
};

template <class GE>
DI void skinny_job(Frame& F, const bf16* A, int lda, const bf16* Bt, int ldb, int K, const GE& ge, int col_out) {
    const int tid = opaque_tid(), lane = tid & 63, wid = __builtin_amdgcn_readfirstlane(tid >> 6), fr = lane & 15, fq = lane >> 4, row = wid * 16 + fr;
    const bf16* ap = A + (size_t)row * lda + fq * 8;
    const bf16* b0 = Bt + (size_t)fr * ldb + fq * 8; const bf16* b1 = b0 + (size_t)16 * ldb;
    f32x4 acc0 = (f32x4){0.f, 0.f, 0.f, 0.f}, acc1 = acc0;
#pragma unroll 8
    for (int k0 = 0; k0 < K; k0 += 32) {
        const bf16x8 a = *(const bf16x8*)(ap + k0), x0 = *(const bf16x8*)(b0 + k0), x1 = *(const bf16x8*)(b1 + k0);
        acc0 = __builtin_amdgcn_mfma_f32_16x16x32_bf16(x0, a, acc0, 0, 0, 0);
        acc1 = __builtin_amdgcn_mfma_f32_16x16x32_bf16(x1, a, acc1, 0, 0, 0);
    }
    ge(MP + row, col_out + fq * 4, acc0); ge(MP + row, col_out + 16 + fq * 4, acc1);
}
template <class GE>
DI void skinny_gemm(Frame& F, const bf16* A, int lda, const bf16* Bt, int ldb, int N, int K, const GE& ge) {
    for (int job = F.vcu; job < N / 32; job += F.G) skinny_job(F, A, lda, Bt + (size_t)job * 32 * ldb, ldb, K, ge, job * 32);
}

DI void transpose_item(const float* W, int ldw, int K, bf16* WT, int k0, int n0src, int n0dst, LAS float* scr, int lane) {
#pragma unroll 16
    for (int k = 0; k < 64; ++k) scr[k * 65 + lane] = W[(size_t)(k0 + k) * ldw + n0src + lane];
    LDS_WAIT(); asm volatile("" ::: "memory");
    const int c = lane & 7;
#pragma unroll
    for (int j = 0; j < 8; ++j) { const int n = (lane >> 3) + 8 * j; const LAS float* sp = scr + (8 * c) * 65 + n;
        u32x4 o; o.x = pk2(sp[0 * 65], sp[1 * 65]); o.y = pk2(sp[2 * 65], sp[3 * 65]); o.z = pk2(sp[4 * 65], sp[5 * 65]); o.w = pk2(sp[6 * 65], sp[7 * 65]);
        *(u32x4*)(WT + (size_t)(n0dst + n) * K + k0 + 8 * c) = o; }
    LDS_WAIT(); asm volatile("" ::: "memory");
}
DI void mat_item(const float* W, int ldw, int K, int N, bf16* WT, int item, LAS float* scr, int lane, int shift_at) {
    const int nblk = N / 64, kb = item / nblk, nb = item % nblk, n0 = 64 * nb;
    transpose_item(W, ldw, K, WT, 64 * kb, n0 + (n0 >= shift_at ? 8 : 0), n0, scr, lane);
}
DI void phase_convert(Frame& F) {
    const int tid = opaque_tid(), lane = tid & 63, wid = __builtin_amdgcn_readfirstlane(tid >> 6);
    LAS float* scr = (LAS float*)(F.lds + wid * 16640);
    const int gw = F.vcu * 8 + wid, NGW = F.G * 8;
    constexpr int I_IN = 16 * 144, I_SQ = 16 * 16, I_KV = 16 * 32, I_UP = 16 * 88, I_DN = 44 * 16, I_P = 4 * 4;
    constexpr int PER_L = I_IN + 3 * I_SQ + I_KV + I_UP + I_DN + 4 * I_P;
    for (int it = gw; it < DEPTH * PER_L; it += NGW) {
        const int l = it / PER_L; int r = it % PER_L;
        if (r < I_IN) { mat_item(((const float*)F.in[12]) + (size_t)l * D * INW, INW, D, NPROJ, WSP(bf16, WS_WIN + l * SZ_WIN), r, scr, lane, 4096); continue; } r -= I_IN;
        if (r < I_SQ) { mat_item(((const float*)F.in[15]) + (size_t)l * D * D, D, D, D, WSP(bf16, WS_WM + l * SZ_W1K), r, scr, lane, 1 << 30); continue; } r -= I_SQ;
        if (r < I_SQ) { mat_item(((const float*)F.in[19]) + (size_t)l * D * D, D, D, D, WSP(bf16, WS_WX + l * SZ_W1K), r, scr, lane, 1 << 30); continue; } r -= I_SQ;
        if (r < I_SQ) { mat_item(((const float*)F.in[20]) + (size_t)l * D * D, D, D, D, WSP(bf16, WS_WO + l * SZ_W1K), r, scr, lane, 1 << 30); continue; } r -= I_SQ;
        if (r < I_KV) { mat_item(((const float*)F.in[18]) + (size_t)l * D * 2048, 2048, D, 2048, WSP(bf16, WS_WKV + l * SZ_WKV), r, scr, lane, 1 << 30); continue; } r -= I_KV;
        if (r < I_UP) { const int kb = r / 88, nb = r % 88, u = nb >> 2, q = nb & 3;
            transpose_item(((const float*)F.in[23]) + (size_t)l * D * FF2, FF2, D, WSP(bf16, WS_WUP + l * SZ_WUP), 64 * kb, (q >> 1) * FF + 128 * u + (q & 1) * 64, 64 * nb, scr, lane); continue; } r -= I_UP;
        if (r < I_DN) { mat_item(((const float*)F.in[26]) + (size_t)l * FF * D, D, FF, D, WSP(bf16, WS_WDN + l * SZ_WDN), r, scr, lane, 1 << 30); continue; } r -= I_DN;
        { const int g = r / I_P, ri = r % I_P; mat_item(((const float*)F.in[16]) + ((size_t)l * 4 + g) * 65536, 256, 256, 256, WSP(bf16, WS_WP + l * SZ_WP) + (size_t)g * 65536, ri, scr, lane, 1 << 30); }
    }
    { const float* mem = ((const float*)F.in[1]); bf16* mb = WSP(bf16, WS_MEMB);
      for (size_t i = ((size_t)F.vcu * 512 + tid) * 8; i < (size_t)2048 * D; i += (size_t)F.G * 512 * 8) {
          const f32x4 a = *(const f32x4*)(mem + i), b = *(const f32x4*)(mem + i + 4);
          u32x4 o; o.x = pk2(a.x, a.y); o.y = pk2(a.z, a.w); o.z = pk2(b.x, b.y); o.w = pk2(b.z, b.w); *(u32x4*)(mb + i) = o; } }
}

DI void stage_gate_w(Frame& F, int l) {
    LAS float* wg = (LAS float*)F.lds;
    const float* w = ((const float*)F.in[12]) + (size_t)l * D * INW + 4096;
    for (int i = opaque_tid(); i < 8192; i += 512) { const int k = i >> 3, j = i & 7; wg[j * 1024 + k] = w[(size_t)k * INW + j]; }
    __syncthreads();
}
DI void ln_row(Frame& F, const int lane, const float* src, const float* gam, const float* bet, int row, int lg, float* fin) {
    const f32x4* xr = (const f32x4*)src + lane;
    f32x4 v[4]; float s = 0.f;
#pragma unroll
    for (int j = 0; j < 4; ++j) { v[j] = xr[64 * j]; s += (v[j].x + v[j].y) + (v[j].z + v[j].w); }
    const float mean = wave_sum(s) * (1.f / D); float s2 = 0.f;
#pragma unroll
    for (int j = 0; j < 4; ++j) { v[j] = v[j] - mean; s2 += (v[j].x * v[j].x + v[j].y * v[j].y) + (v[j].z * v[j].z + v[j].w * v[j].w); }
    const float rstd = 1.f / sqrtf(wave_sum(s2) * (1.f / D) + LN_EPS);
    f32x4* xo = (f32x4*)(WSP(float, WS_X) + (size_t)row * D) + lane;
    u32x2* no = (u32x2*)(WSP(bf16, WS_XN) + (size_t)row * D) + lane;
#pragma unroll
    for (int j = 0; j < 4; ++j) {
        const f32x4 g = ((const f32x4*)gam)[lane + 64 * j], b = ((const f32x4*)bet)[lane + 64 * j];
        v[j] = v[j] * rstd * g + b;
        xo[64 * j] = v[j];
        u32x2 w; w.x = pk2(v[j].x, v[j].y); w.y = pk2(v[j].z, v[j].w); no[64 * j] = w;
        if (fin) ((f32x4*)fin)[lane + 64 * j] = v[j];
    }
    if (lg >= 0) {
        const LAS float* wg = (const LAS float*)F.lds;
        float a[8];
#pragma unroll
        for (int q = 0; q < 8; ++q) { float t = 0.f;
#pragma unroll
            for (int j = 0; j < 4; ++j) { const f32x4 w = *(const LAS f32x4*)(wg + q * 1024 + 4 * lane + 256 * j); t += (v[j].x * w.x + v[j].y * w.y) + (v[j].z * w.z + v[j].w * w.w); }
            a[q] = wave_sum(t); }
        if (lane == 0) { const float* bb = ((const float*)F.in[13]) + (size_t)lg * INW + 4096; float* o = WSP(float, WS_IGFG) + (size_t)row * 8;
#pragma unroll
            for (int q = 0; q < 8; ++q) o[q] = a[q] + bb[q]; }
    }
}
DI void phase_ln_in(Frame& F) {
    stage_gate_w(F, 0);
    const int tid = opaque_tid(), lane = tid & 63, wid = __builtin_amdgcn_readfirstlane(tid >> 6);
    const int gw = F.vcu * 8 + wid, NGW = F.G * 8;
    for (int r = gw; r < MT; r += NGW) {
        const float* src = r < MP ? ((const float*)F.in[0]) + (size_t)r * D : ((const float*)F.in[2]) + (size_t)(r - MP) * D;
        ln_row(F, lane, src, ((const float*)F.in[10]), ((const float*)F.in[11]), r, 0, nullptr);
    }
    __syncthreads();
}
DI void phase_ln(Frame& F, int l, int which) {
    const int lg = (which == 1 && l + 1 < DEPTH) ? l + 1 : -1;
    if (lg >= 0) stage_gate_w(F, lg);
    const float* gam = (const float*)(which ? F.in[27] : F.in[21]) + (size_t)l * D; const float* bet = (const float*)(which ? F.in[28] : F.in[22]) + (size_t)l * D;
    const bool last = (which == 1 && l == DEPTH - 1);
    const int tid = opaque_tid(), lane = tid & 63, wid = __builtin_amdgcn_readfirstlane(tid >> 6);
    const int gw = F.vcu * 8 + wid, NGW = F.G * 8;
    for (int r = gw; r < MT; r += NGW) {
        float* fin = last ? (r < MP ? F.out + O_YP + (size_t)r * D : F.out + O_YS + (size_t)(r - MP) * D) : nullptr;
        ln_row(F, lane, WSP(float, WS_T) + (size_t)r * D, gam, bet, r, lg, fin);
    }
    __syncthreads();
}

constexpr int MP_Q = 0, MP_K = 33792, MP_T2 = 67584, MP_VEC = 104448, MP_END = 104448 + 4 * 6 * 64 * 4;
static_assert(MP_END <= XCH_OFF, "mLSTM prep LDS map");
DI float log_sigmoid(float x) { return fminf(x, 0.f) - log1pf(expf(-fabsf(x))); }
#define DPP_F(oldv, src, ctrl, rmask, bc) __builtin_bit_cast(float, __builtin_amdgcn_update_dpp(__builtin_bit_cast(int, (float)(oldv)), __builtin_bit_cast(int, (float)(src)), ctrl, rmask, 0xf, bc))
DI float wave_scan_add(float v) {
    v += DPP_F(0.f, v, 0x111, 0xf, true); v += DPP_F(0.f, v, 0x112, 0xf, true); v += DPP_F(0.f, v, 0x114, 0xf, true); v += DPP_F(0.f, v, 0x118, 0xf, true);
    v += DPP_F(0.f, v, 0x142, 0xa, true); v += DPP_F(0.f, v, 0x143, 0xc, true); return v; }
DI float wave_scan_max(float v) {
    v = fmaxf(v, DPP_F(v, v, 0x111, 0xf, false)); v = fmaxf(v, DPP_F(v, v, 0x112, 0xf, false)); v = fmaxf(v, DPP_F(v, v, 0x114, 0xf, false)); v = fmaxf(v, DPP_F(v, v, 0x118, 0xf, false));
    v = fmaxf(v, DPP_F(v, v, 0x142, 0xa, false)); v = fmaxf(v, DPP_F(v, v, 0x143, 0xc, false)); return v; }
DI void mlstm_prep_job(Frame& F, int l, int job) {
    const int b = job >> 5, hh = (job >> 3) & 3, c4 = job & 7;
    const int tid = opaque_tid(), lane = tid & 63, wid = __builtin_amdgcn_readfirstlane(tid >> 6), fr = lane & 15, fq = lane >> 4;
    LAS unsigned char* L = F.lds;
    LAS float* vecs = (LAS float*)(L + MP_VEC);
    const bf16* projb = WSP(bf16, WS_PROJ) + (size_t)b * SEQ * NPROJ;
    const size_t bh = (size_t)(b * NH + hh);
    bf16* PTg = WSP(bf16, WS_PT) + bh * 32 * 4096; bf16* KWg = WSP(bf16, WS_KWT) + bh * 32 * 16384; bf16* VTg = WSP(bf16, WS_VTT) + bh * 32 * 16384;
    float* GTg = WSP(float, WS_GT) + bh * 32 * 192;
    if (wid == 0) {
        const float* igfg = WSP(float, WS_IGFG) + (size_t)b * SEQ * 8;
        float mprev = 0.f; const int nch = 4 * c4 + 4;
#pragma unroll 4
        for (int ch = 0; ch < nch; ++ch) {
            const float igv = igfg[(size_t)(ch * 64 + lane) * 8 + hh], fgv = igfg[(size_t)(ch * 64 + lane) * 8 + 4 + hh];
            const float lf = log_sigmoid(fgv);
            const float bb = wave_scan_add(lf);
            const float a = igv - bb; const float cm = wave_scan_max(a);
            const float mt = bb + fmaxf(mprev, cm);
            const float mL = __builtin_bit_cast(float, __builtin_amdgcn_readlane(__builtin_bit_cast(int, mt), 63)), bL = __builtin_bit_cast(float, __builtin_amdgcn_readlane(__builtin_bit_cast(int, bb), 63));
            if (ch >= 4 * c4) {
                const int ci = ch - 4 * c4;
                LAS float* v = vecs + ci * 384;
                v[lane] = a; v[64 + lane] = bb; v[128 + lane] = mt; v[192 + lane] = expf(a + bL - mL);
                float* g = GTg + (size_t)ch * 192;
                g[lane] = expf(mprev + bb - mt); g[64 + lane] = expf(-mt);
                if (lane == 0) g[128] = expf(mprev + bL - mL);
            }
            mprev = mL;
        }
        if (c4 == 7 && lane == 0) F.out[O_PM + (l * NB + b) * NH + hh] = mprev;
    }
    u32x4 q4[4], k4[4], v4[4];
#define MP_LOAD(c) do { const bf16* pr = projb + (size_t)((c) * 64 + lane) * NPROJ + hh * 256 + wid * 32; \
        _Pragma("unroll") for (int i = 0; i < 4; ++i) { q4[i] = *(const u32x4*)(pr + C_Q + i * 8); k4[i] = *(const u32x4*)(pr + C_K + i * 8); v4[i] = *(const u32x4*)(pr + C_V + i * 8); } } while (0)
    MP_LOAD(4 * c4);
    __syncthreads();
    for (int ci = 0; ci < 4; ++ci) {
        const int c = 4 * c4 + ci;
        const LAS float* vec = vecs + ci * 384;
#pragma unroll
        for (int i = 0; i < 4; ++i) { *(LAS u32x4*)(L + MP_Q + lane * 528 + (wid * 32 + i * 8) * 2) = q4[i]; *(LAS u32x4*)(L + MP_K + lane * 528 + (wid * 32 + i * 8) * 2) = k4[i]; }
        { const float w = vec[192 + lane] * 0.0625f;
#pragma unroll
          for (int i = 0; i < 4; ++i) { float kf[8]; unpack8(k4[i], kf);
#pragma unroll
            for (int j = 0; j < 8; ++j) ((LAS unsigned short*)(L + MP_T2))[(wid * 32 + i * 8 + j) * 72 + lane] = (unsigned short)f2bf(kf[j] * w); } }
        u32x4 vc4[4];
#pragma unroll
        for (int i = 0; i < 4; ++i) vc4[i] = v4[i];
        __syncthreads();
        if (ci + 1 < 4) MP_LOAD(c + 1);
        { const int tt = wid >> 1;
#pragma unroll
          for (int si = 0; si < 2; ++si) { const int st = (wid & 1) * 2 + si;
            f32x4 acc = (f32x4){0.f, 0.f, 0.f, 0.f};
            if (st <= tt) {
#pragma unroll
                for (int kk = 0; kk < 8; ++kk) { const bf16x8 kf = *(const LAS bf16x8*)(L + MP_K + (st * 16 + fr) * 528 + (kk * 32 + fq * 8) * 2), qf = *(const LAS bf16x8*)(L + MP_Q + (tt * 16 + fr) * 528 + (kk * 32 + fq * 8) * 2);
                    acc = __builtin_amdgcn_mfma_f32_16x16x32_bf16(kf, qf, acc, 0, 0, 0); }
            }
            const int t = tt * 16 + fr, s0 = st * 16 + fq * 4; const float bt = vec[64 + t] - vec[128 + t];
            float p[4];
#pragma unroll
            for (int j = 0; j < 4; ++j) { const int s = s0 + j; p[j] = (s <= t) ? acc[j] * 0.0625f * __expf(vec[s] + bt) : 0.f; }
            u32x2 w; w.x = pk2(p[0], p[1]); w.y = pk2(p[2], p[3]); *(u32x2*)(PTg + (size_t)c * 4096 + t * 64 + s0) = w; } }
        { const int d = tid >> 1, hf = tid & 1; bf16* o = KWg + (size_t)c * 16384 + d * 64 + hf * 32;
#pragma unroll
          for (int i = 0; i < 4; ++i) *(u32x4*)(o + i * 8) = *(const LAS u32x4*)(L + MP_T2 + d * 144 + hf * 64 + i * 16); }
        __syncthreads();
#pragma unroll
        for (int i = 0; i < 4; ++i) { const unsigned ww[4] = {vc4[i].x, vc4[i].y, vc4[i].z, vc4[i].w};
#pragma unroll
            for (int j = 0; j < 4; ++j) { ((LAS unsigned short*)(L + MP_T2))[(wid * 32 + i * 8 + 2 * j) * 72 + lane] = (unsigned short)(ww[j] & 0xffffu); ((LAS unsigned short*)(L + MP_T2))[(wid * 32 + i * 8 + 2 * j + 1) * 72 + lane] = (unsigned short)(ww[j] >> 16); } }
        __syncthreads();
        { const int d = tid >> 1, hf = tid & 1; bf16* o = VTg + (size_t)c * 16384 + d * 64 + hf * 32;
#pragma unroll
          for (int i = 0; i < 4; ++i) *(u32x4*)(o + i * 8) = *(const LAS u32x4*)(L + MP_T2 + d * 144 + hf * 64 + i * 16); }
        __syncthreads();
    }
#undef MP_LOAD
}

constexpr int MR_CT = 0, MR_NUM = 25344, MR_DEN = 33536, MR_END = 34048;
DI void mlstm_rec_job(Frame& F, int l, int job) {
    const int b = job >> 5, hh = (job >> 3) & 3, sl = job & 7;
    const int tid = opaque_tid(), lane = tid & 63, wid = __builtin_amdgcn_readfirstlane(tid >> 6), fr = lane & 15, fq = lane >> 4;
    const int tt = wid >> 1, et = wid & 1, t = tt * 16 + fr;
    LAS unsigned char* L = F.lds;
    const size_t bh = (size_t)(b * NH + hh);
    const bf16* qp = WSP(bf16, WS_PROJ) + ((size_t)b * SEQ + t) * NPROJ + C_Q + hh * 256 + fq * 8;
    const bf16* pp = WSP(bf16, WS_PT) + bh * 32 * 4096 + t * 64 + fq * 8;
    const bf16* kp = WSP(bf16, WS_KWT) + bh * 32 * 16384 + (wid * 32 + fr) * 64 + fq * 8;
    const bf16* vp = WSP(bf16, WS_VTT) + bh * 32 * 16384 + (sl * 32 + fr) * 64 + fq * 8;
    const float* gp = WSP(float, WS_GT) + bh * 32 * 192;
    const int ht = tid >> 3, he0 = (tid & 7) * 4;
    const bf16* sop = WSP(bf16, WS_PROJ) + ((size_t)b * SEQ + ht) * NPROJ + C_O + hh * 256 + sl * 32 + he0;
    bf16* hc = WSP(bf16, WS_HC) + ((size_t)b * SEQ + ht) * D + hh * 256 + sl * 32 + he0;
    for (int i = tid; i < 25344 / 4; i += 512) ((LAS unsigned*)(L + MR_CT))[i] = 0u;
    f32x4 cacc[2][3];
#pragma unroll
    for (int i = 0; i < 2; ++i)
#pragma unroll
        for (int j = 0; j < 3; ++j) cacc[i][j] = (f32x4){0.f, 0.f, 0.f, 0.f};
    bf16x8 ones; { const short o = (fr == 0) ? (short)0x3F80 : (short)0;
#pragma unroll
        for (int j = 0; j < 8; ++j) ones[j] = o; }
    bf16x8 qf[8], pf[2], kfA[2][2], vfA[2][2], kfB[2][2], vfB[2][2]; float interA, enmA, decA, interB, enmB, decB; u32x2 soA, soB;
#define MR_LOADQP(c) do { \
        _Pragma("unroll") for (int kk = 0; kk < 8; ++kk) qf[kk] = *(const bf16x8*)(qp + (size_t)(c) * 64 * NPROJ + kk * 32); \
        _Pragma("unroll") for (int ks = 0; ks < 2; ++ks) pf[ks] = *(const bf16x8*)(pp + (size_t)(c) * 4096 + ks * 32); } while (0)
#define MR_LOADKV(S, c) do { \
        _Pragma("unroll") for (int ks = 0; ks < 2; ++ks) { \
            _Pragma("unroll") for (int x = 0; x < 2; ++x) { kf##S[x][ks] = *(const bf16x8*)(kp + (size_t)(c) * 16384 + x * 1024 + ks * 32); vf##S[x][ks] = *(const bf16x8*)(vp + (size_t)(c) * 16384 + x * 1024 + ks * 32); } } \
        inter##S = gp[(c) * 192 + t]; enm##S = gp[(c) * 192 + 64 + ht]; dec##S = gp[(c) * 192 + 128]; so##S = *(const u32x2*)(sop + (size_t)(c) * 64 * NPROJ); } while (0)
#define MR_BODY(S, N, c) do { \
          \
        f32x4 aP = (f32x4){0.f, 0.f, 0.f, 0.f}, aC0 = aP, aC1 = aP, dP = aP, dC = aP; \
        bf16x8 cf[8], c2[4]; \
        _Pragma("unroll") for (int kk = 0; kk < 8; ++kk) cf[kk] = *(const LAS bf16x8*)(L + MR_CT + (et * 16 + fr) * 528 + (kk * 32 + fq * 8) * 2); \
        _Pragma("unroll") for (int kk = 0; kk < 4; ++kk) c2[kk] = *(const LAS bf16x8*)(L + MR_CT + (32 + fr) * 528 + ((et * 4 + kk) * 32 + fq * 8) * 2); \
        if (et == 0) { _Pragma("unroll") for (int ks = 0; ks < 2; ++ks) { aP = __builtin_amdgcn_mfma_f32_16x16x32_bf16(vf##S[0][ks], pf[ks], aP, 0, 0, 0); dP = __builtin_amdgcn_mfma_f32_16x16x32_bf16(ones, pf[ks], dP, 0, 0, 0); } \
            _Pragma("unroll") for (int kk = 0; kk < 4; ++kk) dC = __builtin_amdgcn_mfma_f32_16x16x32_bf16(c2[kk], qf[kk], dC, 0, 0, 0); } \
        else { _Pragma("unroll") for (int ks = 0; ks < 2; ++ks) aP = __builtin_amdgcn_mfma_f32_16x16x32_bf16(vf##S[1][ks], pf[ks], aP, 0, 0, 0); \
            _Pragma("unroll") for (int kk = 0; kk < 4; ++kk) dC = __builtin_amdgcn_mfma_f32_16x16x32_bf16(c2[kk], qf[4 + kk], dC, 0, 0, 0); } \
        _Pragma("unroll") for (int kk = 0; kk < 8; kk += 2) { aC0 = __builtin_amdgcn_mfma_f32_16x16x32_bf16(cf[kk], qf[kk], aC0, 0, 0, 0); aC1 = __builtin_amdgcn_mfma_f32_16x16x32_bf16(cf[kk + 1], qf[kk + 1], aC1, 0, 0, 0); } \
        __builtin_amdgcn_sched_barrier(0); \
        if ((c) + 1 < SEQ / 64) { MR_LOADQP((c) + 1); MR_LOADKV(N, (c) + 1); } \
        __builtin_amdgcn_sched_barrier(0); \
        *(LAS f32x4*)(L + MR_NUM + (t * 32 + et * 16 + fq * 4) * 4) = aP + (aC0 + aC1) * inter##S; \
        if (fq == 0) ((LAS float*)(L + MR_DEN))[t * 2 + et] = dP.x + dC.x * inter##S; \
        __syncthreads();                                                      \
          \
        { const f32x4 nm = *(const LAS f32x4*)(L + MR_NUM + (ht * 32 + he0) * 4); const float den = ((LAS float*)(L + MR_DEN))[ht * 2] + ((LAS float*)(L + MR_DEN))[ht * 2 + 1]; \
          const float inv = 1.0f / fmaxf(fabsf(den), enm##S); \
          u32x2 w; w.x = pk2(lo16(so##S.x) * nm.x * inv, hi16(so##S.x) * nm.y * inv); w.y = pk2(lo16(so##S.y) * nm.z * inv, hi16(so##S.y) * nm.w * inv); \
          *(u32x2*)(hc + (size_t)(c) * 64 * D) = w; } \
          \
        _Pragma("unroll") for (int di = 0; di < 2; ++di) { \
            _Pragma("unroll") for (int e3 = 0; e3 < 3; ++e3) { f32x4 a = cacc[di][e3] * dec##S; \
                _Pragma("unroll") for (int ks = 0; ks < 2; ++ks) a = __builtin_amdgcn_mfma_f32_16x16x32_bf16(kf##S[di][ks], e3 == 2 ? ones : vf##S[e3 & 1][ks], a, 0, 0, 0); \
                cacc[di][e3] = a; \
                u32x2 w; w.x = pk2(a.x, a.y); w.y = pk2(a.z, a.w); *(LAS u32x2*)(L + MR_CT + (e3 * 16 + fr) * 528 + ((wid * 2 + di) * 16 + fq * 4) * 2) = w; } } \
        __syncthreads();                                                      \
    } while (0)
    MR_LOADQP(0); MR_LOADKV(A, 0);
    __syncthreads();
#pragma unroll 1
    for (int c = 0; c < SEQ / 64; c += 2) { MR_BODY(A, B, c); MR_BODY(B, A, c + 1); }
#undef MR_BODY
#undef MR_LOADKV
#undef MR_LOADQP
    { float* pc = F.out + O_PC + ((size_t)((l * NB + b) * NH + hh)) * 65536;
#pragma unroll
      for (int di = 0; di < 2; ++di) { const int dt = wid * 2 + di;
#pragma unroll
        for (int e3 = 0; e3 < 2; ++e3)
#pragma unroll
            for (int j = 0; j < 4; ++j) pc[(size_t)(dt * 16 + fq * 4 + j) * 256 + sl * 32 + e3 * 16 + fr] = cacc[di][e3][j];
        if (sl == 0 && fr == 0) { float* pn = F.out + O_PN + ((size_t)((l * NB + b) * NH + hh)) * 256;
#pragma unroll
            for (int j = 0; j < 4; ++j) pn[dt * 16 + fq * 4 + j] = cacc[di][2][j]; } } }
    __syncthreads();
}

DI void mlstm_sample_job(Frame& F, int l, int job) {
    const int b = job >> 2, hh = job & 3; const int tid = opaque_tid(), lane = tid & 63, wid = __builtin_amdgcn_readfirstlane(tid >> 6);
    LAS float* qs = (LAS float*)F.lds;
    LAS float* kws = qs + 256; LAS float* red = qs + 512; LAS float* scal = qs + 512 + 2048;
    const bf16* prow = WSP(bf16, WS_PROJ) + (size_t)(MP + b) * NPROJ;
    const size_t sidx = (size_t)((l * MS + b) * NH + hh);
    const float* C = ((const float*)F.in[5]) + sidx * 65536; const float* nst = ((const float*)F.in[6]) + sidx * 256; float* Cn = F.out + O_SC + sidx * 65536;
    const float ig = WSP(float, WS_IGFG)[(size_t)(MP + b) * 8 + hh], fg = WSP(float, WS_IGFG)[(size_t)(MP + b) * 8 + 4 + hh];
    const float m0 = ((const float*)F.in[7])[sidx];
    const float lf = log_sigmoid(fg), mt = fmaxf(m0 + lf, ig), inter = expf(m0 + lf - mt), wsi = expf(ig - mt);
    if (tid < 256) {
        const float q = bf2f(prow[C_Q + hh * 256 + tid]), k = bf2f(prow[C_K + hh * 256 + tid]) * 0.0625f;
        qs[tid] = q; kws[tid] = k * wsi;
        const float n0 = nst[tid];
        F.out[O_SN + sidx * 256 + tid] = inter * n0 + k * wsi;
        float qk = q * k, qn = q * n0;
        qk = wave_sum(qk); qn = wave_sum(qn);
        if (lane == 0) { scal[wid * 2] = qk; scal[wid * 2 + 1] = qn; }
    }
    __syncthreads();
    const float qk = scal[0] + scal[2] + scal[4] + scal[6], qn = scal[1] + scal[3] + scal[5] + scal[7];
    const float s = qk * wsi, den = s + inter * qn, inv = 1.0f / fmaxf(fabsf(den), expf(-mt));
    const u32x2 vw = *(const u32x2*)(prow + C_V + hh * 256 + lane * 4);
    const f32x4 v4 = (f32x4){lo16(vw.x), hi16(vw.x), lo16(vw.y), hi16(vw.y)};
    f32x4 acc = (f32x4){0.f, 0.f, 0.f, 0.f};
#pragma unroll 8
    for (int i = 0; i < 32; ++i) { const int d = wid * 32 + i; const f32x4 c = *(const f32x4*)(C + (size_t)d * 256 + lane * 4);
        acc += c * qs[d]; *(f32x4*)(Cn + (size_t)d * 256 + lane * 4) = c * inter + v4 * kws[d]; }
    *(LAS f32x4*)(red + wid * 256 + lane * 4) = acc;
    __syncthreads();
    if (tid < 256) { float qc = 0.f;
#pragma unroll
        for (int w = 0; w < 8; ++w) qc += red[w * 256 + tid];
        const float v = bf2f(prow[C_V + hh * 256 + tid]), so = bf2f(prow[C_O + hh * 256 + tid]);
        const float h = (s * v + inter * qc) * inv;
        WSP(bf16, WS_HC)[(size_t)(MP + b) * D + hh * 256 + tid] = (bf16)f2bf(so * h); }
    if (tid == 0) F.out[O_SM + sidx] = mt;
    __syncthreads();
}

DI void xattn_sample_job(Frame& F, int l, int job) {
    const int b = job >> 1, hp = job & 1; const int tid = opaque_tid(), lane = tid & 63, wid = __builtin_amdgcn_readfirstlane(tid >> 6);
    LAS float* sc = (LAS float*)F.lds;
    const bf16* prow = WSP(bf16, WS_XQ) + (size_t)(MP + b) * D + hp * 512;
    const float* Kc = ((const float*)F.in[3]) + ((size_t)(l * MS + b) * NMEM) * 1024 + hp * 512;
    const float* Vc = ((const float*)F.in[4]) + ((size_t)(l * MS + b) * NMEM) * 1024 + hp * 512;
    float q[8]; { const u32x4 w = *(const u32x4*)(prow + lane * 8); unpack8(w, q); }
#pragma unroll 8
    for (int i = 0; i < 32; ++i) { const int m = wid + 8 * i; const f32x4 k0 = *(const f32x4*)(Kc + (size_t)m * 1024 + lane * 8), k1 = *(const f32x4*)(Kc + (size_t)m * 1024 + lane * 8 + 4);
        float t = (q[0] * k0.x + q[1] * k0.y) + (q[2] * k0.z + q[3] * k0.w) + (q[4] * k1.x + q[5] * k1.y) + (q[6] * k1.z + q[7] * k1.w);
#pragma unroll
        for (int o = 1; o < 32; o <<= 1) t += __shfl_xor(t, o);
        if ((lane & 31) == 0) sc[(lane >> 5) * 256 + m] = t * 0.0625f; }
    __syncthreads();
    if (wid < 2) { float x[4]; float mx = -3.0e38f;
#pragma unroll
        for (int j = 0; j < 4; ++j) { x[j] = sc[wid * 256 + lane + 64 * j]; mx = fmaxf(mx, x[j]); }
#pragma unroll
        for (int o = 1; o < 64; o <<= 1) mx = fmaxf(mx, __shfl_xor(mx, o));
        float s = 0.f;
#pragma unroll
        for (int j = 0; j < 4; ++j) { x[j] = expf(x[j] - mx); s += x[j]; }
        s = wave_sum(s); const float inv = 1.0f / s;
#pragma unroll
        for (int j = 0; j < 4; ++j) sc[wid * 256 + lane + 64 * j] = x[j] * inv; }
    __syncthreads();
    {
      const int kg = tid >> 7, c4 = (tid & 127) * 4, hsel = c4 >> 8; f32x4 acc = (f32x4){0.f, 0.f, 0.f, 0.f};
#pragma unroll 16
      for (int i = 0; i < 64; ++i) { const int m = kg * 64 + i; acc += *(const f32x4*)(Vc + (size_t)m * 1024 + c4) * sc[hsel * 256 + m]; }
      LAS f32x4* red = (LAS f32x4*)(sc + 512);
      red[kg * 128 + (tid & 127)] = acc;
      __syncthreads();
      if (tid < 128) { const f32x4 r = (red[tid] + red[128 + tid]) + (red[256 + tid] + red[384 + tid]);
          u32x2 w; w.x = pk2(r.x, r.y); w.y = pk2(r.z, r.w); *(u32x2*)(WSP(bf16, WS_OX) + (size_t)(MP + b) * D + hp * 512 + tid * 4) = w; } }
    __syncthreads();
}

DI void phase_pool_d(Frame& F, int l) {
    const bf16* proj = WSP(bf16, WS_PROJ); bf16* dp = WSP(bf16, WS_DP);
    const int gt = F.vcu * 512 + opaque_tid(), gs = F.G * 512;
    for (int it = gt; it < (MP / 16) * 128; it += gs) {
        const int rb = (int)(it >> 7), cg = (int)(it & 127), row0 = rb * 16, t0 = row0 & (SEQ - 1), b = row0 >> 11, w = 2 << (cg >> 5);
        const bf16* up = proj + (size_t)row0 * NPROJ + C_U + cg * 8;
        float sum[8];
#pragma unroll
        for (int j = 0; j < 8; ++j) sum[j] = 0.f;
        for (int i = 1; i < w; ++i) if (t0 - i >= 0) { float f[8]; unpack8(*(const u32x4*)(up - (size_t)i * NPROJ), f);
#pragma unroll
            for (int j = 0; j < 8; ++j) sum[j] += f[j]; }
#pragma unroll 4
        for (int r = 0; r < 16; ++r) {
            const int t = t0 + r; float u0[8]; unpack8(*(const u32x4*)(up + (size_t)r * NPROJ), u0);
#pragma unroll
            for (int j = 0; j < 8; ++j) sum[j] += u0[j];
            const int nw = (t + 1 < w) ? t + 1 : w; const float inv = 1.0f / (float)nw;
            u32x4 o; o.x = pk2(sum[0] * inv - u0[0], sum[1] * inv - u0[1]); o.y = pk2(sum[2] * inv - u0[2], sum[3] * inv - u0[3]); o.z = pk2(sum[4] * inv - u0[4], sum[5] * inv - u0[5]); o.w = pk2(sum[6] * inv - u0[6], sum[7] * inv - u0[7]);
            *(u32x4*)(dp + (size_t)(row0 + r) * D + cg * 8) = o;
            if (t >= SEQ - 15) { float* pp = F.out + O_PPOOL + ((size_t)(l * NB + b) * 15 + (t - (SEQ - 15))) * 1024 + cg * 8;
                *(f32x4*)pp = (f32x4){u0[0], u0[1], u0[2], u0[3]}; *(f32x4*)(pp + 4) = (f32x4){u0[4], u0[5], u0[6], u0[7]}; }
            if (t - (w - 1) >= 0) { float f[8]; unpack8(*(const u32x4*)(up + (size_t)(r - (w - 1)) * NPROJ), f);
#pragma unroll
                for (int j = 0; j < 8; ++j) sum[j] -= f[j]; }
        }
    }
    for (int it = gt; it < MS * 128; it += gs) {
        const int b = (int)(it >> 7), cg = (int)(it & 127), w = 2 << (cg >> 5);
        const float* sp = ((const float*)F.in[8]) + ((size_t)(l * MS + b) * 15) * 1024 + cg * 8;
        float u0[8], sum[8]; { const u32x4 x = *(const u32x4*)(proj + (size_t)(MP + b) * NPROJ + C_U + cg * 8); unpack8(x, u0); }
#pragma unroll
        for (int j = 0; j < 8; ++j) sum[j] = u0[j];
        for (int i = 1; i < w; ++i) { const f32x4 a = *(const f32x4*)(sp + (size_t)(15 - i) * 1024), c = *(const f32x4*)(sp + (size_t)(15 - i) * 1024 + 4);
            sum[0] += a.x; sum[1] += a.y; sum[2] += a.z; sum[3] += a.w; sum[4] += c.x; sum[5] += c.y; sum[6] += c.z; sum[7] += c.w; }
        const float inv = 1.0f / (float)w;
        u32x4 o; o.x = pk2(sum[0] * inv - u0[0], sum[1] * inv - u0[1]); o.y = pk2(sum[2] * inv - u0[2], sum[3] * inv - u0[3]); o.z = pk2(sum[4] * inv - u0[4], sum[5] * inv - u0[5]); o.w = pk2(sum[6] * inv - u0[6], sum[7] * inv - u0[7]);
        *(u32x4*)(dp + (size_t)(MP + b) * D + cg * 8) = o;
        float* so = F.out + O_SPOOL + ((size_t)(l * MS + b) * 15) * 1024 + cg * 8;
        for (int i = 0; i < 14; ++i) { *(f32x4*)(so + (size_t)i * 1024) = *(const f32x4*)(sp + (size_t)(i + 1) * 1024); *(f32x4*)(so + (size_t)i * 1024 + 4) = *(const f32x4*)(sp + (size_t)(i + 1) * 1024 + 4); }
        *(f32x4*)(so + (size_t)14 * 1024) = (f32x4){u0[0], u0[1], u0[2], u0[3]}; *(f32x4*)(so + (size_t)14 * 1024 + 4) = (f32x4){u0[4], u0[5], u0[6], u0[7]};
    }
}

DI void phase_headnorm(Frame& F, int l) {
    const bf16* hc = WSP(bf16, WS_HC); bf16* hn = WSP(bf16, WS_HN); const float* g = ((const float*)F.in[14]) + (size_t)l * D;
    const int tid = opaque_tid(), lane = tid & 63, wid = __builtin_amdgcn_readfirstlane(tid >> 6);
    const int gw = F.vcu * 8 + wid, NGW = F.G * 8;
    for (int it = gw; it < MT * 4; it += NGW) {
        const size_t off = (size_t)(it >> 2) * D + (it & 3) * 256 + lane * 4;
        const u32x2 w = *(const u32x2*)(hc + off);
        float x0 = lo16(w.x), x1 = hi16(w.x), x2 = lo16(w.y), x3 = hi16(w.y);
        const float mu = wave_sum((x0 + x1) + (x2 + x3)) * (1.f / 256.f);
        x0 -= mu; x1 -= mu; x2 -= mu; x3 -= mu;
        const float var = wave_sum((x0 * x0 + x1 * x1) + (x2 * x2 + x3 * x3)) * (1.f / 256.f);
        const float r = 1.f / sqrtf(var + LN_EPS);
        const f32x4 gg = *(const f32x4*)(g + (it & 3) * 256 + lane * 4);
        u32x2 o; o.x = pk2(x0 * r * gg.x, x1 * r * gg.y); o.y = pk2(x2 * r * gg.z, x3 * r * gg.w);
        *(u32x2*)(hn + off) = o;
    }
}

constexpr int PH_PER_L = 10, PH_TOTAL = 2 + DEPTH * PH_PER_L;
struct Args { const float* in[29]; float* out; unsigned char* ws; int ph_lo, ph_hi, li, pad; };
__global__ void __launch_bounds__(512, 2) trunk_fwd(Args args) {
    extern __shared__ __attribute__((aligned(16))) unsigned char lds_raw[];
    Frame F0;
    F0.lds = (LAS unsigned char*)lds_raw;
    F0.G = gridDim.x; { const int bx = blockIdx.x; F0.vcu = (F0.G % 8 == 0) ? (bx % 8) * (F0.G / 8) + bx / 8 : bx; }
    F0.in = (in_tab_t)__builtin_amdgcn_kernarg_segment_ptr(); F0.out = args.out; F0.ws = args.ws;
    volatile LAS unsigned* MISC = (volatile LAS unsigned*)(F0.lds + MISC_OFF);
    if (threadIdx.x < 64) MISC[threadIdx.x] = 0u;
    __syncthreads();
    unsigned* ctl = (unsigned*)(args.ws + WS_CTL);
    XcdBarrier bar = xcd_barrier_post(ctl + CW_BAR + args.li * XCD_BAR_WORDS, MISC + 8);
    const int lo = args.ph_lo, hi = args.ph_hi;
#define IN(k) (lo <= (k) && (k) < hi)
#define PM(b) ((PHMASK >> (b)) & 1u)
#define SEAM(k) do { if (IN(k) && IN((k) + 1)) xcd_barrier(bar); } while (0)
    const int bx0 = (int)blockIdx.x;

    _Pragma("unroll 1") for (int rep = 0; rep <= REP(16); ++rep) if (PM(0) && IN(0)) { if (rep) xcd_barrier(bar); PHASE_BEGIN(F); phase_convert(F); __syncthreads(); phase_ln_in(F); }
    SEAM(0);
    _Pragma("unroll 1") for (int rep = 0; rep <= REP(17); ++rep) if (PM(1) && IN(1)) { if (rep) xcd_barrier(bar);
        PHASE_BEGIN(F);
        pg8::OrderMN S; S.init(WSP(bf16, WS_MEMB), D, WSP(bf16, WS_WKV), D, 2048, DEPTH * 2048, F.G, bx);
        pg8::EpiGran<GeKV> E{{F.out, WSP(bf16, WS_MK), WSP(bf16, WS_MVT)}};
        pg8::gemm_phase(F.lds, D, D, D, S, E);
    }
    SEAM(1);
    for (int l = 0; l < DEPTH; ++l) {
        const int p0 = 2 + l * PH_PER_L;
        _Pragma("unroll 1") for (int rep = 0; rep <= REP(0); ++rep) if (PM(2) && IN(p0 + 0)) { if (rep) xcd_barrier(bar);
            PHASE_BEGIN(F);
            const bf16* W = WSP(bf16, WS_WIN + l * SZ_WIN);
            pg8::OrderMN S; S.init(WSP(bf16, WS_XN), D, W, D, MP, NPROJ, F.G, bx);
            pg8::EpiGran<GeIn> E{{WSP(bf16, WS_PROJ), ((const float*)F.in[13]) + (size_t)l * INW, WSP(bf16, WS_XQ)}};
            pg8::gemm_phase(F.lds, D, D, D, S, E);
            skinny_gemm(F, WSP(bf16, WS_XN) + (size_t)MP * D, D, W, D, NPROJ, D, E.g);
        }
        SEAM(p0 + 0);
        _Pragma("unroll 1") for (int rep = 0; rep <= REP(1); ++rep) if (PM(3) && IN(p0 + 1)) { if (rep) xcd_barrier(bar);
            PHASE_BEGIN(F);
            _Pragma("unroll 1") for (int sr = 0; sr <= SREP(0); ++sr) if (SM(0)) for (int j = F.vcu; j < 256; j += F.G) mlstm_prep_job(F, l, j);
            _Pragma("unroll 1") for (int sr = 0; sr <= SREP(1); ++sr) if (SM(1)) {
                OrderAttn<(size_t)D * 2, (size_t)256 * 2, (size_t)256 * D * 2, (size_t)256 * 2> S{F.G, bx, (const char*)WSP(bf16, WS_XQ), (const char*)(WSP(bf16, WS_MK) + (size_t)l * 2048 * D)};
                EpiSoftmax E{WSP(bf16, WS_PB), (LAS float*)(F.lds + XCH_OFF)};
                pg8::gemm_phase(F.lds, 256, D, D, S, E);
            }
            _Pragma("unroll 1") for (int sr = 0; sr <= SREP(2); ++sr) if (SM(2)) for (int j = F.vcu; j < MS * NH; j += F.G) mlstm_sample_job(F, l, j);
            _Pragma("unroll 1") for (int sr = 0; sr <= SREP(3); ++sr) if (SM(3)) for (int j = F.vcu; j < MS * 2; j += F.G) xattn_sample_job(F, l, j);
            _Pragma("unroll 1") for (int sr = 0; sr <= SREP(4); ++sr) if (SM(4)) phase_pool_d(F, l);
        }
        SEAM(p0 + 1);
        _Pragma("unroll 1") for (int rep = 0; rep <= REP(2); ++rep) if (PM(4) && IN(p0 + 2)) { if (rep) xcd_barrier(bar);
            PHASE_BEGIN(F);
            _Pragma("unroll 1") for (int sr = 0; sr <= SREP(5); ++sr) if (SM(5)) for (int j = F.vcu; j < 256; j += F.G) mlstm_rec_job(F, l, j);
            OrderAttn<(size_t)D * 2, (size_t)256 * 2, (size_t)256 * 2, (size_t)256 * 2048 * 2> S{F.G, bx, (const char*)WSP(bf16, WS_PB), (const char*)(WSP(bf16, WS_MVT) + (size_t)l * 1024 * 2048)};
            pg8::EpiGran<GeBf16> E{{WSP(bf16, WS_OX), D}};
            pg8::gemm_phase(F.lds, 256, D, 2048, S, E);
        }
        SEAM(p0 + 2);
        _Pragma("unroll 1") for (int rep = 0; rep <= REP(3); ++rep) if (PM(5) && IN(p0 + 3)) { if (rep) xcd_barrier(bar); PHASE_BEGIN(F); phase_headnorm(F, l); }
        SEAM(p0 + 3);
        _Pragma("unroll 1") for (int rep = 0; rep <= REP(4); ++rep) if (PM(6) && IN(p0 + 4)) { if (rep) xcd_barrier(bar);
            PHASE_BEGIN(F);
            const bf16* proj = WSP(bf16, WS_PROJ); float* mix = WSP(float, WS_MIX); bf16* mixb = WSP(bf16, WS_MIXB); const float* ps = ((const float*)F.in[17]) + (size_t)l * D;
            { const bf16* W = WSP(bf16, WS_WM + l * SZ_W1K); pg8::OrderMN S; S.init(WSP(bf16, WS_HN), D, W, D, MP, D, F.G, bx);
              pg8::EpiGran<GeMix<0>> E{{mix, mixb, proj, ps}}; pg8::gemm_phase(F.lds, D, D, D, S, E);
              skinny_gemm(F, WSP(bf16, WS_HN) + (size_t)MP * D, D, W, D, D, D, E.g); }
            { const bf16* W = WSP(bf16, WS_WP + l * SZ_WP); pg8::OrderMN S; S.init(WSP(bf16, WS_DP), D, W, 256, MP, D, F.G, bx, 512);
              pg8::EpiGran<GeMix<1>> E{{mix, mixb, proj, ps}}; pg8::gemm_phase(F.lds, 256, D, 256, S, E);
              for (int job = F.vcu; job < 32; job += F.G) { const int g = job >> 3;
                  skinny_job(F, WSP(bf16, WS_DP) + (size_t)MP * D + g * 256, D, W + (size_t)g * 65536 + (size_t)(job & 7) * 32 * 256, 256, 256, E.g, job * 32); } }
            { const bf16* W = WSP(bf16, WS_WX + l * SZ_W1K); pg8::OrderMN S; S.init(WSP(bf16, WS_OX), D, W, D, MP, D, F.G, bx);
              pg8::EpiGran<GeMix<2>> E{{mix, mixb, proj, ps}}; pg8::gemm_phase(F.lds, D, D, D, S, E);
              skinny_gemm(F, WSP(bf16, WS_OX) + (size_t)MP * D, D, W, D, D, D, E.g); }
        }
        SEAM(p0 + 4);
        _Pragma("unroll 1") for (int rep = 0; rep <= REP(5); ++rep) if (PM(7) && IN(p0 + 5)) { if (rep) xcd_barrier(bar);
            PHASE_BEGIN(F);
            const bf16* W = WSP(bf16, WS_WO + l * SZ_W1K); pg8::OrderMN S; S.init(WSP(bf16, WS_MIXB), D, W, D, MP, D, F.G, bx);
            pg8::EpiGran<GeRes> E{{WSP(float, WS_X), WSP(float, WS_T)}}; pg8::gemm_phase(F.lds, D, D, D, S, E);
            skinny_gemm(F, WSP(bf16, WS_MIXB) + (size_t)MP * D, D, W, D, D, D, E.g);
        }
        SEAM(p0 + 5);
        _Pragma("unroll 1") for (int rep = 0; rep <= REP(6); ++rep) if (PM(8) && IN(p0 + 6)) { if (rep) xcd_barrier(bar); PHASE_BEGIN(F); phase_ln(F, l, 0); }
        SEAM(p0 + 6);
        _Pragma("unroll 1") for (int rep = 0; rep <= REP(7); ++rep) if (PM(9) && IN(p0 + 7)) { if (rep) xcd_barrier(bar);
            PHASE_BEGIN(F);
            const bf16* W = WSP(bf16, WS_WUP + l * SZ_WUP); pg8::OrderMN S; S.init(WSP(bf16, WS_XN), D, W, D, MP, FF2, F.G, bx);
            EpiConv E{WSP(bf16, WS_ACT), WSP(float, WS_HALO), F.out, ((const float*)F.in[24]) + (size_t)l * 3 * FF2, ((const float*)F.in[25]) + (size_t)l * FF2, (LAS float*)(F.lds + XCH_OFF), l};
            pg8::gemm_phase(F.lds, D, D, D, S, E);
            skinny_up_conv(F, l, W);
        }
        SEAM(p0 + 7);
        _Pragma("unroll 1") for (int rep = 0; rep <= REP(8); ++rep) if (PM(10) && IN(p0 + 8)) { if (rep) xcd_barrier(bar);
            PHASE_BEGIN(F);
            const bf16* W = WSP(bf16, WS_WDN + l * SZ_WDN); pg8::OrderMN S; S.init(WSP(bf16, WS_ACT), FF, W, FF, MP, D, F.G, bx);
            { pg8::Unit uu; for (int i = 0; S.next(i, uu); ++i) conv_fixup(F, l, uu.pm); VM_WAIT(); __syncthreads(); }
            pg8::EpiGran<GeRes> E{{WSP(float, WS_X), WSP(float, WS_T)}}; pg8::gemm_phase(F.lds, FF, FF, FF, S, E);
            skinny_gemm(F, WSP(bf16, WS_ACT) + (size_t)MP * FF, FF, W, FF, D, FF, E.g);
        }
        SEAM(p0 + 8);
        _Pragma("unroll 1") for (int rep = 0; rep <= REP(9); ++rep) if (PM(11) && IN(p0 + 9)) { if (rep) xcd_barrier(bar); PHASE_BEGIN(F); phase_ln(F, l, 1); }
        SEAM(p0 + 9);
    }
#undef IN
#undef SEAM
}

extern "C" void kernel_launch(void* const* d_in, const int* in_sizes, int n_in, void* d_out, int out_size, void* d_ws, size_t ws_size, hipStream_t stream) {
    static int grid = 0;
    if (grid == 0) {
        if (n_in != 29 || (size_t)out_size != O_END || ws_size < WS_END) { fprintf(stderr, "kernel_launch: unexpected shapes (n_in %d, out %d, ws %zu; need ws >= %zu)\n", n_in, out_size, ws_size, (size_t)WS_END); grid = -1; return; }
        int dev = 0, cus = 0, per_cu = 0;
        if (hipGetDevice(&dev) != hipSuccess || hipDeviceGetAttribute(&cus, hipDeviceAttributeMultiprocessorCount, dev) != hipSuccess) { grid = -1; return; }
        if (hipFuncSetAttribute((const void*)trunk_fwd, hipFuncAttributeMaxDynamicSharedMemorySize, LDS_BYTES) != hipSuccess) { fprintf(stderr, "kernel_launch: hipFuncSetAttribute failed\n"); grid = -1; return; }
        if (hipOccupancyMaxActiveBlocksPerMultiprocessor(&per_cu, (const void*)trunk_fwd, 512, LDS_BYTES) != hipSuccess || per_cu < 1) fprintf(stderr, "kernel_launch: occupancy query reports %d\n", per_cu);
        (void)hipGetLastError();
        grid = cus;
    }
    if (grid < 0) return;
    (void)hipMemsetAsync((char*)d_ws + WS_CTL, 0, CTL_BYTES, stream);
    Args a{};
    for (int i = 0; i < 29; ++i) a.in[i] = (const float*)d_in[i];
    a.out = (float*)d_out; a.ws = (unsigned char*)d_ws; a.pad = 0;
#if MK_SPLIT
    for (int p = 0; p < PH_TOTAL; ++p) { a.ph_lo = p; a.ph_hi = p + 1; a.li = p; hipLaunchKernelGGL(trunk_fwd, dim3(grid), dim3(512), LDS_BYTES, stream, a); }
#else
    a.ph_lo = 0; a.ph_hi = PH_TOTAL; a.li = 0;
    hipLaunchKernelGGL(trunk_fwd, dim3(grid), dim3(512), LDS_BYTES, stream, a);
#endif
}
```

```cpp
#include <hip/hip_runtime.h>
#include <cstdio>
#include <cstdint>

#define LAS __attribute__((address_space(3)))
#define GAS __attribute__((address_space(1)))
typedef unsigned short bf16;
typedef short bf16x8 __attribute__((ext_vector_type(8)));
typedef float f32x4 __attribute__((ext_vector_type(4)));
typedef float f32x2 __attribute__((ext_vector_type(2)));
typedef unsigned u32x4 __attribute__((ext_vector_type(4)));
typedef unsigned u32x2 __attribute__((ext_vector_type(2)));
#define DI __device__ __forceinline__

#ifndef PHMASK
#define PHMASK 0xFFFFFFFFu
#endif
#ifndef SUBMASK
#define SUBMASK 0xFFFFFFFFu
#endif
#define SM(b) ((SUBMASK >> (b)) & 1u)
#ifndef REPMASK
#define REPMASK 0u
#endif
#ifndef SUBREP
#define SUBREP 0u
#endif
#define REP(k) ((int)((REPMASK >> (k)) & 1u))
#define SREP(k) ((int)((SUBREP >> (k)) & 1u))
#ifndef MK_SPLIT
#define MK_SPLIT 0
#endif

constexpr int D = 1024, NB = 8, SEQ = 2048, MP = NB * SEQ, MS = 128, MT = MP + MS, MTP = MP + 256, DEPTH = 4;
constexpr int NPROJ = 9216, INW = 9224;
constexpr int C_Q = 0, C_K = 1024, C_V = 2048, C_O = 3072, C_U = 4096, C_XQ = 5120, C_G = 6144;
constexpr int FF = 2816, FF2 = 5632, NMEM = 256, HD = 256, NH = 4;
constexpr float LN_EPS = 1e-5f;
constexpr float ALPHA = 1.681792830507429f;
constexpr int PAST_LEN = 16384;

constexpr size_t O_YP = 0, O_YS = 16777216, O_PC = 16908288, O_PN = 25296896, O_PM = 25329664, O_PPOOL = 25329792, O_PCONV = 25821312,
                 O_PMK = 26181760, O_PMV = 34570368, O_SC = 42958976, O_SN = 177176704, O_SM = 177700992, O_SPOOL = 177703040, O_SCONV = 185567360, O_END = 191334528;

constexpr size_t al256(size_t x) { return (x + 255) & ~(size_t)255; }
constexpr size_t WS_CTL = 0, CTL_BYTES = 2u << 20;
constexpr size_t WS_WIN = CTL_BYTES;                                        constexpr size_t SZ_WIN = (size_t)NPROJ * D * 2;
constexpr size_t WS_WM = WS_WIN + DEPTH * SZ_WIN;                           constexpr size_t SZ_W1K = (size_t)D * D * 2;
constexpr size_t WS_WX = WS_WM + DEPTH * SZ_W1K;
constexpr size_t WS_WO = WS_WX + DEPTH * SZ_W1K;
constexpr size_t WS_WP = WS_WO + DEPTH * SZ_W1K;                            constexpr size_t SZ_WP = (size_t)4 * 256 * 256 * 2;
constexpr size_t WS_WKV = WS_WP + DEPTH * SZ_WP;                            constexpr size_t SZ_WKV = (size_t)2048 * D * 2;
constexpr size_t WS_WUP = WS_WKV + DEPTH * SZ_WKV;                          constexpr size_t SZ_WUP = (size_t)FF2 * D * 2;
constexpr size_t WS_WDN = WS_WUP + DEPTH * SZ_WUP;                          constexpr size_t SZ_WDN = (size_t)D * FF * 2;
constexpr size_t WS_X = al256(WS_WDN + DEPTH * SZ_WDN);
constexpr size_t WS_T = WS_X + (size_t)MTP * D * 4;
constexpr size_t WS_MIX = WS_T + (size_t)MTP * D * 4;
constexpr size_t WS_XN = WS_MIX + (size_t)MTP * D * 4;
constexpr size_t WS_PROJ = WS_XN + (size_t)MTP * D * 2;
constexpr size_t WS_HC = WS_PROJ + (size_t)MTP * NPROJ * 2;
constexpr size_t WS_HN = WS_HC + (size_t)MTP * D * 2;
constexpr size_t WS_DP = WS_HN + (size_t)MTP * D * 2;
constexpr size_t WS_PB = WS_DP + (size_t)MTP * D * 2;
constexpr size_t WS_OX = WS_PB + (size_t)MTP * D * 2;
constexpr size_t WS_MIXB = WS_OX + (size_t)MTP * D * 2;
constexpr size_t WS_HUP = WS_MIXB + (size_t)MTP * D * 2;
constexpr size_t WS_ACT = WS_HUP + (size_t)MTP * FF2 * 2;
constexpr size_t WS_IGFG = WS_ACT + (size_t)MTP * FF * 2;
constexpr size_t WS_MEMB = WS_IGFG + (size_t)MTP * 8 * 4;
constexpr size_t WS_MK = WS_MEMB + (size_t)2048 * D * 2;
constexpr size_t WS_MVT = WS_MK + (size_t)DEPTH * 2048 * D * 2;
constexpr size_t WS_PT = WS_MVT + (size_t)DEPTH * 2048 * D * 2;
constexpr size_t WS_KWT = WS_PT + (size_t)32 * 32 * 4096 * 2;
constexpr size_t WS_VTT = WS_KWT + (size_t)32 * 32 * 16384 * 2;
constexpr size_t WS_GT = WS_VTT + (size_t)32 * 32 * 16384 * 2;
constexpr size_t WS_XQ = WS_GT + (size_t)32 * 32 * 192 * 4;
constexpr size_t WS_HALO = WS_XQ + (size_t)MTP * D * 2;
constexpr size_t WS_END = WS_HALO + (size_t)64 * 4 * FF2 * 4;
static_assert(WS_END <= 2147483648ull, "workspace map exceeds 2 GiB");
constexpr int CW_BAR = 4096, CW_QUEUE = 1024;

constexpr int LDS_BYTES = 147456;
constexpr int XCH_OFF = 131072;
constexpr int MISC_OFF = LDS_BYTES - 256;

DI float bf2f(unsigned v) { return __uint_as_float(v << 16); }
DI unsigned f2bf(float f) { unsigned u = __float_as_uint(f); return (u + 0x7fffu + ((u >> 16) & 1u)) >> 16; }
DI unsigned pk2(float lo, float hi) { return f2bf(lo) | (f2bf(hi) << 16); }
DI float lo16(unsigned w) { return __uint_as_float(w << 16); }
DI float hi16(unsigned w) { return __uint_as_float(w & 0xffff0000u); }
DI float sigmoid_fast(float x) { return __builtin_amdgcn_rcpf(1.0f + __expf(-x)); }
DI float wave_sum(float v) {
#pragma unroll
    for (int o = 1; o < 64; o <<= 1) v += __shfl_xor(v, o);
    return v;
}
DI void unpack8(const u32x4 w, float (&f)[8]) { f[0] = lo16(w.x); f[1] = hi16(w.x); f[2] = lo16(w.y); f[3] = hi16(w.y); f[4] = lo16(w.z); f[5] = hi16(w.z); f[6] = lo16(w.w); f[7] = hi16(w.w); }
DI int opaque_tid() { int t = threadIdx.x; asm volatile("" : "+v"(t)); return t; }
#define LDS_WAIT() asm volatile("s_waitcnt lgkmcnt(0)" ::: "memory")
#define VM_WAIT() asm volatile("s_waitcnt vmcnt(0)" ::: "memory")

namespace pg8 {
constexpr int BM = 256, BK = 64, HALF = 128, HTB = HALF * BK * 2, STAGE_BYTES = 8 * HTB, NXCD = 8, WGM = 8;
__host__ __device__ __forceinline__ int lds_byte(int r, int c) { const int st = (r >> 4) * 2 + (c >> 5), rr = r & 15, cc = c & 31, ob = rr * 64 + cc * 2; return st * 1024 + (ob ^ (((ob >> 9) & 1) << 5)); }
__host__ __device__ __forceinline__ void stage_rc(int b, int& R, int& C) { const int st = b / 1024, sb = b % 1024, swz = sb ^ (((sb >> 9) & 1) << 5); R = (st >> 1) * 16 + swz / 64; C = (st & 1) * 32 + (swz % 64) / 2; }

struct Unit { const char* a; const char* b; int pm, pn; };

struct OrderMN {
    int nM, nN, nwg, G, c; const char* A; const char* Bt; size_t astep, bstep, apn;
    DI void init(const bf16* A_, int lda, const bf16* Bt_, int ldb, int M, int N, int G_, int c_, int apn_ = 0) { nM = M / BM; nN = N / BM; nwg = nM * nN; G = G_; c = c_; A = (const char*)A_; Bt = (const char*)Bt_; astep = (size_t)BM * lda * 2; bstep = (size_t)BM * ldb * 2; apn = (size_t)apn_; }
    DI bool next(int i, Unit& u) const {
        const long L = (long)i * G + c; if (L >= nwg) return false;
        int wgid = (int)L; { const int q = nwg / NXCD, r = nwg % NXCD, xcd = wgid % NXCD, off = wgid / NXCD; wgid = (xcd < r ? xcd * (q + 1) : r * (q + 1) + (xcd - r) * q) + off; }
        const int nig = WGM * nN, gid = wgid / nig, fm = gid * WGM, gsz = (nM - fm) < WGM ? (nM - fm) : WGM;
        u.pm = fm + ((wgid % nig) % gsz); u.pn = (wgid % nig) / gsz; u.a = A + (size_t)u.pm * astep + (size_t)u.pn * apn; u.b = Bt + (size_t)u.pn * bstep; return true;
    }
};

template <class Epi, class Sched>
DI void gemm_phase(LAS unsigned char* lds, const int K, const int lda, const int ldb, const Sched& S, const Epi& E) {
    const int tid = opaque_tid(), wid = __builtin_amdgcn_readfirstlane(tid >> 6), lane = tid & 63, wr = wid >> 2, wc = wid & 3, fr = lane & 15, fq = lane >> 4;
    const int nt = K / BK;
    unsigned voffA[2], voffB[2];
#pragma unroll
    for (int i = 0; i < 2; ++i) { int R, C; stage_rc(tid * 16 + i * 8192, R, C); voffA[i] = (unsigned)(R * lda + C) * 2u; voffB[i] = (unsigned)(R * ldb + C) * 2u; }
    const size_t kstep = (size_t)(BK * 2);
    const size_t hstepA = (size_t)HALF * lda * 2, hstepB = (size_t)HALF * ldb * 2;
    const unsigned ldsw = (unsigned)wid * 1024u;
    const int aoff = lds_byte(wr * 64 + fr, fq * 8), boff = lds_byte(wc * 32 + fr, fq * 8);
#define PG8_SA(b, h) (((b) * 2 + (h)) * HTB)
#define PG8_SB(b, h) ((4 + (b) * 2 + (h)) * HTB)
#define PG8_STAGE(bufoff, gbase, voff) do { _Pragma("unroll") for (int _i = 0; _i < 2; ++_i) \
        __builtin_amdgcn_global_load_lds((const unsigned*)((const char*)(gbase) + (voff)[_i]), (LAS unsigned*)(lds + (bufoff) + ldsw + _i * 8192), 16, 0, 0); } while (0)
#define PG8_LDA(dst, b, h) do { _Pragma("unroll") for (int m = 0; m < 4; ++m) _Pragma("unroll") for (int k = 0; k < 2; ++k) dst[m][k] = *(const LAS bf16x8*)(lds + PG8_SA(b, h) + aoff + m * 2048 + k * 1024); } while (0)
#define PG8_LDB(dst, b, h) do { _Pragma("unroll") for (int n = 0; n < 2; ++n) _Pragma("unroll") for (int k = 0; k < 2; ++k) dst[n][k] = *(const LAS bf16x8*)(lds + PG8_SB(b, h) + boff + n * 2048 + k * 1024); } while (0)
#define PG8_MMA(ai, bj, At, Bt) do { __builtin_amdgcn_s_setprio(1); _Pragma("unroll") for (int m = 0; m < 4; ++m) _Pragma("unroll") for (int n = 0; n < 2; ++n) _Pragma("unroll") for (int k = 0; k < 2; ++k) \
        acc[ai][bj][m][n] = __builtin_amdgcn_mfma_f32_16x16x32_bf16(Bt[n][k], At[m][k], acc[ai][bj][m][n], 0, 0, 0); __builtin_amdgcn_s_setprio(0); } while (0)
#define PG8_WAIT_V(n) asm volatile("s_waitcnt vmcnt(" #n ")" ::: "memory")
#define PG8_WAIT_L(n) asm volatile("s_waitcnt lgkmcnt(" #n ")" ::: "memory")
#define PG8_BAR __builtin_amdgcn_s_barrier()
#define PG8_SCHED __builtin_amdgcn_sched_barrier(0)
    Unit cur, nxt; int ui = 0;
    if (!S.next(0, cur)) return;
    f32x4 acc[2][2][4][2];
#pragma unroll
    for (int a = 0; a < 2; ++a)
#pragma unroll
        for (int b = 0; b < 2; ++b)
#pragma unroll
            for (int m = 0; m < 4; ++m)
#pragma unroll
                for (int n = 0; n < 2; ++n) acc[a][b][m][n] = (f32x4){0.f, 0.f, 0.f, 0.f};
    bf16x8 At[4][2], B0[2][2], B1[2][2];
    const char* cA = cur.a; const char* cB = cur.b;
    PG8_STAGE(PG8_SB(0, 0), cB, voffB); PG8_STAGE(PG8_SB(0, 1), cB + hstepB, voffB); PG8_STAGE(PG8_SA(0, 0), cA, voffA); PG8_STAGE(PG8_SA(0, 1), cA + hstepA, voffA);
    if (wr == 1) PG8_BAR;
    PG8_WAIT_V(2); PG8_BAR;
    PG8_STAGE(PG8_SB(1, 0), cB + kstep, voffB); PG8_STAGE(PG8_SA(1, 0), cA + kstep, voffA); PG8_STAGE(PG8_SB(1, 1), cB + hstepB + kstep, voffB);
    PG8_WAIT_V(6); PG8_BAR;
    for (;;) {
        const bool has_next = S.next(ui + 1, nxt);
        const char* nA = has_next ? nxt.a : cA; const char* nB = has_next ? nxt.b : cB;
#pragma unroll 1
        for (int t = 0; t < nt; t += 2) {
            const bool last = (t == nt - 2);
            const char* a1 = cA + (size_t)(t + 1) * kstep;
            const char* a2 = last ? nA : cA + (size_t)(t + 2) * kstep; const char* b2 = last ? nB : cB + (size_t)(t + 2) * kstep;
            const char* a3 = a2 + kstep; const char* b3 = b2 + kstep;
            PG8_LDB(B0, 0, 0); PG8_LDB(B1, 0, 1); PG8_SCHED; PG8_LDA(At, 0, 0); PG8_STAGE(PG8_SA(1, 1), a1 + hstepA, voffA);
            PG8_WAIT_V(8); PG8_WAIT_L(0); PG8_BAR; PG8_MMA(0, 0, At, B0); PG8_MMA(0, 1, At, B1); PG8_BAR; PG8_SCHED;
            PG8_LDA(At, 0, 1); PG8_STAGE(PG8_SB(0, 0), b2, voffB); PG8_STAGE(PG8_SB(0, 1), b2 + hstepB, voffB); PG8_STAGE(PG8_SA(0, 0), a2, voffA);
            PG8_WAIT_V(8); PG8_WAIT_L(0); PG8_BAR; PG8_MMA(1, 0, At, B0); PG8_MMA(1, 1, At, B1); PG8_BAR; PG8_SCHED;
            PG8_LDB(B0, 1, 0); PG8_LDB(B1, 1, 1); PG8_SCHED; PG8_LDA(At, 1, 0); PG8_STAGE(PG8_SA(0, 1), a2 + hstepA, voffA);
            PG8_WAIT_V(8); PG8_WAIT_L(0); PG8_BAR; PG8_MMA(0, 0, At, B0); PG8_MMA(0, 1, At, B1); PG8_BAR; PG8_SCHED;
            PG8_LDA(At, 1, 1); PG8_STAGE(PG8_SB(1, 0), b3, voffB); PG8_STAGE(PG8_SB(1, 1), b3 + hstepB, voffB); PG8_STAGE(PG8_SA(1, 0), a3, voffA);
            PG8_WAIT_V(8); PG8_WAIT_L(0); PG8_BAR; PG8_MMA(1, 0, At, B0); PG8_MMA(1, 1, At, B1); PG8_BAR; PG8_SCHED;
        }
        if (wr == 0) PG8_BAR;
        E(acc, cur, wr, wc, fr, fq);
        if (!has_next) break;
#pragma unroll
        for (int a = 0; a < 2; ++a)
#pragma unroll
            for (int b = 0; b < 2; ++b)
#pragma unroll
                for (int m = 0; m < 4; ++m)
#pragma unroll
                    for (int n = 0; n < 2; ++n) acc[a][b][m][n] = (f32x4){0.f, 0.f, 0.f, 0.f};
        cur = nxt; cA = nA; cB = nB; ++ui;
        if (wr == 1) PG8_BAR;
    }
    PG8_WAIT_V(0);
    PG8_BAR;
#undef PG8_SA
#undef PG8_SB
#undef PG8_STAGE
#undef PG8_LDA
#undef PG8_LDB
#undef PG8_MMA
#undef PG8_WAIT_V
#undef PG8_WAIT_L
#undef PG8_BAR
#undef PG8_SCHED
}

template <class GE> struct EpiGran {
    GE g;
    DI void operator()(f32x4 (&acc)[2][2][4][2], const Unit& u, int wr, int wc, int fr, int fq) const {
        const int row0 = u.pm * BM + wr * 64 + fr, col0 = u.pn * BM + wc * 32 + 4 * fq;
#pragma unroll
        for (int ai = 0; ai < 2; ++ai)
#pragma unroll
            for (int m = 0; m < 4; ++m)
#pragma unroll
                for (int bj = 0; bj < 2; ++bj)
#pragma unroll
                    for (int n = 0; n < 2; ++n) g(row0 + ai * HALF + m * 16, col0 + bj * HALF + n * 16, acc[ai][bj][m][n]);
    }
};
}

#define XB_TMO      128
#define XB_XCNT(j)  (256  + 64 * (j))
#define XB_XSUB(j)  (1280 + 64 * (j))
#define XB_XGEN(j)  (2304 + 64 * (j))
#define XB_TOP      3328
#define XB_TOPGEN   3392
#define XCD_BAR_WORDS 3456
#define XB_SPIN_CAP (1u << 22)
DI unsigned xb_ld(unsigned* p)              { return __hip_atomic_load(p, __ATOMIC_RELAXED, __HIP_MEMORY_SCOPE_AGENT); }
DI unsigned xb_add(unsigned* p, unsigned v) { return __hip_atomic_fetch_add(p, v, __ATOMIC_RELAXED, __HIP_MEMORY_SCOPE_AGENT); }
DI unsigned xb_xcc_id() { return (unsigned)__builtin_amdgcn_s_getreg((3 << 11) | 20) & 0xFu; }
#define XB_SPIN(cond, bar) do { unsigned _sp = 0; while (cond) { __builtin_amdgcn_s_sleep(1); \
    if ((++_sp & 255u) == 0u) { if (xb_ld(&(bar)[XB_TMO])) break; if (_sp > XB_SPIN_CAP) { atomicAdd(&(bar)[XB_TMO], 1u); break; } } } } while (0)
struct XcdBarrier { unsigned* bar; unsigned x; volatile LAS unsigned* st; };
DI XcdBarrier xcd_barrier_post(unsigned* bar, volatile LAS unsigned* st) {
    XcdBarrier b; b.bar = bar; b.x = xb_xcc_id(); b.st = st;
    if (threadIdx.x == 0) (void)xb_add(&bar[XB_XCNT(b.x)], 1u);
    return b;
}
DI void xcd_barrier_complete(unsigned* bar, unsigned x, unsigned& nloc, unsigned& nx) {
    const unsigned G = gridDim.x * gridDim.y * gridDim.z;
    unsigned sum, cnt, mine, sp = 0u;
    for (;;) {
        sum = 0u; cnt = 0u; mine = 0u;
#pragma unroll
        for (unsigned j = 0; j < 16; ++j) { const unsigned c = xb_ld(&bar[XB_XCNT(j)]); sum += c; cnt += (c > 0u) ? 1u : 0u; mine = (j == x) ? c : mine; }
        if (sum == G) break;
        __builtin_amdgcn_s_sleep(1);
        if ((++sp & 255u) == 0u) { if (xb_ld(&bar[XB_TMO])) break; if (sp > XB_SPIN_CAP) { atomicAdd(&bar[XB_TMO], 1u); break; } }
    }
    nloc = mine > 0u ? mine : 1u; nx = cnt > 0u ? cnt : 1u;
}
DI void xcd_barrier(const XcdBarrier& b) {
    asm volatile("s_waitcnt vmcnt(0)" ::: "memory");
    __syncthreads();
    if (threadIdx.x == 0) {
        unsigned* bar = b.bar;
        __builtin_amdgcn_s_waitcnt(0);
        unsigned nloc = b.st[0], nx = b.st[1];
        if (nloc == 0u) { xcd_barrier_complete(bar, b.x, nloc, nx); b.st[0] = nloc; b.st[1] = nx; }
        const unsigned old = xb_add(&bar[XB_XSUB(b.x)], 1u);
        const unsigned gen = old / nloc;
        if (old + 1u == (gen + 1u) * nloc) {
            __builtin_amdgcn_fence(__ATOMIC_RELEASE, "agent");
            asm volatile("s_waitcnt vmcnt(0)" ::: "memory");
            const unsigned og = xb_add(&bar[XB_TOP], 1u);
            const unsigned tg = og / nx;
            if (og + 1u == (tg + 1u) * nx) xb_add(&bar[XB_TOPGEN], 1u);
            else XB_SPIN(xb_ld(&bar[XB_TOPGEN]) == tg, bar);
            __builtin_amdgcn_fence(__ATOMIC_ACQUIRE, "agent");
            xb_add(&bar[XB_XGEN(b.x)], 1u);
            asm volatile("s_waitcnt vmcnt(0)" ::: "memory");
        } else {
            XB_SPIN(xb_ld(&bar[XB_XGEN(b.x)]) == gen, bar);
            __builtin_amdgcn_fence(__ATOMIC_ACQUIRE, "agent");
            asm volatile("s_waitcnt vmcnt(0)" ::: "memory");
        }
    }
    __syncthreads();
}

typedef const GAS float* fptr_t;
typedef const __attribute__((address_space(4))) fptr_t* in_tab_t;
struct Frame {
    LAS unsigned char* lds;
    int vcu, G;
    in_tab_t in; float* out; unsigned char* ws;
};
#define PHASE_BEGIN(F) Frame F = F0; int bx = bx0; { unsigned long long _a = (unsigned long long)F0.in, _b = (unsigned long long)F0.out, _c = (unsigned long long)F0.ws; int _g = F0.G, _v = F0.vcu; \
    asm volatile("" : "+s"(_a), "+s"(_b), "+s"(_c), "+s"(_g), "+s"(_v), "+s"(bx)); \
    F.in = (in_tab_t)_a; F.out = (float*)(GAS float*)_b; F.ws = (unsigned char*)(GAS unsigned char*)_c; F.G = _g; F.vcu = _v; }
#define WSP(T, off) ((T*)(F.ws + (off)))

struct GeIn {
    bf16* proj; const float* bias; bf16* xqb;
    DI void operator()(int row, int col, const f32x4& a) const {
        const int bc = col + (col >= 4096 ? 8 : 0);
        const f32x4 bv = *(const f32x4*)(bias + bc);
        f32x4 v = a + bv;
        const bool sg = (col >= C_O && col < C_U) || col >= C_G;
        if (sg) { v.x = sigmoid_fast(v.x); v.y = sigmoid_fast(v.y); v.z = sigmoid_fast(v.z); v.w = sigmoid_fast(v.w); }
        u32x2 w; w.x = pk2(v.x, v.y); w.y = pk2(v.z, v.w);
        if (col >= C_XQ && col < C_G) *(u32x2*)(xqb + (size_t)row * D + (col - C_XQ)) = w;
        else *(u32x2*)(proj + (size_t)row * NPROJ + col) = w;
    }
};
struct GeKV {
    float* out; bf16* mk; bf16* mvt;
    DI void operator()(int row, int col, const f32x4& a) const {
        const int l = col >> 11, c = col & 2047;
        if (c < 1024) {
            *(f32x4*)(out + O_PMK + ((size_t)l * 2048 + row) * 1024 + c) = a;
            u32x2 w; w.x = pk2(a.x, a.y); w.y = pk2(a.z, a.w);
            *(u32x2*)(mk + ((size_t)l * 2048 + row) * 1024 + c) = w;
        } else {
            const int cc = c - 1024;
            *(f32x4*)(out + O_PMV + ((size_t)l * 2048 + row) * 1024 + cc) = a;
            bf16* t = mvt + ((size_t)l * 1024 + cc) * 2048 + row;
            t[0] = (bf16)f2bf(a.x); t[2048] = (bf16)f2bf(a.y); t[4096] = (bf16)f2bf(a.z); t[6144] = (bf16)f2bf(a.w);
        }
    }
};
struct GeBf16 {
    bf16* o; int ldc;
    DI void operator()(int row, int col, const f32x4& a) const { u32x2 w; w.x = pk2(a.x, a.y); w.y = pk2(a.z, a.w); *(u32x2*)(o + (size_t)row * ldc + col) = w; }
};
template <int MODE> struct GeMix {
    float* mix; bf16* mixb; const bf16* proj; const float* ps;
    DI void operator()(int row, int col, const f32x4& a) const {
        const u32x2 gw = *(const u32x2*)(proj + (size_t)row * NPROJ + C_G + MODE * 1024 + col);
        const f32x4 g = (f32x4){lo16(gw.x), hi16(gw.x), lo16(gw.y), hi16(gw.y)};
        float* mp = mix + (size_t)row * D + col;
        if (MODE == 0) { *(f32x4*)mp = g * a; }
        else if (MODE == 1) { const f32x4 s = *(const f32x4*)(ps + col); *(f32x4*)mp = *(const f32x4*)mp + g * s * a; }
        else { const f32x4 v = *(const f32x4*)mp + g * a; u32x2 w; w.x = pk2(v.x, v.y); w.y = pk2(v.z, v.w); *(u32x2*)(mixb + (size_t)row * D + col) = w; }
    }
};
struct GeRes {
    const float* x; float* t;
    DI void operator()(int row, int col, const f32x4& a) const { const size_t o = (size_t)row * D + col; *(f32x4*)(t + o) = *(const f32x4*)(x + o) * ALPHA + a; }
};

struct EpiSoftmax {
    bf16* P; LAS float* X;
    DI void operator()(f32x4 (&acc)[2][2][4][2], const pg8::Unit& u, int wr, int wc, int fr, int fq) const {
        const float sc = 0.0625f * 1.4426950408889634f;
        LAS float* XM = X; LAS float* XS = X + 1024;
#pragma unroll
        for (int ai = 0; ai < 2; ++ai)
#pragma unroll
            for (int m = 0; m < 4; ++m) {
                float v = -3.0e38f;
#pragma unroll
                for (int bj = 0; bj < 2; ++bj)
#pragma unroll
                    for (int n = 0; n < 2; ++n) { const f32x4 x = acc[ai][bj][m][n]; v = fmaxf(v, fmaxf(fmaxf(x.x, x.y), fmaxf(x.z, x.w))); }
                v = fmaxf(v, __shfl_xor(v, 16)); v = fmaxf(v, __shfl_xor(v, 32));
                if (fq == 0) XM[(ai * 128 + wr * 64 + m * 16 + fr) * 4 + wc] = v;
            }
        LDS_WAIT(); __builtin_amdgcn_s_barrier(); asm volatile("" ::: "memory");
#pragma unroll
        for (int ai = 0; ai < 2; ++ai)
#pragma unroll
            for (int m = 0; m < 4; ++m) {
                const int r = ai * 128 + wr * 64 + m * 16 + fr;
                const f32x4 mm = *(const LAS f32x4*)(XM + r * 4);
                const float mx = fmaxf(fmaxf(mm.x, mm.y), fmaxf(mm.z, mm.w)) * sc;
                float s = 0.f;
#pragma unroll
                for (int bj = 0; bj < 2; ++bj)
#pragma unroll
                    for (int n = 0; n < 2; ++n) { f32x4 x = acc[ai][bj][m][n];
                        x.x = __builtin_amdgcn_exp2f(x.x * sc - mx); x.y = __builtin_amdgcn_exp2f(x.y * sc - mx); x.z = __builtin_amdgcn_exp2f(x.z * sc - mx); x.w = __builtin_amdgcn_exp2f(x.w * sc - mx);
                        acc[ai][bj][m][n] = x; s += (x.x + x.y) + (x.z + x.w); }
                s += __shfl_xor(s, 16); s += __shfl_xor(s, 32);
                if (fq == 0) XS[r * 4 + wc] = s;
                asm volatile("" ::: "memory");
            }
        LDS_WAIT(); __builtin_amdgcn_s_barrier(); asm volatile("" ::: "memory");
#pragma unroll
        for (int ai = 0; ai < 2; ++ai)
#pragma unroll
            for (int m = 0; m < 4; ++m) {
                const int r = ai * 128 + wr * 64 + m * 16 + fr;
                const f32x4 ss = *(const LAS f32x4*)(XS + r * 4);
                const float inv = 1.0f / ((ss.x + ss.y) + (ss.z + ss.w));
                bf16* rowp = P + (size_t)(u.pm * 256 + r) * D + u.pn * 256 + wc * 32 + 4 * fq;
#pragma unroll
                for (int bj = 0; bj < 2; ++bj)
#pragma unroll
                    for (int n = 0; n < 2; ++n) { const f32x4 x = acc[ai][bj][m][n] * inv; u32x2 w; w.x = pk2(x.x, x.y); w.y = pk2(x.z, x.w); *(u32x2*)(rowp + bj * 128 + n * 16) = w; }
                asm volatile("" ::: "memory");
            }
        LDS_WAIT(); __builtin_amdgcn_s_barrier(); asm volatile("" ::: "memory");
    }
};

#define ROR_F(x, n) __builtin_bit_cast(float, __builtin_amdgcn_update_dpp(0, __builtin_bit_cast(int, (float)(x)), 0x120 + (n), 0xf, 0xf, false))
DI float gelu_tanh(float x) { return x * sigmoid_fast(1.5957691216057308f * (x + 0.044715f * x * x * x)); }
struct EpiConv {
    bf16* act; float* halo; float* out; const float* cw; const float* cb; LAS float* X; int l;
    DI void operator()(f32x4 (&acc)[2][2][4][2], const pg8::Unit& u, int wr, int wc, int fr, int fq) const {
        if (fr >= 14) {
#pragma unroll
            for (int ai = 0; ai < 2; ++ai)
#pragma unroll
                for (int bj = 0; bj < 2; ++bj)
#pragma unroll
                    for (int n = 0; n < 2; ++n) *(LAS f32x4*)(X + (((ai * 2 + wr) * 2 + (fr - 14)) * 256 + bj * 128 + wc * 32 + n * 16 + fq * 4)) = acc[ai][bj][3][n];
        }
        LDS_WAIT(); __builtin_amdgcn_s_barrier(); asm volatile("" ::: "memory");
        if (wr == 0 && fr < 2) {
#pragma unroll
            for (int h = 0; h < 2; ++h)
#pragma unroll
                for (int n = 0; n < 2; ++n) *(f32x4*)(halo + ((size_t)u.pm * 4 + fr) * FF2 + h * FF + u.pn * 128 + wc * 32 + n * 16 + fq * 4) = acc[0][h][0][n];
        }
        if (wr == 1 && fr >= 14) {
#pragma unroll
            for (int h = 0; h < 2; ++h)
#pragma unroll
                for (int n = 0; n < 2; ++n) { const int ca = u.pn * 128 + wc * 32 + n * 16 + fq * 4;
                    *(f32x4*)(halo + ((size_t)u.pm * 4 + 2 + (fr - 14)) * FF2 + h * FF + ca) = acc[1][h][3][n];
                    if ((u.pm & 7) == 7) *(f32x4*)(out + O_PCONV + ((size_t)(l * NB + (u.pm >> 3)) * 2 + (fr - 14)) * FF2 + h * FF + ca) = acc[1][h][3][n]; }
        }
        const bool p1own = fr >= 1, p2own = fr >= 2;
#pragma unroll
        for (int n = 0; n < 2; ++n) {
            asm volatile("" ::: "memory");
            const int ca = u.pn * 128 + wc * 32 + n * 16 + fq * 4;
            f32x4 w[2][3], bsv[2];
#pragma unroll
            for (int h = 0; h < 2; ++h) {
#pragma unroll
                for (int i = 0; i < 3; ++i) w[h][i] = *(const f32x4*)(cw + (size_t)i * FF2 + h * FF + ca);
                bsv[h] = *(const f32x4*)(cb + h * FF + ca); }
            bf16* ap = act + (size_t)(u.pm * 256 + wr * 64 + fr) * FF + ca;
#pragma unroll
            for (int ai = 0; ai < 2; ++ai)
#pragma unroll
                for (int m = 3; m >= 0; --m) {
                    f32x4 c[2];
#pragma unroll
                    for (int h = 0; h < 2; ++h) {
                        const f32x4 cur = acc[ai][h][m][n];
                        f32x4 g;
                        if (m > 0) g = acc[ai][h][m - 1][n];
                        else { g = (f32x4){0.f, 0.f, 0.f, 0.f};
                            if (fr >= 14 && (wr == 1 || ai == 1)) { const int sa = (wr == 1) ? ai : 0, sw = (wr == 1) ? 0 : 1; g = *(const LAS f32x4*)(X + (((sa * 2 + sw) * 2 + (fr - 14)) * 256 + h * 128 + wc * 32 + n * 16 + fq * 4)); } }
                        f32x4 p1, p2;
#pragma unroll
                        for (int j = 0; j < 4; ++j) { const float a1 = ROR_F(cur[j], 1), b1 = ROR_F(g[j], 1), a2 = ROR_F(cur[j], 2), b2 = ROR_F(g[j], 2); p1[j] = p1own ? a1 : b1; p2[j] = p2own ? a2 : b2; }
                        c[h] = p2 * w[h][0] + p1 * w[h][1] + cur * w[h][2] + bsv[h];
                    }
                    const f32x4 o = (f32x4){gelu_tanh(c[0].x) * c[1].x, gelu_tanh(c[0].y) * c[1].y, gelu_tanh(c[0].z) * c[1].z, gelu_tanh(c[0].w) * c[1].w};
                    u32x2 wv; wv.x = pk2(o.x, o.y); wv.y = pk2(o.z, o.w);
                    *(u32x2*)(ap + (size_t)(ai * 128 + m * 16) * FF) = wv;
                }
        }
        LDS_WAIT(); __builtin_amdgcn_s_barrier(); asm volatile("" ::: "memory");
    }
};
DI void conv_fixup(Frame& F, int l, int pm) {
    const float* halo = WSP(float, WS_HALO); bf16* act = WSP(bf16, WS_ACT);
    const float* cw = ((const float*)F.in[24]) + (size_t)l * 3 * FF2; const float* cb = ((const float*)F.in[25]) + (size_t)l * FF2;
    const bool first = (pm & 7) == 0;
    for (int it = opaque_tid(); it < FF / 4; it += 512) {
        const int ca = it * 4; f32x4 c0[2], c1[2];
#pragma unroll
        for (int h = 0; h < 2; ++h) {
            const size_t co = (size_t)h * FF + ca;
            const f32x4 r0 = *(const f32x4*)(halo + ((size_t)pm * 4 + 0) * FF2 + co), r1 = *(const f32x4*)(halo + ((size_t)pm * 4 + 1) * FF2 + co);
            f32x4 q2 = (f32x4){0.f, 0.f, 0.f, 0.f}, q1 = q2;
            if (!first) { q2 = *(const f32x4*)(halo + ((size_t)(pm - 1) * 4 + 2) * FF2 + co); q1 = *(const f32x4*)(halo + ((size_t)(pm - 1) * 4 + 3) * FF2 + co); }
            const f32x4 w0 = *(const f32x4*)(cw + co), w1 = *(const f32x4*)(cw + FF2 + co), w2 = *(const f32x4*)(cw + 2 * FF2 + co), bv = *(const f32x4*)(cb + co);
            c0[h] = q2 * w0 + q1 * w1 + r0 * w2 + bv; c1[h] = q1 * w0 + r0 * w1 + r1 * w2 + bv; }
        u32x2 wv; wv.x = pk2(gelu_tanh(c0[0].x) * c0[1].x, gelu_tanh(c0[0].y) * c0[1].y); wv.y = pk2(gelu_tanh(c0[0].z) * c0[1].z, gelu_tanh(c0[0].w) * c0[1].w);
        *(u32x2*)(act + (size_t)(pm * 256) * FF + ca) = wv;
        wv.x = pk2(gelu_tanh(c1[0].x) * c1[1].x, gelu_tanh(c1[0].y) * c1[1].y); wv.y = pk2(gelu_tanh(c1[0].z) * c1[1].z, gelu_tanh(c1[0].w) * c1[1].w);
        *(u32x2*)(act + (size_t)(pm * 256 + 1) * FF + ca) = wv;
    }
}
DI void skinny_up_conv(Frame& F, int l, const bf16* W) {
    const int tid = opaque_tid(), lane = tid & 63, wid = __builtin_amdgcn_readfirstlane(tid >> 6), fr = lane & 15, fq = lane >> 4, b = wid * 16 + fr;
    const bf16* ap = WSP(bf16, WS_XN) + (size_t)(MP + b) * D + fq * 8;
    const float* cw = ((const float*)F.in[24]) + (size_t)l * 3 * FF2; const float* cb = ((const float*)F.in[25]) + (size_t)l * FF2;
    const float* sc = ((const float*)F.in[9]) + ((size_t)(l * MS + b) * 2) * FF2; float* so = F.out + O_SCONV + ((size_t)(l * MS + b) * 2) * FF2;
    for (int job = F.vcu; job < FF / 16; job += F.G) {
        const int uu = job >> 3, cc = (job & 7) * 16;
        const bf16* b0 = W + (size_t)(uu * 256 + cc + fr) * D + fq * 8; const bf16* b1 = b0 + (size_t)128 * D;
        f32x4 acc[2] = {(f32x4){0.f, 0.f, 0.f, 0.f}, (f32x4){0.f, 0.f, 0.f, 0.f}};
#pragma unroll 8
        for (int k0 = 0; k0 < D; k0 += 32) { const bf16x8 a = *(const bf16x8*)(ap + k0), x0 = *(const bf16x8*)(b0 + k0), x1 = *(const bf16x8*)(b1 + k0);
            acc[0] = __builtin_amdgcn_mfma_f32_16x16x32_bf16(x0, a, acc[0], 0, 0, 0); acc[1] = __builtin_amdgcn_mfma_f32_16x16x32_bf16(x1, a, acc[1], 0, 0, 0); }
        const int ca = job * 16 + fq * 4; f32x4 c[2];
#pragma unroll
        for (int h = 0; h < 2; ++h) { const size_t co = (size_t)h * FF + ca;
            const f32x4 s0 = *(const f32x4*)(sc + co), s1 = *(const f32x4*)(sc + FF2 + co);
            c[h] = s0 * *(const f32x4*)(cw + co) + s1 * *(const f32x4*)(cw + FF2 + co) + acc[h] * *(const f32x4*)(cw + 2 * FF2 + co) + *(const f32x4*)(cb + co);
            *(f32x4*)(so + co) = s1; *(f32x4*)(so + FF2 + co) = acc[h]; }
        u32x2 wv; wv.x = pk2(gelu_tanh(c[0].x) * c[1].x, gelu_tanh(c[0].y) * c[1].y); wv.y = pk2(gelu_tanh(c[0].z) * c[1].z, gelu_tanh(c[0].w) * c[1].w);
        *(u32x2*)(WSP(bf16, WS_ACT) + (size_t)(MP + b) * FF + ca) = wv;
    }
}

template <size_t AROW, size_t AH, size_t BB, size_t BH>
struct OrderAttn {
    int G, c; const char* A; const char* Bt;
    DI bool next(int i, pg8::Unit& u) const {
        const long L = (long)i * G + c; if (L >= 256) return false;
        const int b = (int)L >> 5, h = ((int)L >> 3) & 3, rb = (int)L & 7;
        u.pm = b * 8 + rb; u.pn = h;
        u.a = A + (size_t)u.pm * 256 * AROW + (size_t)h * AH;
        u.b = Bt + (size_t)b * BB + (size_t)h * BH; return true;
    }
};

template <class GE>
DI void skinny_job(Frame& F, const bf16* A, int lda, const bf16* Bt, int ldb, int K, const GE& ge, int col_out) {
    const int tid = opaque_tid(), lane = tid & 63, wid = __builtin_amdgcn_readfirstlane(tid >> 6), fr = lane & 15, fq = lane >> 4, row = wid * 16 + fr;
    const bf16* ap = A + (size_t)row * lda + fq * 8;
    const bf16* b0 = Bt + (size_t)fr * ldb + fq * 8; const bf16* b1 = b0 + (size_t)16 * ldb;
    f32x4 acc0 = (f32x4){0.f, 0.f, 0.f, 0.f}, acc1 = acc0;
#pragma unroll 8
    for (int k0 = 0; k0 < K; k0 += 32) {
        const bf16x8 a = *(const bf16x8*)(ap + k0), x0 = *(const bf16x8*)(b0 + k0), x1 = *(const bf16x8*)(b1 + k0);
        acc0 = __builtin_amdgcn_mfma_f32_16x16x32_bf16(x0, a, acc0, 0, 0, 0);
        acc1 = __builtin_amdgcn_mfma_f32_16x16x32_bf16(x1, a, acc1, 0, 0, 0);
    }
    ge(MP + row, col_out + fq * 4, acc0); ge(MP + row, col_out + 16 + fq * 4, acc1);
}
template <class GE>
DI void skinny_gemm(Frame& F, const bf16* A, int lda, const bf16* Bt, int ldb, int N, int K, const GE& ge) {
    for (int job = F.vcu; job < N / 32; job += F.G) skinny_job(F, A, lda, Bt + (size_t)job * 32 * ldb, ldb, K, ge, job * 32);
}

DI void transpose_item(const float* W, int ldw, int K, bf16* WT, int k0, int n0src, int n0dst, LAS float* scr, int lane) {
#pragma unroll 16
    for (int k = 0; k < 64; ++k) scr[k * 65 + lane] = W[(size_t)(k0 + k) * ldw + n0src + lane];
    LDS_WAIT(); asm volatile("" ::: "memory");
    const int c = lane & 7;
#pragma unroll
    for (int j = 0; j < 8; ++j) { const int n = (lane >> 3) + 8 * j; const LAS float* sp = scr + (8 * c) * 65 + n;
        u32x4 o; o.x = pk2(sp[0 * 65], sp[1 * 65]); o.y = pk2(sp[2 * 65], sp[3 * 65]); o.z = pk2(sp[4 * 65], sp[5 * 65]); o.w = pk2(sp[6 * 65], sp[7 * 65]);
        *(u32x4*)(WT + (size_t)(n0dst + n) * K + k0 + 8 * c) = o; }
    LDS_WAIT(); asm volatile("" ::: "memory");
}
DI void mat_item(const float* W, int ldw, int K, int N, bf16* WT, int item, LAS float* scr, int lane, int shift_at) {
    const int nblk = N / 64, kb = item / nblk, nb = item % nblk, n0 = 64 * nb;
    transpose_item(W, ldw, K, WT, 64 * kb, n0 + (n0 >= shift_at ? 8 : 0), n0, scr, lane);
}
DI void phase_convert(Frame& F) {
    const int tid = opaque_tid(), lane = tid & 63, wid = __builtin_amdgcn_readfirstlane(tid >> 6);
    LAS float* scr = (LAS float*)(F.lds + wid * 16640);
    const int gw = F.vcu * 8 + wid, NGW = F.G * 8;
    constexpr int I_IN = 16 * 144, I_SQ = 16 * 16, I_KV = 16 * 32, I_UP = 16 * 88, I_DN = 44 * 16, I_P = 4 * 4;
    constexpr int PER_L = I_IN + 3 * I_SQ + I_KV + I_UP + I_DN + 4 * I_P;
    for (int it = gw; it < DEPTH * PER_L; it += NGW) {
        const int l = it / PER_L; int r = it % PER_L;
        if (r < I_IN) { mat_item(((const float*)F.in[12]) + (size_t)l * D * INW, INW, D, NPROJ, WSP(bf16, WS_WIN + l * SZ_WIN), r, scr, lane, 4096); continue; } r -= I_IN;
        if (r < I_SQ) { mat_item(((const float*)F.in[15]) + (size_t)l * D * D, D, D, D, WSP(bf16, WS_WM + l * SZ_W1K), r, scr, lane, 1 << 30); continue; } r -= I_SQ;
        if (r < I_SQ) { mat_item(((const float*)F.in[19]) + (size_t)l * D * D, D, D, D, WSP(bf16, WS_WX + l * SZ_W1K), r, scr, lane, 1 << 30); continue; } r -= I_SQ;
        if (r < I_SQ) { mat_item(((const float*)F.in[20]) + (size_t)l * D * D, D, D, D, WSP(bf16, WS_WO + l * SZ_W1K), r, scr, lane, 1 << 30); continue; } r -= I_SQ;
        if (r < I_KV) { mat_item(((const float*)F.in[18]) + (size_t)l * D * 2048, 2048, D, 2048, WSP(bf16, WS_WKV + l * SZ_WKV), r, scr, lane, 1 << 30); continue; } r -= I_KV;
        if (r < I_UP) { const int kb = r / 88, nb = r % 88, u = nb >> 2, q = nb & 3;
            transpose_item(((const float*)F.in[23]) + (size_t)l * D * FF2, FF2, D, WSP(bf16, WS_WUP + l * SZ_WUP), 64 * kb, (q >> 1) * FF + 128 * u + (q & 1) * 64, 64 * nb, scr, lane); continue; } r -= I_UP;
        if (r < I_DN) { mat_item(((const float*)F.in[26]) + (size_t)l * FF * D, D, FF, D, WSP(bf16, WS_WDN + l * SZ_WDN), r, scr, lane, 1 << 30); continue; } r -= I_DN;
        { const int g = r / I_P, ri = r % I_P; mat_item(((const float*)F.in[16]) + ((size_t)l * 4 + g) * 65536, 256, 256, 256, WSP(bf16, WS_WP + l * SZ_WP) + (size_t)g * 65536, ri, scr, lane, 1 << 30); }
    }
    { const float* mem = ((const float*)F.in[1]); bf16* mb = WSP(bf16, WS_MEMB);
      for (size_t i = ((size_t)F.vcu * 512 + tid) * 8; i < (size_t)2048 * D; i += (size_t)F.G * 512 * 8) {
          const f32x4 a = *(const f32x4*)(mem + i), b = *(const f32x4*)(mem + i + 4);
          u32x4 o; o.x = pk2(a.x, a.y); o.y = pk2(a.z, a.w); o.z = pk2(b.x, b.y); o.w = pk2(b.z, b.w); *(u32x4*)(mb + i) = o; } }
}

DI void stage_gate_w(Frame& F, int l) {
    LAS float* wg = (LAS float*)F.lds;
    const float* w = ((const float*)F.in[12]) + (size_t)l * D * INW + 4096;
    for (int i = opaque_tid(); i < 8192; i += 512) { const int k = i >> 3, j = i & 7; wg[j * 1024 + k] = w[(size_t)k * INW + j]; }
    __syncthreads();
}
DI void ln_row(Frame& F, const int lane, const float* src, const float* gam, const float* bet, int row, int lg, float* fin) {
    const f32x4* xr = (const f32x4*)src + lane;
    f32x4 v[4]; float s = 0.f;
#pragma unroll
    for (int j = 0; j < 4; ++j) { v[j] = xr[64 * j]; s += (v[j].x + v[j].y) + (v[j].z + v[j].w); }
    const float mean = wave_sum(s) * (1.f / D); float s2 = 0.f;
#pragma unroll
    for (int j = 0; j < 4; ++j) { v[j] = v[j] - mean; s2 += (v[j].x * v[j].x + v[j].y * v[j].y) + (v[j].z * v[j].z + v[j].w * v[j].w); }
    const float rstd = 1.f / sqrtf(wave_sum(s2) * (1.f / D) + LN_EPS);
    f32x4* xo = (f32x4*)(WSP(float, WS_X) + (size_t)row * D) + lane;
    u32x2* no = (u32x2*)(WSP(bf16, WS_XN) + (size_t)row * D) + lane;
#pragma unroll
    for (int j = 0; j < 4; ++j) {
        const f32x4 g = ((const f32x4*)gam)[lane + 64 * j], b = ((const f32x4*)bet)[lane + 64 * j];
        v[j] = v[j] * rstd * g + b;
        xo[64 * j] = v[j];
        u32x2 w; w.x = pk2(v[j].x, v[j].y); w.y = pk2(v[j].z, v[j].w); no[64 * j] = w;
        if (fin) ((f32x4*)fin)[lane + 64 * j] = v[j];
    }
    if (lg >= 0) {
        const LAS float* wg = (const LAS float*)F.lds;
        float a[8];
#pragma unroll
        for (int q = 0; q < 8; ++q) { float t = 0.f;
#pragma unroll
            for (int j = 0; j < 4; ++j) { const f32x4 w = *(const LAS f32x4*)(wg + q * 1024 + 4 * lane + 256 * j); t += (v[j].x * w.x + v[j].y * w.y) + (v[j].z * w.z + v[j].w * w.w); }
            a[q] = wave_sum(t); }
        if (lane == 0) { const float* bb = ((const float*)F.in[13]) + (size_t)lg * INW + 4096; float* o = WSP(float, WS_IGFG) + (size_t)row * 8;
#pragma unroll
            for (int q = 0; q < 8; ++q) o[q] = a[q] + bb[q]; }
    }
}
DI void phase_ln_in(Frame& F) {
    stage_gate_w(F, 0);
    const int tid = opaque_tid(), lane = tid & 63, wid = __builtin_amdgcn_readfirstlane(tid >> 6);
    const int gw = F.vcu * 8 + wid, NGW = F.G * 8;
    for (int r = gw; r < MT; r += NGW) {
        const float* src = r < MP ? ((const float*)F.in[0]) + (size_t)r * D : ((const float*)F.in[2]) + (size_t)(r - MP) * D;
        ln_row(F, lane, src, ((const float*)F.in[10]), ((const float*)F.in[11]), r, 0, nullptr);
    }
    __syncthreads();
}
DI void phase_ln(Frame& F, int l, int which) {
    const int lg = (which == 1 && l + 1 < DEPTH) ? l + 1 : -1;
    if (lg >= 0) stage_gate_w(F, lg);
    const float* gam = (const float*)(which ? F.in[27] : F.in[21]) + (size_t)l * D; const float* bet = (const float*)(which ? F.in[28] : F.in[22]) + (size_t)l * D;
    const bool last = (which == 1 && l == DEPTH - 1);
    const int tid = opaque_tid(), lane = tid & 63, wid = __builtin_amdgcn_readfirstlane(tid >> 6);
    const int gw = F.vcu * 8 + wid, NGW = F.G * 8;
    for (int r = gw; r < MT; r += NGW) {
        float* fin = last ? (r < MP ? F.out + O_YP + (size_t)r * D : F.out + O_YS + (size_t)(r - MP) * D) : nullptr;
        ln_row(F, lane, WSP(float, WS_T) + (size_t)r * D, gam, bet, r, lg, fin);
    }
    __syncthreads();
}

constexpr int MP_Q = 0, MP_K = 33792, MP_T2 = 67584, MP_VEC = 104448, MP_END = 104448 + 4 * 6 * 64 * 4;
static_assert(MP_END <= XCH_OFF, "mLSTM prep LDS map");
DI float log_sigmoid(float x) { return fminf(x, 0.f) - log1pf(expf(-fabsf(x))); }
#define DPP_F(oldv, src, ctrl, rmask, bc) __builtin_bit_cast(float, __builtin_amdgcn_update_dpp(__builtin_bit_cast(int, (float)(oldv)), __builtin_bit_cast(int, (float)(src)), ctrl, rmask, 0xf, bc))
DI float wave_scan_add(float v) {
    v += DPP_F(0.f, v, 0x111, 0xf, true); v += DPP_F(0.f, v, 0x112, 0xf, true); v += DPP_F(0.f, v, 0x114, 0xf, true); v += DPP_F(0.f, v, 0x118, 0xf, true);
    v += DPP_F(0.f, v, 0x142, 0xa, true); v += DPP_F(0.f, v, 0x143, 0xc, true); return v; }
DI float wave_scan_max(float v) {
    v = fmaxf(v, DPP_F(v, v, 0x111, 0xf, false)); v = fmaxf(v, DPP_F(v, v, 0x112, 0xf, false)); v = fmaxf(v, DPP_F(v, v, 0x114, 0xf, false)); v = fmaxf(v, DPP_F(v, v, 0x118, 0xf, false));
    v = fmaxf(v, DPP_F(v, v, 0x142, 0xa, false)); v = fmaxf(v, DPP_F(v, v, 0x143, 0xc, false)); return v; }
DI void mlstm_prep_job(Frame& F, int l, int job) {
    const int b = job >> 5, hh = (job >> 3) & 3, c4 = job & 7;
    const int tid = opaque_tid(), lane = tid & 63, wid = __builtin_amdgcn_readfirstlane(tid >> 6), fr = lane & 15, fq = lane >> 4;
    LAS unsigned char* L = F.lds;
    LAS float* vecs = (LAS float*)(L + MP_VEC);
    const bf16* projb = WSP(bf16, WS_PROJ) + (size_t)b * SEQ * NPROJ;
    const size_t bh = (size_t)(b * NH + hh);
    bf16* PTg = WSP(bf16, WS_PT) + bh * 32 * 4096; bf16* KWg = WSP(bf16, WS_KWT) + bh * 32 * 16384; bf16* VTg = WSP(bf16, WS_VTT) + bh * 32 * 16384;
    float* GTg = WSP(float, WS_GT) + bh * 32 * 192;
    if (wid == 0) {
        const float* igfg = WSP(float, WS_IGFG) + (size_t)b * SEQ * 8;
        float mprev = 0.f; const int nch = 4 * c4 + 4;
#pragma unroll 4
        for (int ch = 0; ch < nch; ++ch) {
            const float igv = igfg[(size_t)(ch * 64 + lane) * 8 + hh], fgv = igfg[(size_t)(ch * 64 + lane) * 8 + 4 + hh];
            const float lf = log_sigmoid(fgv);
            const float bb = wave_scan_add(lf);
            const float a = igv - bb; const float cm = wave_scan_max(a);
            const float mt = bb + fmaxf(mprev, cm);
            const float mL = __builtin_bit_cast(float, __builtin_amdgcn_readlane(__builtin_bit_cast(int, mt), 63)), bL = __builtin_bit_cast(float, __builtin_amdgcn_readlane(__builtin_bit_cast(int, bb), 63));
            if (ch >= 4 * c4) {
                const int ci = ch - 4 * c4;
                LAS float* v = vecs + ci * 384;
                v[lane] = a; v[64 + lane] = bb; v[128 + lane] = mt; v[192 + lane] = expf(a + bL - mL);
                float* g = GTg + (size_t)ch * 192;
                g[lane] = expf(mprev + bb - mt); g[64 + lane] = expf(-mt);
                if (lane == 0) g[128] = expf(mprev + bL - mL);
            }
            mprev = mL;
        }
        if (c4 == 7 && lane == 0) F.out[O_PM + (l * NB + b) * NH + hh] = mprev;
    }
    u32x4 q4[4], k4[4], v4[4];
#define MP_LOAD(c) do { const bf16* pr = projb + (size_t)((c) * 64 + lane) * NPROJ + hh * 256 + wid * 32; \
        _Pragma("unroll") for (int i = 0; i < 4; ++i) { q4[i] = *(const u32x4*)(pr + C_Q + i * 8); k4[i] = *(const u32x4*)(pr + C_K + i * 8); v4[i] = *(const u32x4*)(pr + C_V + i * 8); } } while (0)
    MP_LOAD(4 * c4);
    __syncthreads();
    for (int ci = 0; ci < 4; ++ci) {
        const int c = 4 * c4 + ci;
        const LAS float* vec = vecs + ci * 384;
#pragma unroll
        for (int i = 0; i < 4; ++i) { *(LAS u32x4*)(L + MP_Q + lane * 528 + (wid * 32 + i * 8) * 2) = q4[i]; *(LAS u32x4*)(L + MP_K + lane * 528 + (wid * 32 + i * 8) * 2) = k4[i]; }
        { const float w = vec[192 + lane] * 0.0625f;
#pragma unroll
          for (int i = 0; i < 4; ++i) { float kf[8]; unpack8(k4[i], kf);
#pragma unroll
            for (int j = 0; j < 8; ++j) ((LAS unsigned short*)(L + MP_T2))[(wid * 32 + i * 8 + j) * 72 + lane] = (unsigned short)f2bf(kf[j] * w); } }
        u32x4 vc4[4];
#pragma unroll
        for (int i = 0; i < 4; ++i) vc4[i] = v4[i];
        __syncthreads();
        if (ci + 1 < 4) MP_LOAD(c + 1);
        { const int tt = wid >> 1;
#pragma unroll
          for (int si = 0; si < 2; ++si) { const int st = (wid & 1) * 2 + si;
            f32x4 acc = (f32x4){0.f, 0.f, 0.f, 0.f};
            if (st <= tt) {
#pragma unroll
                for (int kk = 0; kk < 8; ++kk) { const bf16x8 kf = *(const LAS bf16x8*)(L + MP_K + (st * 16 + fr) * 528 + (kk * 32 + fq * 8) * 2), qf = *(const LAS bf16x8*)(L + MP_Q + (tt * 16 + fr) * 528 + (kk * 32 + fq * 8) * 2);
                    acc = __builtin_amdgcn_mfma_f32_16x16x32_bf16(kf, qf, acc, 0, 0, 0); }
            }
            const int t = tt * 16 + fr, s0 = st * 16 + fq * 4; const float bt = vec[64 + t] - vec[128 + t];
            float p[4];
#pragma unroll
            for (int j = 0; j < 4; ++j) { const int s = s0 + j; p[j] = (s <= t) ? acc[j] * 0.0625f * __expf(vec[s] + bt) : 0.f; }
            u32x2 w; w.x = pk2(p[0], p[1]); w.y = pk2(p[2], p[3]); *(u32x2*)(PTg + (size_t)c * 4096 + t * 64 + s0) = w; } }
        { const int d = tid >> 1, hf = tid & 1; bf16* o = KWg + (size_t)c * 16384 + d * 64 + hf * 32;
#pragma unroll
          for (int i = 0; i < 4; ++i) *(u32x4*)(o + i * 8) = *(const LAS u32x4*)(L + MP_T2 + d * 144 + hf * 64 + i * 16); }
        __syncthreads();
#pragma unroll
        for (int i = 0; i < 4; ++i) { const unsigned ww[4] = {vc4[i].x, vc4[i].y, vc4[i].z, vc4[i].w};
#pragma unroll
            for (int j = 0; j < 4; ++j) { ((LAS unsigned short*)(L + MP_T2))[(wid * 32 + i * 8 + 2 * j) * 72 + lane] = (unsigned short)(ww[j] & 0xffffu); ((LAS unsigned short*)(L + MP_T2))[(wid * 32 + i * 8 + 2 * j + 1) * 72 + lane] = (unsigned short)(ww[j] >> 16); } }
        __syncthreads();
        { const int d = tid >> 1, hf = tid & 1; bf16* o = VTg + (size_t)c * 16384 + d * 64 + hf * 32;
#pragma unroll
          for (int i = 0; i < 4; ++i) *(u32x4*)(o + i * 8) = *(const LAS u32x4*)(L + MP_T2 + d * 144 + hf * 64 + i * 16); }
        __syncthreads();
    }
#undef MP_LOAD
}

constexpr int MR_CT = 0, MR_NUM = 25344, MR_DEN = 33536, MR_END = 34048;
DI void mlstm_rec_job(Frame& F, int l, int job) {
    const int b = job >> 5, hh = (job >> 3) & 3, sl = job & 7;
    const int tid = opaque_tid(), lane = tid & 63, wid = __builtin_amdgcn_readfirstlane(tid >> 6), fr = lane & 15, fq = lane >> 4;
    const int tt = wid >> 1, et = wid & 1, t = tt * 16 + fr;
    LAS unsigned char* L = F.lds;
    const size_t bh = (size_t)(b * NH + hh);
    const bf16* qp = WSP(bf16, WS_PROJ) + ((size_t)b * SEQ + t) * NPROJ + C_Q + hh * 256 + fq * 8;
    const bf16* pp = WSP(bf16, WS_PT) + bh * 32 * 4096 + t * 64 + fq * 8;
    const bf16* kp = WSP(bf16, WS_KWT) + bh * 32 * 16384 + (wid * 32 + fr) * 64 + fq * 8;
    const bf16* vp = WSP(bf16, WS_VTT) + bh * 32 * 16384 + (sl * 32 + fr) * 64 + fq * 8;
    const float* gp = WSP(float, WS_GT) + bh * 32 * 192;
    const int ht = tid >> 3, he0 = (tid & 7) * 4;
    const bf16* sop = WSP(bf16, WS_PROJ) + ((size_t)b * SEQ + ht) * NPROJ + C_O + hh * 256 + sl * 32 + he0;
    bf16* hc = WSP(bf16, WS_HC) + ((size_t)b * SEQ + ht) * D + hh * 256 + sl * 32 + he0;
    for (int i = tid; i < 25344 / 4; i += 512) ((LAS unsigned*)(L + MR_CT))[i] = 0u;
    f32x4 cacc[2][3];
#pragma unroll
    for (int i = 0; i < 2; ++i)
#pragma unroll
        for (int j = 0; j < 3; ++j) cacc[i][j] = (f32x4){0.f, 0.f, 0.f, 0.f};
    bf16x8 ones; { const short o = (fr == 0) ? (short)0x3F80 : (short)0;
#pragma unroll
        for (int j = 0; j < 8; ++j) ones[j] = o; }
    bf16x8 qf[8], pf[2], kfA[2][2], vfA[2][2], kfB[2][2], vfB[2][2]; float interA, enmA, decA, interB, enmB, decB; u32x2 soA, soB;
#define MR_LOADQP(c) do { \
        _Pragma("unroll") for (int kk = 0; kk < 8; ++kk) qf[kk] = *(const bf16x8*)(qp + (size_t)(c) * 64 * NPROJ + kk * 32); \
        _Pragma("unroll") for (int ks = 0; ks < 2; ++ks) pf[ks] = *(const bf16x8*)(pp + (size_t)(c) * 4096 + ks * 32); } while (0)
#define MR_LOADKV(S, c) do { \
        _Pragma("unroll") for (int ks = 0; ks < 2; ++ks) { \
            _Pragma("unroll") for (int x = 0; x < 2; ++x) { kf##S[x][ks] = *(const bf16x8*)(kp + (size_t)(c) * 16384 + x * 1024 + ks * 32); vf##S[x][ks] = *(const bf16x8*)(vp + (size_t)(c) * 16384 + x * 1024 + ks * 32); } } \
        inter##S = gp[(c) * 192 + t]; enm##S = gp[(c) * 192 + 64 + ht]; dec##S = gp[(c) * 192 + 128]; so##S = *(const u32x2*)(sop + (size_t)(c) * 64 * NPROJ); } while (0)
#define MR_BODY(S, N, c) do { \
          \
        f32x4 aP = (f32x4){0.f, 0.f, 0.f, 0.f}, aC0 = aP, aC1 = aP, dP = aP, dC = aP; \
        bf16x8 cf[8], c2[4]; \
        _Pragma("unroll") for (int kk = 0; kk < 8; ++kk) cf[kk] = *(const LAS bf16x8*)(L + MR_CT + (et * 16 + fr) * 528 + (kk * 32 + fq * 8) * 2); \
        _Pragma("unroll") for (int kk = 0; kk < 4; ++kk) c2[kk] = *(const LAS bf16x8*)(L + MR_CT + (32 + fr) * 528 + ((et * 4 + kk) * 32 + fq * 8) * 2); \
        if (et == 0) { _Pragma("unroll") for (int ks = 0; ks < 2; ++ks) { aP = __builtin_amdgcn_mfma_f32_16x16x32_bf16(vf##S[0][ks], pf[ks], aP, 0, 0, 0); dP = __builtin_amdgcn_mfma_f32_16x16x32_bf16(ones, pf[ks], dP, 0, 0, 0); } \
            _Pragma("unroll") for (int kk = 0; kk < 4; ++kk) dC = __builtin_amdgcn_mfma_f32_16x16x32_bf16(c2[kk], qf[kk], dC, 0, 0, 0); } \
        else { _Pragma("unroll") for (int ks = 0; ks < 2; ++ks) aP = __builtin_amdgcn_mfma_f32_16x16x32_bf16(vf##S[1][ks], pf[ks], aP, 0, 0, 0); \
            _Pragma("unroll") for (int kk = 0; kk < 4; ++kk) dC = __builtin_amdgcn_mfma_f32_16x16x32_bf16(c2[kk], qf[4 + kk], dC, 0, 0, 0); } \
        _Pragma("unroll") for (int kk = 0; kk < 8; kk += 2) { aC0 = __builtin_amdgcn_mfma_f32_16x16x32_bf16(cf[kk], qf[kk], aC0, 0, 0, 0); aC1 = __builtin_amdgcn_mfma_f32_16x16x32_bf16(cf[kk + 1], qf[kk + 1], aC1, 0, 0, 0); } \
        __builtin_amdgcn_sched_barrier(0); \
        if ((c) + 1 < SEQ / 64) { MR_LOADQP((c) + 1); MR_LOADKV(N, (c) + 1); } \
        __builtin_amdgcn_sched_barrier(0); \
        *(LAS f32x4*)(L + MR_NUM + (t * 32 + et * 16 + fq * 4) * 4) = aP + (aC0 + aC1) * inter##S; \
        if (fq == 0) ((LAS float*)(L + MR_DEN))[t * 2 + et] = dP.x + dC.x * inter##S; \
        __syncthreads();                                                      \
          \
        { const f32x4 nm = *(const LAS f32x4*)(L + MR_NUM + (ht * 32 + he0) * 4); const float den = ((LAS float*)(L + MR_DEN))[ht * 2] + ((LAS float*)(L + MR_DEN))[ht * 2 + 1]; \
          const float inv = 1.0f / fmaxf(fabsf(den), enm##S); \
          u32x2 w; w.x = pk2(lo16(so##S.x) * nm.x * inv, hi16(so##S.x) * nm.y * inv); w.y = pk2(lo16(so##S.y) * nm.z * inv, hi16(so##S.y) * nm.w * inv); \
          *(u32x2*)(hc + (size_t)(c) * 64 * D) = w; } \
          \
        _Pragma("unroll") for (int di = 0; di < 2; ++di) { \
            _Pragma("unroll") for (int e3 = 0; e3 < 3; ++e3) { f32x4 a = cacc[di][e3] * dec##S; \
                _Pragma("unroll") for (int ks = 0; ks < 2; ++ks) a = __builtin_amdgcn_mfma_f32_16x16x32_bf16(kf##S[di][ks], e3 == 2 ? ones : vf##S[e3 & 1][ks], a, 0, 0, 0); \
                cacc[di][e3] = a; \
                u32x2 w; w.x = pk2(a.x, a.y); w.y = pk2(a.z, a.w); *(LAS u32x2*)(L + MR_CT + (e3 * 16 + fr) * 528 + ((wid * 2 + di) * 16 + fq * 4) * 2) = w; } } \
        __syncthreads();                                                      \
    } while (0)
    MR_LOADQP(0); MR_LOADKV(A, 0);
    __syncthreads();
#pragma unroll 1
    for (int c = 0; c < SEQ / 64; c += 2) { MR_BODY(A, B, c); MR_BODY(B, A, c + 1); }
#undef MR_BODY
#undef MR_LOADKV
#undef MR_LOADQP
    { float* pc = F.out + O_PC + ((size_t)((l * NB + b) * NH + hh)) * 65536;
#pragma unroll
      for (int di = 0; di < 2; ++di) { const int dt = wid * 2 + di;
#pragma unroll
        for (int e3 = 0; e3 < 2; ++e3)
#pragma unroll
            for (int j = 0; j < 4; ++j) pc[(size_t)(dt * 16 + fq * 4 + j) * 256 + sl * 32 + e3 * 16 + fr] = cacc[di][e3][j];
        if (sl == 0 && fr == 0) { float* pn = F.out + O_PN + ((size_t)((l * NB + b) * NH + hh)) * 256;
#pragma unroll
            for (int j = 0; j < 4; ++j) pn[dt * 16 + fq * 4 + j] = cacc[di][2][j]; } } }
    __syncthreads();
}

constexpr int R2_CT = 0, R2_NUM = 42240, R2_DEN = 75008, R2_END = 75520;
static_assert(R2_END <= XCH_OFF, "rec2 LDS map");
DI void mlstm_rec2_job(Frame& F, int l, int job) {
    const int b = job >> 4, hh = (job >> 2) & 3, sp = job & 3;
    const int tid = opaque_tid(), lane = tid & 63, wid = __builtin_amdgcn_readfirstlane(tid >> 6), fr = lane & 15, fq = lane >> 4;
    const int tt = wid >> 1, kh = wid & 1, t = tt * 16 + fr;
    LAS unsigned char* L = F.lds;
    const size_t bh = (size_t)(b * NH + hh);
    const bf16* qp = WSP(bf16, WS_PROJ) + ((size_t)b * SEQ + t) * NPROJ + C_Q + hh * 256 + kh * 128 + fq * 8;
    const bf16* pp = WSP(bf16, WS_PT) + bh * 32 * 4096 + t * 64 + kh * 32 + fq * 8;
    const bf16* kp = WSP(bf16, WS_KWT) + bh * 32 * 16384 + (wid * 32 + fr) * 64 + fq * 8;
    const bf16* vp = WSP(bf16, WS_VTT) + bh * 32 * 16384 + (sp * 64 + fr) * 64 + fq * 8;
    const float* gp = WSP(float, WS_GT) + bh * 32 * 192;
    const int ht = tid >> 3, he0 = (tid & 7) * 8;
    const bf16* sop = WSP(bf16, WS_PROJ) + ((size_t)b * SEQ + ht) * NPROJ + C_O + hh * 256 + sp * 64 + he0;
    bf16* hc = WSP(bf16, WS_HC) + ((size_t)b * SEQ + ht) * D + hh * 256 + sp * 64 + he0;
    for (int i = tid; i < 42240 / 4; i += 512) ((LAS unsigned*)(L + R2_CT))[i] = 0u;
    f32x4 cacc[2][5];
#pragma unroll
    for (int i = 0; i < 2; ++i)
#pragma unroll
        for (int j = 0; j < 5; ++j) cacc[i][j] = (f32x4){0.f, 0.f, 0.f, 0.f};
    bf16x8 ones; { const short o = (fr == 0) ? (short)0x3F80 : (short)0;
#pragma unroll
        for (int j = 0; j < 8; ++j) ones[j] = o; }
    bf16x8 qf[4], pf, kf[2][2], vfA[4][2], vfB[4][2]; float interA, enmA, decA, interB, enmB, decB; u32x4 soA, soB;
#define R2_LOADQP(c) do { \
        _Pragma("unroll") for (int kk = 0; kk < 4; ++kk) qf[kk] = *(const bf16x8*)(qp + (size_t)(c) * 64 * NPROJ + kk * 32); \
        pf = *(const bf16x8*)(pp + (size_t)(c) * 4096); } while (0)
#define R2_LOADK(c) do { \
        _Pragma("unroll") for (int ks = 0; ks < 2; ++ks) { \
            _Pragma("unroll") for (int x = 0; x < 2; ++x) kf[x][ks] = *(const bf16x8*)(kp + (size_t)(c) * 16384 + x * 1024 + ks * 32); } } while (0)
#define R2_LOADKV(S, c) do { \
        _Pragma("unroll") for (int ks = 0; ks < 2; ++ks) { \
            _Pragma("unroll") for (int e = 0; e < 4; ++e) vf##S[e][ks] = *(const bf16x8*)(vp + (size_t)(c) * 16384 + e * 1024 + ks * 32); } \
        inter##S = gp[(c) * 192 + t]; enm##S = gp[(c) * 192 + 64 + ht]; dec##S = gp[(c) * 192 + 128]; so##S = *(const u32x4*)(sop + (size_t)(c) * 64 * NPROJ); } while (0)
#define R2_BODY(S, N, c) do { \
        f32x4 ac[5]; \
        _Pragma("unroll") for (int e = 0; e < 5; ++e) { bf16x8 cf[4]; f32x4 a = (f32x4){0.f, 0.f, 0.f, 0.f}; \
            _Pragma("unroll") for (int kk = 0; kk < 4; ++kk) cf[kk] = *(const LAS bf16x8*)(L + R2_CT + (e * 16 + fr) * 528 + ((kh * 4 + kk) * 32 + fq * 8) * 2); \
            _Pragma("unroll") for (int kk = 0; kk < 4; ++kk) a = __builtin_amdgcn_mfma_f32_16x16x32_bf16(cf[kk], qf[kk], a, 0, 0, 0); \
            ac[e] = a * inter##S; }                                             \
        if (kh == 0) { _Pragma("unroll") for (int e = 0; e < 4; ++e) ac[e] = __builtin_amdgcn_mfma_f32_16x16x32_bf16(vf##S[e][0], pf, ac[e], 0, 0, 0); } \
        else { _Pragma("unroll") for (int e = 0; e < 4; ++e) ac[e] = __builtin_amdgcn_mfma_f32_16x16x32_bf16(vf##S[e][1], pf, ac[e], 0, 0, 0); } \
        ac[4] = __builtin_amdgcn_mfma_f32_16x16x32_bf16(ones, pf, ac[4], 0, 0, 0); \
        __builtin_amdgcn_sched_barrier(0); \
        if ((c) + 1 < SEQ / 64) { R2_LOADQP((c) + 1); R2_LOADKV(N, (c) + 1); } \
        __builtin_amdgcn_sched_barrier(0); \
        _Pragma("unroll") for (int e = 0; e < 4; ++e) *(LAS f32x4*)(L + R2_NUM + ((kh * 64 + t) * 64 + e * 16 + fq * 4) * 4) = ac[e]; \
        if (fq == 0) ((LAS float*)(L + R2_DEN))[kh * 64 + t] = ac[4].x; \
        __syncthreads();                                                      \
        { const LAS float* n0 = (const LAS float*)(L + R2_NUM) + ht * 64 + he0; \
          const f32x4 x0 = *(const LAS f32x4*)n0 + *(const LAS f32x4*)(n0 + 4096), x1 = *(const LAS f32x4*)(n0 + 4) + *(const LAS f32x4*)(n0 + 4096 + 4); \
          const float den = ((LAS float*)(L + R2_DEN))[ht] + ((LAS float*)(L + R2_DEN))[64 + ht]; \
          const float inv = 1.0f / fmaxf(fabsf(den), enm##S); \
          u32x4 w; w.x = pk2(lo16(so##S.x) * x0.x * inv, hi16(so##S.x) * x0.y * inv); w.y = pk2(lo16(so##S.y) * x0.z * inv, hi16(so##S.y) * x0.w * inv); \
          w.z = pk2(lo16(so##S.z) * x1.x * inv, hi16(so##S.z) * x1.y * inv); w.w = pk2(lo16(so##S.w) * x1.z * inv, hi16(so##S.w) * x1.w * inv); \
          *(u32x4*)(hc + (size_t)(c) * 64 * D) = w; } \
        _Pragma("unroll") for (int di = 0; di < 2; ++di) { \
            _Pragma("unroll") for (int e3 = 0; e3 < 5; ++e3) { f32x4 a = cacc[di][e3] * dec##S; \
                _Pragma("unroll") for (int ks = 0; ks < 2; ++ks) a = __builtin_amdgcn_mfma_f32_16x16x32_bf16(kf[di][ks], e3 == 4 ? ones : vf##S[e3 & 3][ks], a, 0, 0, 0); \
                cacc[di][e3] = a; \
                u32x2 w; w.x = pk2(a.x, a.y); w.y = pk2(a.z, a.w); *(LAS u32x2*)(L + R2_CT + (e3 * 16 + fr) * 528 + ((wid * 2 + di) * 16 + fq * 4) * 2) = w; } } \
        __builtin_amdgcn_sched_barrier(0); \
        if ((c) + 1 < SEQ / 64) R2_LOADK((c) + 1); \
        __builtin_amdgcn_sched_barrier(0); \
        __syncthreads();                                                      \
    } while (0)
    R2_LOADQP(0); R2_LOADKV(A, 0); R2_LOADK(0);
    __syncthreads();
#pragma unroll 1
    for (int c = 0; c < SEQ / 64; c += 2) { R2_BODY(A, B, c); R2_BODY(B, A, c + 1); }
#undef R2_BODY
#undef R2_LOADK
#undef R2_LOADKV
#undef R2_LOADQP
    { float* pc = F.out + O_PC + ((size_t)((l * NB + b) * NH + hh)) * 65536;
#pragma unroll
      for (int di = 0; di < 2; ++di) { const int dt = wid * 2 + di;
#pragma unroll
        for (int e3 = 0; e3 < 4; ++e3)
#pragma unroll
            for (int j = 0; j < 4; ++j) pc[(size_t)(dt * 16 + fq * 4 + j) * 256 + sp * 64 + e3 * 16 + fr] = cacc[di][e3][j];
        if (sp == 0 && fr == 0) { float* pn = F.out + O_PN + ((size_t)((l * NB + b) * NH + hh)) * 256;
#pragma unroll
            for (int j = 0; j < 4; ++j) pn[dt * 16 + fq * 4 + j] = cacc[di][4][j]; } } }
    __syncthreads();
}

DI void mlstm_sample_job(Frame& F, int l, int job) {
    const int b = job >> 2, hh = job & 3; const int tid = opaque_tid(), lane = tid & 63, wid = __builtin_amdgcn_readfirstlane(tid >> 6);
    LAS float* qs = (LAS float*)F.lds;
    LAS float* kws = qs + 256; LAS float* red = qs + 512; LAS float* scal = qs + 512 + 2048;
    const bf16* prow = WSP(bf16, WS_PROJ) + (size_t)(MP + b) * NPROJ;
    const size_t sidx = (size_t)((l * MS + b) * NH + hh);
    const float* C = ((const float*)F.in[5]) + sidx * 65536; const float* nst = ((const float*)F.in[6]) + sidx * 256; float* Cn = F.out + O_SC + sidx * 65536;
    const float ig = WSP(float, WS_IGFG)[(size_t)(MP + b) * 8 + hh], fg = WSP(float, WS_IGFG)[(size_t)(MP + b) * 8 + 4 + hh];
    const float m0 = ((const float*)F.in[7])[sidx];
    const float lf = log_sigmoid(fg), mt = fmaxf(m0 + lf, ig), inter = expf(m0 + lf - mt), wsi = expf(ig - mt);
    if (tid < 256) {
        const float q = bf2f(prow[C_Q + hh * 256 + tid]), k = bf2f(prow[C_K + hh * 256 + tid]) * 0.0625f;
        qs[tid] = q; kws[tid] = k * wsi;
        const float n0 = nst[tid];
        F.out[O_SN + sidx * 256 + tid] = inter * n0 + k * wsi;
        float qk = q * k, qn = q * n0;
        qk = wave_sum(qk); qn = wave_sum(qn);
        if (lane == 0) { scal[wid * 2] = qk; scal[wid * 2 + 1] = qn; }
    }
    __syncthreads();
    const float qk = scal[0] + scal[2] + scal[4] + scal[6], qn = scal[1] + scal[3] + scal[5] + scal[7];
    const float s = qk * wsi, den = s + inter * qn, inv = 1.0f / fmaxf(fabsf(den), expf(-mt));
    const u32x2 vw = *(const u32x2*)(prow + C_V + hh * 256 + lane * 4);
    const f32x4 v4 = (f32x4){lo16(vw.x), hi16(vw.x), lo16(vw.y), hi16(vw.y)};
    f32x4 acc = (f32x4){0.f, 0.f, 0.f, 0.f};
#pragma unroll 8
    for (int i = 0; i < 32; ++i) { const int d = wid * 32 + i; const f32x4 c = *(const f32x4*)(C + (size_t)d * 256 + lane * 4);
        acc += c * qs[d]; *(f32x4*)(Cn + (size_t)d * 256 + lane * 4) = c * inter + v4 * kws[d]; }
    *(LAS f32x4*)(red + wid * 256 + lane * 4) = acc;
    __syncthreads();
    if (tid < 256) { float qc = 0.f;
#pragma unroll
        for (int w = 0; w < 8; ++w) qc += red[w * 256 + tid];
        const float v = bf2f(prow[C_V + hh * 256 + tid]), so = bf2f(prow[C_O + hh * 256 + tid]);
        const float h = (s * v + inter * qc) * inv;
        WSP(bf16, WS_HC)[(size_t)(MP + b) * D + hh * 256 + tid] = (bf16)f2bf(so * h); }
    if (tid == 0) F.out[O_SM + sidx] = mt;
    __syncthreads();
}

DI void xattn_sample_job(Frame& F, int l, int job) {
    const int b = job >> 1, hp = job & 1; const int tid = opaque_tid(), lane = tid & 63, wid = __builtin_amdgcn_readfirstlane(tid >> 6);
    LAS float* sc = (LAS float*)F.lds;
    const bf16* prow = WSP(bf16, WS_XQ) + (size_t)(MP + b) * D + hp * 512;
    const float* Kc = ((const float*)F.in[3]) + ((size_t)(l * MS + b) * NMEM) * 1024 + hp * 512;
    const float* Vc = ((const float*)F.in[4]) + ((size_t)(l * MS + b) * NMEM) * 1024 + hp * 512;
    float q[8]; { const u32x4 w = *(const u32x4*)(prow + lane * 8); unpack8(w, q); }
#pragma unroll 8
    for (int i = 0; i < 32; ++i) { const int m = wid + 8 * i; const f32x4 k0 = *(const f32x4*)(Kc + (size_t)m * 1024 + lane * 8), k1 = *(const f32x4*)(Kc + (size_t)m * 1024 + lane * 8 + 4);
        float t = (q[0] * k0.x + q[1] * k0.y) + (q[2] * k0.z + q[3] * k0.w) + (q[4] * k1.x + q[5] * k1.y) + (q[6] * k1.z + q[7] * k1.w);
#pragma unroll
        for (int o = 1; o < 32; o <<= 1) t += __shfl_xor(t, o);
        if ((lane & 31) == 0) sc[(lane >> 5) * 256 + m] = t * 0.0625f; }
    __syncthreads();
    if (wid < 2) { float x[4]; float mx = -3.0e38f;
#pragma unroll
        for (int j = 0; j < 4; ++j) { x[j] = sc[wid * 256 + lane + 64 * j]; mx = fmaxf(mx, x[j]); }
#pragma unroll
        for (int o = 1; o < 64; o <<= 1) mx = fmaxf(mx, __shfl_xor(mx, o));
        float s = 0.f;
#pragma unroll
        for (int j = 0; j < 4; ++j) { x[j] = expf(x[j] - mx); s += x[j]; }
        s = wave_sum(s); const float inv = 1.0f / s;
#pragma unroll
        for (int j = 0; j < 4; ++j) sc[wid * 256 + lane + 64 * j] = x[j] * inv; }
    __syncthreads();
    {
      const int kg = tid >> 7, c4 = (tid & 127) * 4, hsel = c4 >> 8; f32x4 acc = (f32x4){0.f, 0.f, 0.f, 0.f};
#pragma unroll 16
      for (int i = 0; i < 64; ++i) { const int m = kg * 64 + i; acc += *(const f32x4*)(Vc + (size_t)m * 1024 + c4) * sc[hsel * 256 + m]; }
      LAS f32x4* red = (LAS f32x4*)(sc + 512);
      red[kg * 128 + (tid & 127)] = acc;
      __syncthreads();
      if (tid < 128) { const f32x4 r = (red[tid] + red[128 + tid]) + (red[256 + tid] + red[384 + tid]);
          u32x2 w; w.x = pk2(r.x, r.y); w.y = pk2(r.z, r.w); *(u32x2*)(WSP(bf16, WS_OX) + (size_t)(MP + b) * D + hp * 512 + tid * 4) = w; } }
    __syncthreads();
}

DI void phase_pool_d(Frame& F, int l) {
    const bf16* proj = WSP(bf16, WS_PROJ); bf16* dp = WSP(bf16, WS_DP);
    const int gt = F.vcu * 512 + opaque_tid(), gs = F.G * 512;
    for (int it = gt; it < (MP / 16) * 128; it += gs) {
        const int rb = (int)(it >> 7), cg = (int)(it & 127), row0 = rb * 16, t0 = row0 & (SEQ - 1), b = row0 >> 11, w = 2 << (cg >> 5);
        const bf16* up = proj + (size_t)row0 * NPROJ + C_U + cg * 8;
        float sum[8];
#pragma unroll
        for (int j = 0; j < 8; ++j) sum[j] = 0.f;
        for (int i = 1; i < w; ++i) if (t0 - i >= 0) { float f[8]; unpack8(*(const u32x4*)(up - (size_t)i * NPROJ), f);
#pragma unroll
            for (int j = 0; j < 8; ++j) sum[j] += f[j]; }
#pragma unroll 4
        for (int r = 0; r < 16; ++r) {
            const int t = t0 + r; float u0[8]; unpack8(*(const u32x4*)(up + (size_t)r * NPROJ), u0);
#pragma unroll
            for (int j = 0; j < 8; ++j) sum[j] += u0[j];
            const int nw = (t + 1 < w) ? t + 1 : w; const float inv = 1.0f / (float)nw;
            u32x4 o; o.x = pk2(sum[0] * inv - u0[0], sum[1] * inv - u0[1]); o.y = pk2(sum[2] * inv - u0[2], sum[3] * inv - u0[3]); o.z = pk2(sum[4] * inv - u0[4], sum[5] * inv - u0[5]); o.w = pk2(sum[6] * inv - u0[6], sum[7] * inv - u0[7]);
            *(u32x4*)(dp + (size_t)(row0 + r) * D + cg * 8) = o;
            if (t >= SEQ - 15) { float* pp = F.out + O_PPOOL + ((size_t)(l * NB + b) * 15 + (t - (SEQ - 15))) * 1024 + cg * 8;
                *(f32x4*)pp = (f32x4){u0[0], u0[1], u0[2], u0[3]}; *(f32x4*)(pp + 4) = (f32x4){u0[4], u0[5], u0[6], u0[7]}; }
            if (t - (w - 1) >= 0) { float f[8]; unpack8(*(const u32x4*)(up + (size_t)(r - (w - 1)) * NPROJ), f);
#pragma unroll
                for (int j = 0; j < 8; ++j) sum[j] -= f[j]; }
        }
    }
    for (int it = gt; it < MS * 128; it += gs) {
        const int b = (int)(it >> 7), cg = (int)(it & 127), w = 2 << (cg >> 5);
        const float* sp = ((const float*)F.in[8]) + ((size_t)(l * MS + b) * 15) * 1024 + cg * 8;
        float u0[8], sum[8]; { const u32x4 x = *(const u32x4*)(proj + (size_t)(MP + b) * NPROJ + C_U + cg * 8); unpack8(x, u0); }
#pragma unroll
        for (int j = 0; j < 8; ++j) sum[j] = u0[j];
        for (int i = 1; i < w; ++i) { const f32x4 a = *(const f32x4*)(sp + (size_t)(15 - i) * 1024), c = *(const f32x4*)(sp + (size_t)(15 - i) * 1024 + 4);
            sum[0] += a.x; sum[1] += a.y; sum[2] += a.z; sum[3] += a.w; sum[4] += c.x; sum[5] += c.y; sum[6] += c.z; sum[7] += c.w; }
        const float inv = 1.0f / (float)w;
        u32x4 o; o.x = pk2(sum[0] * inv - u0[0], sum[1] * inv - u0[1]); o.y = pk2(sum[2] * inv - u0[2], sum[3] * inv - u0[3]); o.z = pk2(sum[4] * inv - u0[4], sum[5] * inv - u0[5]); o.w = pk2(sum[6] * inv - u0[6], sum[7] * inv - u0[7]);
        *(u32x4*)(dp + (size_t)(MP + b) * D + cg * 8) = o;
        float* so = F.out + O_SPOOL + ((size_t)(l * MS + b) * 15) * 1024 + cg * 8;
        for (int i = 0; i < 14; ++i) { *(f32x4*)(so + (size_t)i * 1024) = *(const f32x4*)(sp + (size_t)(i + 1) * 1024); *(f32x4*)(so + (size_t)i * 1024 + 4) = *(const f32x4*)(sp + (size_t)(i + 1) * 1024 + 4); }
        *(f32x4*)(so + (size_t)14 * 1024) = (f32x4){u0[0], u0[1], u0[2], u0[3]}; *(f32x4*)(so + (size_t)14 * 1024 + 4) = (f32x4){u0[4], u0[5], u0[6], u0[7]};
    }
}

DI void phase_headnorm(Frame& F, int l) {
    const bf16* hc = WSP(bf16, WS_HC); bf16* hn = WSP(bf16, WS_HN); const float* g = ((const float*)F.in[14]) + (size_t)l * D;
    const int tid = opaque_tid(), lane = tid & 63, wid = __builtin_amdgcn_readfirstlane(tid >> 6);
    const int gw = F.vcu * 8 + wid, NGW = F.G * 8;
    for (int it = gw; it < MT * 4; it += NGW) {
        const size_t off = (size_t)(it >> 2) * D + (it & 3) * 256 + lane * 4;
        const u32x2 w = *(const u32x2*)(hc + off);
        float x0 = lo16(w.x), x1 = hi16(w.x), x2 = lo16(w.y), x3 = hi16(w.y);
        const float mu = wave_sum((x0 + x1) + (x2 + x3)) * (1.f / 256.f);
        x0 -= mu; x1 -= mu; x2 -= mu; x3 -= mu;
        const float var = wave_sum((x0 * x0 + x1 * x1) + (x2 * x2 + x3 * x3)) * (1.f / 256.f);
        const float r = 1.f / sqrtf(var + LN_EPS);
        const f32x4 gg = *(const f32x4*)(g + (it & 3) * 256 + lane * 4);
        u32x2 o; o.x = pk2(x0 * r * gg.x, x1 * r * gg.y); o.y = pk2(x2 * r * gg.z, x3 * r * gg.w);
        *(u32x2*)(hn + off) = o;
    }
}

constexpr int PH_PER_L = 10, PH_TOTAL = 2 + DEPTH * PH_PER_L;
struct Args { const float* in[29]; float* out; unsigned char* ws; int ph_lo, ph_hi, li, pad; };
__global__ void __launch_bounds__(512, 2) trunk_fwd(Args args) {
    extern __shared__ __attribute__((aligned(16))) unsigned char lds_raw[];
    Frame F0;
    F0.lds = (LAS unsigned char*)lds_raw;
    F0.G = gridDim.x; { const int bx = blockIdx.x; F0.vcu = (F0.G % 8 == 0) ? (bx % 8) * (F0.G / 8) + bx / 8 : bx; }
    F0.in = (in_tab_t)__builtin_amdgcn_kernarg_segment_ptr(); F0.out = args.out; F0.ws = args.ws;
    volatile LAS unsigned* MISC = (volatile LAS unsigned*)(F0.lds + MISC_OFF);
    if (threadIdx.x < 64) MISC[threadIdx.x] = 0u;
    __syncthreads();
    unsigned* ctl = (unsigned*)(args.ws + WS_CTL);
    XcdBarrier bar = xcd_barrier_post(ctl + CW_BAR + args.li * XCD_BAR_WORDS, MISC + 8);
    const int lo = args.ph_lo, hi = args.ph_hi;
#define IN(k) (lo <= (k) && (k) < hi)
#define PM(b) ((PHMASK >> (b)) & 1u)
#define SEAM(k) do { if (IN(k) && IN((k) + 1)) xcd_barrier(bar); } while (0)
    const int bx0 = (int)blockIdx.x;

    _Pragma("unroll 1") for (int rep = 0; rep <= REP(16); ++rep) if (PM(0) && IN(0)) { if (rep) xcd_barrier(bar); PHASE_BEGIN(F); phase_convert(F); __syncthreads(); phase_ln_in(F); }
    SEAM(0);
    _Pragma("unroll 1") for (int rep = 0; rep <= REP(17); ++rep) if (PM(1) && IN(1)) { if (rep) xcd_barrier(bar);
        PHASE_BEGIN(F);
        pg8::OrderMN S; S.init(WSP(bf16, WS_MEMB), D, WSP(bf16, WS_WKV), D, 2048, DEPTH * 2048, F.G, bx);
        pg8::EpiGran<GeKV> E{{F.out, WSP(bf16, WS_MK), WSP(bf16, WS_MVT)}};
        pg8::gemm_phase(F.lds, D, D, D, S, E);
    }
    SEAM(1);
    for (int l = 0; l < DEPTH; ++l) {
        const int p0 = 2 + l * PH_PER_L;
        _Pragma("unroll 1") for (int rep = 0; rep <= REP(0); ++rep) if (PM(2) && IN(p0 + 0)) { if (rep) xcd_barrier(bar);
            PHASE_BEGIN(F);
            const bf16* W = WSP(bf16, WS_WIN + l * SZ_WIN);
            pg8::OrderMN S; S.init(WSP(bf16, WS_XN), D, W, D, MP, NPROJ, F.G, bx);
            pg8::EpiGran<GeIn> E{{WSP(bf16, WS_PROJ), ((const float*)F.in[13]) + (size_t)l * INW, WSP(bf16, WS_XQ)}};
            pg8::gemm_phase(F.lds, D, D, D, S, E);
            skinny_gemm(F, WSP(bf16, WS_XN) + (size_t)MP * D, D, W, D, NPROJ, D, E.g);
        }
        SEAM(p0 + 0);
        _Pragma("unroll 1") for (int rep = 0; rep <= REP(1); ++rep) if (PM(3) && IN(p0 + 1)) { if (rep) xcd_barrier(bar);
            PHASE_BEGIN(F);
            _Pragma("unroll 1") for (int sr = 0; sr <= SREP(0); ++sr) if (SM(0)) for (int j = F.vcu; j < 256; j += F.G) mlstm_prep_job(F, l, j);
            _Pragma("unroll 1") for (int sr = 0; sr <= SREP(1); ++sr) if (SM(1)) {
                OrderAttn<(size_t)D * 2, (size_t)256 * 2, (size_t)256 * D * 2, (size_t)256 * 2> S{F.G, bx, (const char*)WSP(bf16, WS_XQ), (const char*)(WSP(bf16, WS_MK) + (size_t)l * 2048 * D)};
                EpiSoftmax E{WSP(bf16, WS_PB), (LAS float*)(F.lds + XCH_OFF)};
                pg8::gemm_phase(F.lds, 256, D, D, S, E);
            }
        }
        SEAM(p0 + 1);
        _Pragma("unroll 1") for (int rep = 0; rep <= REP(2); ++rep) if (PM(4) && IN(p0 + 2)) { if (rep) xcd_barrier(bar);
            PHASE_BEGIN(F);
            const bool split = (F.G % 16 == 0);
            const int xr = bx >> 3, xi = bx & 7, hx = F.G >> 4;
            const bool rec_role = !split || xr < hx;
            const int ri = split ? xi * hx + xr : F.vcu, rn = split ? F.G / 2 : F.G;
            const int oi = split ? xi * hx + (xr - hx) : F.vcu, on = split ? F.G / 2 : F.G;
            if (rec_role) { _Pragma("unroll 1") for (int sr = 0; sr <= SREP(5); ++sr) if (SM(5)) for (int j = ri; j < 128; j += rn) mlstm_rec2_job(F, l, j); }
            if (!split || !rec_role) {
                Frame F2 = F; F2.vcu = oi; F2.G = on;
                if (SM(6)) { OrderAttn<(size_t)D * 2, (size_t)256 * 2, (size_t)256 * 2, (size_t)256 * 2048 * 2> S{on, oi, (const char*)WSP(bf16, WS_PB), (const char*)(WSP(bf16, WS_MVT) + (size_t)l * 1024 * 2048)};
                    pg8::EpiGran<GeBf16> E{{WSP(bf16, WS_OX), D}};
                    pg8::gemm_phase(F.lds, 256, D, 2048, S, E); }
                _Pragma("unroll 1") for (int sr = 0; sr <= SREP(4); ++sr) if (SM(4)) phase_pool_d(F2, l);
            }
            if (SM(2)) { unsigned* qc = (unsigned*)(F.ws + WS_CTL) + CW_QUEUE + 64 * l; volatile LAS unsigned* slot = (volatile LAS unsigned*)(F.lds + MISC_OFF) + 16;
                for (;;) {
                    __syncthreads();
                    if (threadIdx.x == 0) *slot = __hip_atomic_fetch_add(qc, 1u, __ATOMIC_RELAXED, __HIP_MEMORY_SCOPE_AGENT);
                    __syncthreads();
                    const int j = (int)*slot;
                    if (j >= MS * NH + MS * 2) break;
                    if (j < MS * NH) mlstm_sample_job(F, l, j); else xattn_sample_job(F, l, j - MS * NH);
                } }
        }
        SEAM(p0 + 2);
        _Pragma("unroll 1") for (int rep = 0; rep <= REP(3); ++rep) if (PM(5) && IN(p0 + 3)) { if (rep) xcd_barrier(bar); PHASE_BEGIN(F); phase_headnorm(F, l); }
        SEAM(p0 + 3);
        _Pragma("unroll 1") for (int rep = 0; rep <= REP(4); ++rep) if (PM(6) && IN(p0 + 4)) { if (rep) xcd_barrier(bar);
            PHASE_BEGIN(F);
            const bf16* proj = WSP(bf16, WS_PROJ); float* mix = WSP(float, WS_MIX); bf16* mixb = WSP(bf16, WS_MIXB); const float* ps = ((const float*)F.in[17]) + (size_t)l * D;
            { const bf16* W = WSP(bf16, WS_WM + l * SZ_W1K); pg8::OrderMN S; S.init(WSP(bf16, WS_HN), D, W, D, MP, D, F.G, bx);
              pg8::EpiGran<GeMix<0>> E{{mix, mixb, proj, ps}}; pg8::gemm_phase(F.lds, D, D, D, S, E);
              skinny_gemm(F, WSP(bf16, WS_HN) + (size_t)MP * D, D, W, D, D, D, E.g); }
            { const bf16* W = WSP(bf16, WS_WP + l * SZ_WP); pg8::OrderMN S; S.init(WSP(bf16, WS_DP), D, W, 256, MP, D, F.G, bx, 512);
              pg8::EpiGran<GeMix<1>> E{{mix, mixb, proj, ps}}; pg8::gemm_phase(F.lds, 256, D, 256, S, E);
              for (int job = F.vcu; job < 32; job += F.G) { const int g = job >> 3;
                  skinny_job(F, WSP(bf16, WS_DP) + (size_t)MP * D + g * 256, D, W + (size_t)g * 65536 + (size_t)(job & 7) * 32 * 256, 256, 256, E.g, job * 32); } }
            { const bf16* W = WSP(bf16, WS_WX + l * SZ_W1K); pg8::OrderMN S; S.init(WSP(bf16, WS_OX), D, W, D, MP, D, F.G, bx);
              pg8::EpiGran<GeMix<2>> E{{mix, mixb, proj, ps}}; pg8::gemm_phase(F.lds, D, D, D, S, E);
              skinny_gemm(F, WSP(bf16, WS_OX) + (size_t)MP * D, D, W, D, D, D, E.g); }
        }
        SEAM(p0 + 4);
        _Pragma("unroll 1") for (int rep = 0; rep <= REP(5); ++rep) if (PM(7) && IN(p0 + 5)) { if (rep) xcd_barrier(bar);
            PHASE_BEGIN(F);
            const bf16* W = WSP(bf16, WS_WO + l * SZ_W1K); pg8::OrderMN S; S.init(WSP(bf16, WS_MIXB), D, W, D, MP, D, F.G, bx);
            pg8::EpiGran<GeRes> E{{WSP(float, WS_X), WSP(float, WS_T)}}; pg8::gemm_phase(F.lds, D, D, D, S, E);
            skinny_gemm(F, WSP(bf16, WS_MIXB) + (size_t)MP * D, D, W, D, D, D, E.g);
        }
        SEAM(p0 + 5);
        _Pragma("unroll 1") for (int rep = 0; rep <= REP(6); ++rep) if (PM(8) && IN(p0 + 6)) { if (rep) xcd_barrier(bar); PHASE_BEGIN(F); phase_ln(F, l, 0); }
        SEAM(p0 + 6);
        _Pragma("unroll 1") for (int rep = 0; rep <= REP(7); ++rep) if (PM(9) && IN(p0 + 7)) { if (rep) xcd_barrier(bar);
            PHASE_BEGIN(F);
            const bf16* W = WSP(bf16, WS_WUP + l * SZ_WUP); pg8::OrderMN S; S.init(WSP(bf16, WS_XN), D, W, D, MP, FF2, F.G, bx);
            EpiConv E{WSP(bf16, WS_ACT), WSP(float, WS_HALO), F.out, ((const float*)F.in[24]) + (size_t)l * 3 * FF2, ((const float*)F.in[25]) + (size_t)l * FF2, (LAS float*)(F.lds + XCH_OFF), l};
            pg8::gemm_phase(F.lds, D, D, D, S, E);
            skinny_up_conv(F, l, W);
        }
        SEAM(p0 + 7);
        _Pragma("unroll 1") for (int rep = 0; rep <= REP(8); ++rep) if (PM(10) && IN(p0 + 8)) { if (rep) xcd_barrier(bar);
            PHASE_BEGIN(F);
            const bf16* W = WSP(bf16, WS_WDN + l * SZ_WDN); pg8::OrderMN S; S.init(WSP(bf16, WS_ACT), FF, W, FF, MP, D, F.G, bx);
            { pg8::Unit uu; for (int i = 0; S.next(i, uu); ++i) conv_fixup(F, l, uu.pm); VM_WAIT(); __syncthreads(); }
            pg8::EpiGran<GeRes> E{{WSP(float, WS_X), WSP(float, WS_T)}}; pg8::gemm_phase(F.lds, FF, FF, FF, S, E);
            skinny_gemm(F, WSP(bf16, WS_ACT) + (size_t)MP * FF, FF, W, FF, D, FF, E.g);
        }
        SEAM(p0 + 8);
        _Pragma("unroll 1") for (int rep = 0; rep <= REP(9); ++rep) if (PM(11) && IN(p0 + 9)) { if (rep) xcd_barrier(bar); PHASE_BEGIN(F); phase_ln(F, l, 1); }
        SEAM(p0 + 9);
    }
#undef IN
#undef SEAM
}

extern "C" void kernel_launch(void* const* d_in, const int* in_sizes, int n_in, void* d_out, int out_size, void* d_ws, size_t ws_size, hipStream_t stream) {
    static int grid = 0;
    if (grid == 0) {
        if (n_in != 29 || (size_t)out_size != O_END || ws_size < WS_END) { fprintf(stderr, "kernel_launch: unexpected shapes (n_in %d, out %d, ws %zu; need ws >= %zu)\n", n_in, out_size, ws_size, (size_t)WS_END); grid = -1; return; }
        int dev = 0, cus = 0, per_cu = 0;
        if (hipGetDevice(&dev) != hipSuccess || hipDeviceGetAttribute(&cus, hipDeviceAttributeMultiprocessorCount, dev) != hipSuccess) { grid = -1; return; }
        if (hipFuncSetAttribute((const void*)trunk_fwd, hipFuncAttributeMaxDynamicSharedMemorySize, LDS_BYTES) != hipSuccess) { fprintf(stderr, "kernel_launch: hipFuncSetAttribute failed\n"); grid = -1; return; }
        if (hipOccupancyMaxActiveBlocksPerMultiprocessor(&per_cu, (const void*)trunk_fwd, 512, LDS_BYTES) != hipSuccess || per_cu < 1) fprintf(stderr, "kernel_launch: occupancy query reports %d\n", per_cu);
        (void)hipGetLastError();
        grid = cus;
    }
    if (grid < 0) return;
    (void)hipMemsetAsync((char*)d_ws + WS_CTL, 0, CTL_BYTES, stream);
    Args a{};
    for (int i = 0; i < 29; ++i) a.in[i] = (const float*)d_in[i];
    a.out = (float*)d_out; a.ws = (unsigned char*)d_ws; a.pad = 0;
#if MK_SPLIT
    for (int p = 0; p < PH_TOTAL; ++p) { a.ph_lo = p; a.ph_hi = p + 1; a.li = p; hipLaunchKernelGGL(trunk_fwd, dim3(grid), dim3(512), LDS_BYTES, stream, a); }
#else
    a.ph_lo = 0; a.ph_hi = PH_TOTAL; a.li = 0;
    hipLaunchKernelGGL(trunk_fwd, dim3(grid), dim3(512), LDS_BYTES, stream, a);
#endif
}
```

```cpp
#include <hip/hip_runtime.h>
#include <cstdio>
#include <cstdint>

#define LAS __attribute__((address_space(3)))
#define GAS __attribute__((address_space(1)))
typedef unsigned short bf16;
typedef short bf16x8 __attribute__((ext_vector_type(8)));
typedef float f32x4 __attribute__((ext_vector_type(4)));
typedef float f32x2 __attribute__((ext_vector_type(2)));
typedef unsigned u32x4 __attribute__((ext_vector_type(4)));
typedef unsigned u32x2 __attribute__((ext_vector_type(2)));
#define DI __device__ __forceinline__

#ifndef PHMASK
#define PHMASK 0xFFFFFFFFu
#endif
#ifndef SUBMASK
#define SUBMASK 0xFFFFFFFFu
#endif
#define SM(b) ((SUBMASK >> (b)) & 1u)
#ifndef REPMASK
#define REPMASK 0u
#endif
#ifndef SUBREP
#define SUBREP 0u
#endif
#define REP(k) ((int)((REPMASK >> (k)) & 1u))
#define SREP(k) ((int)((SUBREP >> (k)) & 1u))
#ifndef MK_SPLIT
#define MK_SPLIT 0
#endif

constexpr int D = 1024, NB = 8, SEQ = 2048, MP = NB * SEQ, MS = 128, MT = MP + MS, MTP = MP + 256, DEPTH = 4;
constexpr int NPROJ = 9216, INW = 9224;
constexpr int C_Q = 0, C_K = 1024, C_V = 2048, C_O = 3072, C_U = 4096, C_XQ = 5120, C_G = 6144;
constexpr int FF = 2816, FF2 = 5632, NMEM = 256, HD = 256, NH = 4;
constexpr float LN_EPS = 1e-5f;
constexpr float ALPHA = 1.681792830507429f;
constexpr int PAST_LEN = 16384;

constexpr size_t O_YP = 0, O_YS = 16777216, O_PC = 16908288, O_PN = 25296896, O_PM = 25329664, O_PPOOL = 25329792, O_PCONV = 25821312,
                 O_PMK = 26181760, O_PMV = 34570368, O_SC = 42958976, O_SN = 177176704, O_SM = 177700992, O_SPOOL = 177703040, O_SCONV = 185567360, O_END = 191334528;

constexpr size_t al256(size_t x) { return (x + 255) & ~(size_t)255; }
constexpr size_t WS_CTL = 0, CTL_BYTES = 2u << 20;
constexpr size_t WS_WIN = CTL_BYTES;                                        constexpr size_t SZ_WIN = (size_t)NPROJ * D * 2;
constexpr size_t WS_WM = WS_WIN + DEPTH * SZ_WIN;                           constexpr size_t SZ_W1K = (size_t)D * D * 2;
constexpr size_t WS_WX = WS_WM + DEPTH * SZ_W1K;
constexpr size_t WS_WO = WS_WX + DEPTH * SZ_W1K;
constexpr size_t WS_WP = WS_WO + DEPTH * SZ_W1K;                            constexpr size_t SZ_WP = (size_t)D * D * 2;
constexpr size_t WS_WKV = WS_WP + DEPTH * SZ_WP;                            constexpr size_t SZ_WKV = (size_t)2048 * D * 2;
constexpr size_t WS_WUP = WS_WKV + DEPTH * SZ_WKV;                          constexpr size_t SZ_WUP = (size_t)FF2 * D * 2;
constexpr size_t WS_WDN = WS_WUP + DEPTH * SZ_WUP;                          constexpr size_t SZ_WDN = (size_t)D * FF * 2;
constexpr size_t WS_X = al256(WS_WDN + DEPTH * SZ_WDN);
constexpr size_t WS_T = WS_X + (size_t)MTP * D * 4;
constexpr size_t WS_MIX = WS_T + (size_t)MTP * D * 4;
constexpr size_t WS_XN = WS_MIX + (size_t)MTP * D * 4;
constexpr size_t WS_PROJ = WS_XN + (size_t)MTP * D * 2;
constexpr size_t WS_HC = WS_PROJ + (size_t)MTP * NPROJ * 2;
constexpr size_t WS_HN = WS_HC + (size_t)MTP * D * 2;
constexpr size_t WS_DP = WS_HN + (size_t)MTP * D * 2;
constexpr size_t WS_PB = WS_DP + (size_t)MTP * D * 2;
constexpr size_t WS_OX = WS_PB + (size_t)MTP * D * 2;
constexpr size_t WS_MIXB = WS_OX + (size_t)MTP * D * 2;
constexpr size_t WS_HUP = WS_MIXB + (size_t)MTP * D * 2;
constexpr size_t WS_ACT = WS_HUP + (size_t)MTP * FF2 * 2;
constexpr size_t WS_IGFG = WS_ACT + (size_t)MTP * FF * 2;
constexpr size_t WS_MEMB = WS_IGFG + (size_t)MTP * 8 * 4;
constexpr size_t WS_MK = WS_MEMB + (size_t)2048 * D * 2;
constexpr size_t WS_MVT = WS_MK + (size_t)DEPTH * 2048 * D * 2;
constexpr size_t WS_PT = WS_MVT + (size_t)DEPTH * 2048 * D * 2;
constexpr size_t WS_KWT = WS_PT + (size_t)32 * 32 * 4096 * 2;
constexpr size_t WS_VTT = WS_KWT + (size_t)32 * 32 * 16384 * 2;
constexpr size_t WS_GT = WS_VTT + (size_t)32 * 32 * 16384 * 2;
constexpr size_t WS_XQ = WS_GT + (size_t)32 * 32 * 192 * 4;
constexpr size_t WS_HALO = WS_XQ + (size_t)MTP * D * 2;
constexpr size_t WS_END = WS_HALO + (size_t)64 * 4 * FF2 * 4;
static_assert(WS_END <= 2147483648ull, "workspace map exceeds 2 GiB");
constexpr int CW_BAR = 4096, CW_QUEUE = 1024;

constexpr int LDS_BYTES = 147456;
constexpr int XCH_OFF = 131072;
constexpr int MISC_OFF = LDS_BYTES - 256;

DI float bf2f(unsigned v) { return __uint_as_float(v << 16); }
DI unsigned f2bf(float f) { unsigned u = __float_as_uint(f); return (u + 0x7fffu + ((u >> 16) & 1u)) >> 16; }
DI unsigned pk2(float lo, float hi) { return f2bf(lo) | (f2bf(hi) << 16); }
DI float lo16(unsigned w) { return __uint_as_float(w << 16); }
DI float hi16(unsigned w) { return __uint_as_float(w & 0xffff0000u); }
DI float sigmoid_fast(float x) { return __builtin_amdgcn_rcpf(1.0f + __expf(-x)); }
DI float wave_sum(float v) {
#pragma unroll
    for (int o = 1; o < 64; o <<= 1) v += __shfl_xor(v, o);
    return v;
}
DI void unpack8(const u32x4 w, float (&f)[8]) { f[0] = lo16(w.x); f[1] = hi16(w.x); f[2] = lo16(w.y); f[3] = hi16(w.y); f[4] = lo16(w.z); f[5] = hi16(w.z); f[6] = lo16(w.w); f[7] = hi16(w.w); }
DI int opaque_tid() { int t = threadIdx.x; asm volatile("" : "+v"(t)); return t; }
#define LDS_WAIT() asm volatile("s_waitcnt lgkmcnt(0)" ::: "memory")
#define VM_WAIT() asm volatile("s_waitcnt vmcnt(0)" ::: "memory")

namespace pg8 {
constexpr int BM = 256, BK = 64, HALF = 128, HTB = HALF * BK * 2, STAGE_BYTES = 8 * HTB, NXCD = 8, WGM = 8;
__host__ __device__ __forceinline__ int lds_byte(int r, int c) { const int st = (r >> 4) * 2 + (c >> 5), rr = r & 15, cc = c & 31, ob = rr * 64 + cc * 2; return st * 1024 + (ob ^ (((ob >> 9) & 1) << 5)); }
__host__ __device__ __forceinline__ void stage_rc(int b, int& R, int& C) { const int st = b / 1024, sb = b % 1024, swz = sb ^ (((sb >> 9) & 1) << 5); R = (st >> 1) * 16 + swz / 64; C = (st & 1) * 32 + (swz % 64) / 2; }

struct Unit { const char* a; const char* b; int pm, pn, nt, aux; };

struct OrderMN {
    int nM, nN, nwg, G, c; const char* A; const char* Bt; size_t astep, bstep, apn;
    DI void init(const bf16* A_, int lda, const bf16* Bt_, int ldb, int M, int N, int G_, int c_, int apn_ = 0) { nM = M / BM; nN = N / BM; nwg = nM * nN; G = G_; c = c_; A = (const char*)A_; Bt = (const char*)Bt_; astep = (size_t)BM * lda * 2; bstep = (size_t)BM * ldb * 2; apn = (size_t)apn_; }
    DI bool next(int i, Unit& u) const {
        const long L = (long)i * G + c; if (L >= nwg) return false;
        int wgid = (int)L; { const int q = nwg / NXCD, r = nwg % NXCD, xcd = wgid % NXCD, off = wgid / NXCD; wgid = (xcd < r ? xcd * (q + 1) : r * (q + 1) + (xcd - r) * q) + off; }
        const int nig = WGM * nN, gid = wgid / nig, fm = gid * WGM, gsz = (nM - fm) < WGM ? (nM - fm) : WGM;
        u.pm = fm + ((wgid % nig) % gsz); u.pn = (wgid % nig) / gsz; u.a = A + (size_t)u.pm * astep + (size_t)u.pn * apn; u.b = Bt + (size_t)u.pn * bstep; return true;
    }
};

template <class Epi, class Sched>
DI void gemm_phase(LAS unsigned char* lds, const int K, const int lda, const int ldb, const Sched& S, const Epi& E) {
    const int tid = opaque_tid(), wid = __builtin_amdgcn_readfirstlane(tid >> 6), lane = tid & 63, wr = wid >> 2, wc = wid & 3, fr = lane & 15, fq = lane >> 4;
    const int nt = K / BK;
    unsigned voffA[2], voffB[2];
#pragma unroll
    for (int i = 0; i < 2; ++i) { int R, C; stage_rc(tid * 16 + i * 8192, R, C); voffA[i] = (unsigned)(R * lda + C) * 2u; voffB[i] = (unsigned)(R * ldb + C) * 2u; }
    const size_t kstep = (size_t)(BK * 2);
    const size_t hstepA = (size_t)HALF * lda * 2, hstepB = (size_t)HALF * ldb * 2;
    const unsigned ldsw = (unsigned)wid * 1024u;
    const int aoff = lds_byte(wr * 64 + fr, fq * 8), boff = lds_byte(wc * 32 + fr, fq * 8);
#define PG8_SA(b, h) (((b) * 2 + (h)) * HTB)
#define PG8_SB(b, h) ((4 + (b) * 2 + (h)) * HTB)
#define PG8_STAGE(bufoff, gbase, voff) do { _Pragma("unroll") for (int _i = 0; _i < 2; ++_i) \
        __builtin_amdgcn_global_load_lds((const unsigned*)((const char*)(gbase) + (voff)[_i]), (LAS unsigned*)(lds + (bufoff) + ldsw + _i * 8192), 16, 0, 0); } while (0)
#define PG8_LDA(dst, b, h) do { _Pragma("unroll") for (int m = 0; m < 4; ++m) _Pragma("unroll") for (int k = 0; k < 2; ++k) dst[m][k] = *(const LAS bf16x8*)(lds + PG8_SA(b, h) + aoff + m * 2048 + k * 1024); } while (0)
#define PG8_LDB(dst, b, h) do { _Pragma("unroll") for (int n = 0; n < 2; ++n) _Pragma("unroll") for (int k = 0; k < 2; ++k) dst[n][k] = *(const LAS bf16x8*)(lds + PG8_SB(b, h) + boff + n * 2048 + k * 1024); } while (0)
#define PG8_MMA(ai, bj, At, Bt) do { __builtin_amdgcn_s_setprio(1); _Pragma("unroll") for (int m = 0; m < 4; ++m) _Pragma("unroll") for (int n = 0; n < 2; ++n) _Pragma("unroll") for (int k = 0; k < 2; ++k) \
        acc[ai][bj][m][n] = __builtin_amdgcn_mfma_f32_16x16x32_bf16(Bt[n][k], At[m][k], acc[ai][bj][m][n], 0, 0, 0); __builtin_amdgcn_s_setprio(0); } while (0)
#define PG8_WAIT_V(n) asm volatile("s_waitcnt vmcnt(" #n ")" ::: "memory")
#define PG8_WAIT_L(n) asm volatile("s_waitcnt lgkmcnt(" #n ")" ::: "memory")
#define PG8_BAR __builtin_amdgcn_s_barrier()
#define PG8_SCHED __builtin_amdgcn_sched_barrier(0)
    Unit cur, nxt; int ui = 0; cur.nt = 0; cur.aux = 0;
    if (!S.next(0, cur)) return;
    f32x4 acc[2][2][4][2];
    E.init(acc, cur, wr, wc, fr, fq);
    bf16x8 At[4][2], B0[2][2], B1[2][2];
    const char* cA = cur.a; const char* cB = cur.b;
    PG8_STAGE(PG8_SB(0, 0), cB, voffB); PG8_STAGE(PG8_SB(0, 1), cB + hstepB, voffB); PG8_STAGE(PG8_SA(0, 0), cA, voffA); PG8_STAGE(PG8_SA(0, 1), cA + hstepA, voffA);
    if (wr == 1) PG8_BAR;
    PG8_WAIT_V(2); PG8_BAR;
    PG8_STAGE(PG8_SB(1, 0), cB + kstep, voffB); PG8_STAGE(PG8_SA(1, 0), cA + kstep, voffA); PG8_STAGE(PG8_SB(1, 1), cB + hstepB + kstep, voffB);
    PG8_WAIT_V(6); PG8_BAR;
    for (;;) {
        nxt.nt = 0; nxt.aux = 0;
        const bool has_next = S.next(ui + 1, nxt);
        const int cnt = cur.nt ? cur.nt : nt;
        const char* nA = has_next ? nxt.a : cA; const char* nB = has_next ? nxt.b : cB;
#pragma unroll 1
        for (int t = 0; t < cnt; t += 2) {
            const bool last = (t == cnt - 2);
            const char* a1 = cA + (size_t)(t + 1) * kstep;
            const char* a2 = last ? nA : cA + (size_t)(t + 2) * kstep; const char* b2 = last ? nB : cB + (size_t)(t + 2) * kstep;
            const char* a3 = a2 + kstep; const char* b3 = b2 + kstep;
            PG8_LDB(B0, 0, 0); PG8_LDB(B1, 0, 1); PG8_SCHED; PG8_LDA(At, 0, 0); PG8_STAGE(PG8_SA(1, 1), a1 + hstepA, voffA);
            PG8_WAIT_V(8); PG8_WAIT_L(0); PG8_BAR; PG8_MMA(0, 0, At, B0); PG8_MMA(0, 1, At, B1); PG8_BAR; PG8_SCHED;
            PG8_LDA(At, 0, 1); PG8_STAGE(PG8_SB(0, 0), b2, voffB); PG8_STAGE(PG8_SB(0, 1), b2 + hstepB, voffB); PG8_STAGE(PG8_SA(0, 0), a2, voffA);
            PG8_WAIT_V(8); PG8_WAIT_L(0); PG8_BAR; PG8_MMA(1, 0, At, B0); PG8_MMA(1, 1, At, B1); PG8_BAR; PG8_SCHED;
            PG8_LDB(B0, 1, 0); PG8_LDB(B1, 1, 1); PG8_SCHED; PG8_LDA(At, 1, 0); PG8_STAGE(PG8_SA(0, 1), a2 + hstepA, voffA);
            PG8_WAIT_V(8); PG8_WAIT_L(0); PG8_BAR; PG8_MMA(0, 0, At, B0); PG8_MMA(0, 1, At, B1); PG8_BAR; PG8_SCHED;
            PG8_LDA(At, 1, 1); PG8_STAGE(PG8_SB(1, 0), b3, voffB); PG8_STAGE(PG8_SB(1, 1), b3 + hstepB, voffB); PG8_STAGE(PG8_SA(1, 0), a3, voffA);
            PG8_WAIT_V(8); PG8_WAIT_L(0); PG8_BAR; PG8_MMA(1, 0, At, B0); PG8_MMA(1, 1, At, B1); PG8_BAR; PG8_SCHED;
        }
        if (wr == 0) PG8_BAR;
        E(acc, cur, wr, wc, fr, fq);
        if (!has_next) break;
        if (!E.keep(cur)) E.init(acc, nxt, wr, wc, fr, fq);
        cur = nxt; cA = nA; cB = nB; ++ui;
        if (wr == 1) PG8_BAR;
    }
    PG8_WAIT_V(0);
    PG8_BAR;
#undef PG8_SA
#undef PG8_SB
#undef PG8_STAGE
#undef PG8_LDA
#undef PG8_LDB
#undef PG8_MMA
#undef PG8_WAIT_V
#undef PG8_WAIT_L
#undef PG8_BAR
#undef PG8_SCHED
}

DI void acc_zero(f32x4 (&acc)[2][2][4][2]) {
#pragma unroll
    for (int a = 0; a < 2; ++a)
#pragma unroll
        for (int b = 0; b < 2; ++b)
#pragma unroll
            for (int m = 0; m < 4; ++m)
#pragma unroll
                for (int n = 0; n < 2; ++n) acc[a][b][m][n] = (f32x4){0.f, 0.f, 0.f, 0.f};
}
template <class GE> struct EpiGran {
    GE g;
    DI bool keep(const Unit&) const { return false; }
    DI void init(f32x4 (&acc)[2][2][4][2], const Unit& u, int wr, int wc, int fr, int fq) const { g.init(acc, u, wr, wc, fr, fq); }
    DI void operator()(f32x4 (&acc)[2][2][4][2], const Unit& u, int wr, int wc, int fr, int fq) const {
        const int row0 = u.pm * BM + wr * 64 + fr, col0 = u.pn * BM + wc * 32 + 4 * fq;
#pragma unroll
        for (int ai = 0; ai < 2; ++ai)
#pragma unroll
            for (int m = 0; m < 4; ++m)
#pragma unroll
                for (int bj = 0; bj < 2; ++bj)
#pragma unroll
                    for (int n = 0; n < 2; ++n) g(row0 + ai * HALF + m * 16, col0 + bj * HALF + n * 16, acc[ai][bj][m][n]);
    }
};
}

#define XB_TMO      128
#define XB_XCNT(j)  (256  + 64 * (j))
#define XB_XSUB(j)  (1280 + 64 * (j))
#define XB_XGEN(j)  (2304 + 64 * (j))
#define XB_TOP      3328
#define XB_TOPGEN   3392
#define XCD_BAR_WORDS 3456
#define XB_SPIN_CAP (1u << 22)
DI unsigned xb_ld(unsigned* p)              { return __hip_atomic_load(p, __ATOMIC_RELAXED, __HIP_MEMORY_SCOPE_AGENT); }
DI unsigned xb_add(unsigned* p, unsigned v) { return __hip_atomic_fetch_add(p, v, __ATOMIC_RELAXED, __HIP_MEMORY_SCOPE_AGENT); }
DI unsigned xb_xcc_id() { return (unsigned)__builtin_amdgcn_s_getreg((3 << 11) | 20) & 0xFu; }
#define XB_SPIN(cond, bar) do { unsigned _sp = 0; while (cond) { __builtin_amdgcn_s_sleep(1); \
    if ((++_sp & 255u) == 0u) { if (xb_ld(&(bar)[XB_TMO])) break; if (_sp > XB_SPIN_CAP) { atomicAdd(&(bar)[XB_TMO], 1u); break; } } } } while (0)
struct XcdBarrier { unsigned* bar; unsigned x; volatile LAS unsigned* st; };
DI XcdBarrier xcd_barrier_post(unsigned* bar, volatile LAS unsigned* st) {
    XcdBarrier b; b.bar = bar; b.x = xb_xcc_id(); b.st = st;
    if (threadIdx.x == 0) (void)xb_add(&bar[XB_XCNT(b.x)], 1u);
    return b;
}
DI void xcd_barrier_complete(unsigned* bar, unsigned x, unsigned& nloc, unsigned& nx) {
    const unsigned G = gridDim.x * gridDim.y * gridDim.z;
    unsigned sum, cnt, mine, sp = 0u;
    for (;;) {
        sum = 0u; cnt = 0u; mine = 0u;
#pragma unroll
        for (unsigned j = 0; j < 16; ++j) { const unsigned c = xb_ld(&bar[XB_XCNT(j)]); sum += c; cnt += (c > 0u) ? 1u : 0u; mine = (j == x) ? c : mine; }
        if (sum == G) break;
        __builtin_amdgcn_s_sleep(1);
        if ((++sp & 255u) == 0u) { if (xb_ld(&bar[XB_TMO])) break; if (sp > XB_SPIN_CAP) { atomicAdd(&bar[XB_TMO], 1u); break; } }
    }
    nloc = mine > 0u ? mine : 1u; nx = cnt > 0u ? cnt : 1u;
}
DI void xcd_barrier(const XcdBarrier& b) {
    asm volatile("s_waitcnt vmcnt(0)" ::: "memory");
    __syncthreads();
    if (threadIdx.x == 0) {
        unsigned* bar = b.bar;
        __builtin_amdgcn_s_waitcnt(0);
        unsigned nloc = b.st[0], nx = b.st[1];
        if (nloc == 0u) { xcd_barrier_complete(bar, b.x, nloc, nx); b.st[0] = nloc; b.st[1] = nx; }
        const unsigned old = xb_add(&bar[XB_XSUB(b.x)], 1u);
        const unsigned gen = old / nloc;
        if (old + 1u == (gen + 1u) * nloc) {
            __builtin_amdgcn_fence(__ATOMIC_RELEASE, "agent");
            asm volatile("s_waitcnt vmcnt(0)" ::: "memory");
            const unsigned og = xb_add(&bar[XB_TOP], 1u);
            const unsigned tg = og / nx;
            if (og + 1u == (tg + 1u) * nx) xb_add(&bar[XB_TOPGEN], 1u);
            else XB_SPIN(xb_ld(&bar[XB_TOPGEN]) == tg, bar);
            __builtin_amdgcn_fence(__ATOMIC_ACQUIRE, "agent");
            xb_add(&bar[XB_XGEN(b.x)], 1u);
            asm volatile("s_waitcnt vmcnt(0)" ::: "memory");
        } else {
            XB_SPIN(xb_ld(&bar[XB_XGEN(b.x)]) == gen, bar);
            __builtin_amdgcn_fence(__ATOMIC_ACQUIRE, "agent");
            asm volatile("s_waitcnt vmcnt(0)" ::: "memory");
        }
    }
    __syncthreads();
}

typedef const GAS float* fptr_t;
typedef const __attribute__((address_space(4))) fptr_t* in_tab_t;
struct Frame {
    LAS unsigned char* lds;
    int vcu, G;
    in_tab_t in; float* out; unsigned char* ws;
};
#define PHASE_BEGIN(F) Frame F = F0; int bx = bx0; { unsigned long long _a = (unsigned long long)F0.in, _b = (unsigned long long)F0.out, _c = (unsigned long long)F0.ws; int _g = F0.G, _v = F0.vcu; \
    asm volatile("" : "+s"(_a), "+s"(_b), "+s"(_c), "+s"(_g), "+s"(_v), "+s"(bx)); \
    F.in = (in_tab_t)_a; F.out = (float*)(GAS float*)_b; F.ws = (unsigned char*)(GAS unsigned char*)_c; F.G = _g; F.vcu = _v; }
#define WSP(T, off) ((T*)(F.ws + (off)))

struct GeIn {
    bf16* proj; const float* bias; bf16* xqb; bool pre;
    DI void init(f32x4 (&acc)[2][2][4][2], const pg8::Unit& u, int wr, int wc, int fr, int fq) const {
#pragma unroll
        for (int bj = 0; bj < 2; ++bj)
#pragma unroll
            for (int n = 0; n < 2; ++n) { const int col = u.pn * 256 + wc * 32 + 4 * fq + bj * 128 + n * 16; const f32x4 bv = *(const f32x4*)(bias + col + (col >= 4096 ? 8 : 0));
#pragma unroll
                for (int ai = 0; ai < 2; ++ai)
#pragma unroll
                    for (int m = 0; m < 4; ++m) acc[ai][bj][m][n] = bv; }
    }
    DI void operator()(int row, int col, const f32x4& a) const {
        f32x4 v = a + (pre ? (f32x4){0.f, 0.f, 0.f, 0.f} : *(const f32x4*)(bias + col + (col >= 4096 ? 8 : 0)));
        const bool sg = (col >= C_O && col < C_U) || col >= C_G;
        if (sg) { v.x = sigmoid_fast(v.x); v.y = sigmoid_fast(v.y); v.z = sigmoid_fast(v.z); v.w = sigmoid_fast(v.w); }
        u32x2 w; w.x = pk2(v.x, v.y); w.y = pk2(v.z, v.w);
        if (col >= C_XQ && col < C_G) *(u32x2*)(xqb + (size_t)row * D + (col - C_XQ)) = w;
        else *(u32x2*)(proj + (size_t)row * NPROJ + col) = w;
    }
};
struct GeKV {
    float* out; bf16* mk; bf16* mvt;
    DI void init(f32x4 (&acc)[2][2][4][2], const pg8::Unit&, int, int, int, int) const { pg8::acc_zero(acc); }
    DI void operator()(int row, int col, const f32x4& a) const {
        const int l = col >> 11, c = col & 2047;
        if (c < 1024) {
            *(f32x4*)(out + O_PMK + ((size_t)l * 2048 + row) * 1024 + c) = a;
            u32x2 w; w.x = pk2(a.x, a.y); w.y = pk2(a.z, a.w);
            *(u32x2*)(mk + ((size_t)l * 2048 + row) * 1024 + c) = w;
        } else {
            const int cc = c - 1024;
            *(f32x4*)(out + O_PMV + ((size_t)l * 2048 + row) * 1024 + cc) = a;
            bf16* t = mvt + ((size_t)l * 1024 + cc) * 2048 + row;
            t[0] = (bf16)f2bf(a.x); t[2048] = (bf16)f2bf(a.y); t[4096] = (bf16)f2bf(a.z); t[6144] = (bf16)f2bf(a.w);
        }
    }
};
struct GeBf16 {
    bf16* o; int ldc;
    DI void init(f32x4 (&acc)[2][2][4][2], const pg8::Unit&, int, int, int, int) const { pg8::acc_zero(acc); }
    DI void operator()(int row, int col, const f32x4& a) const { u32x2 w; w.x = pk2(a.x, a.y); w.y = pk2(a.z, a.w); *(u32x2*)(o + (size_t)row * ldc + col) = w; }
};
template <int MODE> struct GeMix {
    float* mix; bf16* mixb; const bf16* proj; const float* ps;
    DI void init(f32x4 (&acc)[2][2][4][2], const pg8::Unit&, int, int, int, int) const { pg8::acc_zero(acc); }
    DI void operator()(int row, int col, const f32x4& a) const {
        const u32x2 gw = *(const u32x2*)(proj + (size_t)row * NPROJ + C_G + MODE * 1024 + col);
        const f32x4 g = (f32x4){lo16(gw.x), hi16(gw.x), lo16(gw.y), hi16(gw.y)};
        float* mp = mix + (size_t)row * D + col;
        if (MODE == 0) { *(f32x4*)mp = g * a; }
        else if (MODE == 1) { const f32x4 s = *(const f32x4*)(ps + col); *(f32x4*)mp = *(const f32x4*)mp + g * s * a; }
        else { const f32x4 v = *(const f32x4*)mp + g * a; u32x2 w; w.x = pk2(v.x, v.y); w.y = pk2(v.z, v.w); *(u32x2*)(mixb + (size_t)row * D + col) = w; }
    }
};
struct GeRes {
    const float* x; float* t; bool pre;
    DI void init(f32x4 (&acc)[2][2][4][2], const pg8::Unit& u, int wr, int wc, int fr, int fq) const {
        const int row0 = u.pm * 256 + wr * 64 + fr, col0 = u.pn * 256 + wc * 32 + 4 * fq;
#pragma unroll
        for (int ai = 0; ai < 2; ++ai)
#pragma unroll
            for (int m = 0; m < 4; ++m)
#pragma unroll
                for (int bj = 0; bj < 2; ++bj)
#pragma unroll
                    for (int n = 0; n < 2; ++n) acc[ai][bj][m][n] = *(const f32x4*)(x + (size_t)(row0 + ai * 128 + m * 16) * D + col0 + bj * 128 + n * 16) * ALPHA;
    }
    DI void operator()(int row, int col, const f32x4& a) const { const size_t o = (size_t)row * D + col; *(f32x4*)(t + o) = pre ? a : *(const f32x4*)(x + o) * ALPHA + a; }
};

struct EpiSoftmax {
    bf16* P; LAS float* X;
    DI bool keep(const pg8::Unit&) const { return false; }
    DI void init(f32x4 (&acc)[2][2][4][2], const pg8::Unit&, int, int, int, int) const { pg8::acc_zero(acc); }
    DI void operator()(f32x4 (&acc)[2][2][4][2], const pg8::Unit& u, int wr, int wc, int fr, int fq) const {
        const float sc = 0.0625f * 1.4426950408889634f;
        LAS float* XM = X; LAS float* XS = X + 1024;
#pragma unroll
        for (int ai = 0; ai < 2; ++ai)
#pragma unroll
            for (int m = 0; m < 4; ++m) {
                float v = -3.0e38f;
#pragma unroll
                for (int bj = 0; bj < 2; ++bj)
#pragma unroll
                    for (int n = 0; n < 2; ++n) { const f32x4 x = acc[ai][bj][m][n]; v = fmaxf(v, fmaxf(fmaxf(x.x, x.y), fmaxf(x.z, x.w))); }
                v = fmaxf(v, __shfl_xor(v, 16)); v = fmaxf(v, __shfl_xor(v, 32));
                if (fq == 0) XM[(ai * 128 + wr * 64 + m * 16 + fr) * 4 + wc] = v;
            }
        LDS_WAIT(); __builtin_amdgcn_s_barrier(); asm volatile("" ::: "memory");
#pragma unroll
        for (int ai = 0; ai < 2; ++ai)
#pragma unroll
            for (int m = 0; m < 4; ++m) {
                const int r = ai * 128 + wr * 64 + m * 16 + fr;
                const f32x4 mm = *(const LAS f32x4*)(XM + r * 4);
                const float mx = fmaxf(fmaxf(mm.x, mm.y), fmaxf(mm.z, mm.w)) * sc;
                float s = 0.f;
#pragma unroll
                for (int bj = 0; bj < 2; ++bj)
#pragma unroll
                    for (int n = 0; n < 2; ++n) { f32x4 x = acc[ai][bj][m][n];
                        x.x = __builtin_amdgcn_exp2f(x.x * sc - mx); x.y = __builtin_amdgcn_exp2f(x.y * sc - mx); x.z = __builtin_amdgcn_exp2f(x.z * sc - mx); x.w = __builtin_amdgcn_exp2f(x.w * sc - mx);
                        acc[ai][bj][m][n] = x; s += (x.x + x.y) + (x.z + x.w); }
                s += __shfl_xor(s, 16); s += __shfl_xor(s, 32);
                if (fq == 0) XS[r * 4 + wc] = s;
                asm volatile("" ::: "memory");
            }
        LDS_WAIT(); __builtin_amdgcn_s_barrier(); asm volatile("" ::: "memory");
#pragma unroll
        for (int ai = 0; ai < 2; ++ai)
#pragma unroll
            for (int m = 0; m < 4; ++m) {
                const int r = ai * 128 + wr * 64 + m * 16 + fr;
                const f32x4 ss = *(const LAS f32x4*)(XS + r * 4);
                const float inv = 1.0f / ((ss.x + ss.y) + (ss.z + ss.w));
                bf16* rowp = P + (size_t)(u.pm * 256 + r) * D + u.pn * 256 + wc * 32 + 4 * fq;
#pragma unroll
                for (int bj = 0; bj < 2; ++bj)
#pragma unroll
                    for (int n = 0; n < 2; ++n) { const f32x4 x = acc[ai][bj][m][n] * inv; u32x2 w; w.x = pk2(x.x, x.y); w.y = pk2(x.z, x.w); *(u32x2*)(rowp + bj * 128 + n * 16) = w; }
                asm volatile("" ::: "memory");
            }
        LDS_WAIT(); __builtin_amdgcn_s_barrier(); asm volatile("" ::: "memory");
    }
};

#define ROR_F(x, n) __builtin_bit_cast(float, __builtin_amdgcn_update_dpp(0, __builtin_bit_cast(int, (float)(x)), 0x120 + (n), 0xf, 0xf, false))
DI float gelu_tanh(float x) { return x * sigmoid_fast(1.5957691216057308f * (x + 0.044715f * x * x * x)); }
struct EpiConv {
    DI bool keep(const pg8::Unit&) const { return false; }
    DI void init(f32x4 (&acc)[2][2][4][2], const pg8::Unit&, int, int, int, int) const { pg8::acc_zero(acc); }
    bf16* act; float* halo; float* out; const float* cw; const float* cb; LAS float* X; int l;
    DI void operator()(f32x4 (&acc)[2][2][4][2], const pg8::Unit& u, int wr, int wc, int fr, int fq) const {
        if (fr >= 14) {
#pragma unroll
            for (int ai = 0; ai < 2; ++ai)
#pragma unroll
                for (int bj = 0; bj < 2; ++bj)
#pragma unroll
                    for (int n = 0; n < 2; ++n) *(LAS f32x4*)(X + (((ai * 2 + wr) * 2 + (fr - 14)) * 256 + bj * 128 + wc * 32 + n * 16 + fq * 4)) = acc[ai][bj][3][n];
        }
        LDS_WAIT(); __builtin_amdgcn_s_barrier(); asm volatile("" ::: "memory");
        if (wr == 0 && fr < 2) {
#pragma unroll
            for (int h = 0; h < 2; ++h)
#pragma unroll
                for (int n = 0; n < 2; ++n) *(f32x4*)(halo + ((size_t)u.pm * 4 + fr) * FF2 + h * FF + u.pn * 128 + wc * 32 + n * 16 + fq * 4) = acc[0][h][0][n];
        }
        if (wr == 1 && fr >= 14) {
#pragma unroll
            for (int h = 0; h < 2; ++h)
#pragma unroll
                for (int n = 0; n < 2; ++n) { const int ca = u.pn * 128 + wc * 32 + n * 16 + fq * 4;
                    *(f32x4*)(halo + ((size_t)u.pm * 4 + 2 + (fr - 14)) * FF2 + h * FF + ca) = acc[1][h][3][n];
                    if ((u.pm & 7) == 7) *(f32x4*)(out + O_PCONV + ((size_t)(l * NB + (u.pm >> 3)) * 2 + (fr - 14)) * FF2 + h * FF + ca) = acc[1][h][3][n]; }
        }
        const bool p1own = fr >= 1, p2own = fr >= 2;
#pragma unroll
        for (int n = 0; n < 2; ++n) {
            asm volatile("" ::: "memory");
            const int ca = u.pn * 128 + wc * 32 + n * 16 + fq * 4;
            f32x4 w[2][3], bsv[2];
#pragma unroll
            for (int h = 0; h < 2; ++h) {
#pragma unroll
                for (int i = 0; i < 3; ++i) w[h][i] = *(const f32x4*)(cw + (size_t)i * FF2 + h * FF + ca);
                bsv[h] = *(const f32x4*)(cb + h * FF + ca); }
            bf16* ap = act + (size_t)(u.pm * 256 + wr * 64 + fr) * FF + ca;
#pragma unroll
            for (int ai = 0; ai < 2; ++ai)
#pragma unroll
                for (int m = 3; m >= 0; --m) {
                    f32x4 c[2];
#pragma unroll
                    for (int h = 0; h < 2; ++h) {
                        const f32x4 cur = acc[ai][h][m][n];
                        f32x4 g;
                        if (m > 0) g = acc[ai][h][m - 1][n];
                        else { g = (f32x4){0.f, 0.f, 0.f, 0.f};
                            if (fr >= 14 && (wr == 1 || ai == 1)) { const int sa = (wr == 1) ? ai : 0, sw = (wr == 1) ? 0 : 1; g = *(const LAS f32x4*)(X + (((sa * 2 + sw) * 2 + (fr - 14)) * 256 + h * 128 + wc * 32 + n * 16 + fq * 4)); } }
                        f32x4 p1, p2;
#pragma unroll
                        for (int j = 0; j < 4; ++j) { const float a1 = ROR_F(cur[j], 1), b1 = ROR_F(g[j], 1), a2 = ROR_F(cur[j], 2), b2 = ROR_F(g[j], 2); p1[j] = p1own ? a1 : b1; p2[j] = p2own ? a2 : b2; }
                        c[h] = p2 * w[h][0] + p1 * w[h][1] + cur * w[h][2] + bsv[h];
                    }
                    const f32x4 o = (f32x4){gelu_tanh(c[0].x) * c[1].x, gelu_tanh(c[0].y) * c[1].y, gelu_tanh(c[0].z) * c[1].z, gelu_tanh(c[0].w) * c[1].w};
                    u32x2 wv; wv.x = pk2(o.x, o.y); wv.y = pk2(o.z, o.w);
                    *(u32x2*)(ap + (size_t)(ai * 128 + m * 16) * FF) = wv;
                }
        }
        LDS_WAIT(); __builtin_amdgcn_s_barrier(); asm volatile("" ::: "memory");
    }
};
DI void conv_fixup(Frame& F, int l, int pm) {
    const float* halo = WSP(float, WS_HALO); bf16* act = WSP(bf16, WS_ACT);
    const float* cw = ((const float*)F.in[24]) + (size_t)l * 3 * FF2; const float* cb = ((const float*)F.in[25]) + (size_t)l * FF2;
    const bool first = (pm & 7) == 0;
    for (int it = opaque_tid(); it < FF / 4; it += 512) {
        const int ca = it * 4; f32x4 c0[2], c1[2];
#pragma unroll
        for (int h = 0; h < 2; ++h) {
            const size_t co = (size_t)h * FF + ca;
            const f32x4 r0 = *(const f32x4*)(halo + ((size_t)pm * 4 + 0) * FF2 + co), r1 = *(const f32x4*)(halo + ((size_t)pm * 4 + 1) * FF2 + co);
            f32x4 q2 = (f32x4){0.f, 0.f, 0.f, 0.f}, q1 = q2;
            if (!first) { q2 = *(const f32x4*)(halo + ((size_t)(pm - 1) * 4 + 2) * FF2 + co); q1 = *(const f32x4*)(halo + ((size_t)(pm - 1) * 4 + 3) * FF2 + co); }
            const f32x4 w0 = *(const f32x4*)(cw + co), w1 = *(const f32x4*)(cw + FF2 + co), w2 = *(const f32x4*)(cw + 2 * FF2 + co), bv = *(const f32x4*)(cb + co);
            c0[h] = q2 * w0 + q1 * w1 + r0 * w2 + bv; c1[h] = q1 * w0 + r0 * w1 + r1 * w2 + bv; }
        u32x2 wv; wv.x = pk2(gelu_tanh(c0[0].x) * c0[1].x, gelu_tanh(c0[0].y) * c0[1].y); wv.y = pk2(gelu_tanh(c0[0].z) * c0[1].z, gelu_tanh(c0[0].w) * c0[1].w);
        *(u32x2*)(act + (size_t)(pm * 256) * FF + ca) = wv;
        wv.x = pk2(gelu_tanh(c1[0].x) * c1[1].x, gelu_tanh(c1[0].y) * c1[1].y); wv.y = pk2(gelu_tanh(c1[0].z) * c1[1].z, gelu_tanh(c1[0].w) * c1[1].w);
        *(u32x2*)(act + (size_t)(pm * 256 + 1) * FF + ca) = wv;
    }
}
DI void skinny_up_conv(Frame& F, int l, const bf16* W, int j0, int jstride) {
    const int tid = opaque_tid(), lane = tid & 63, wid = __builtin_amdgcn_readfirstlane(tid >> 6), fr = lane & 15, fq = lane >> 4, b = wid * 16 + fr;
    const bf16* ap = WSP(bf16, WS_XN) + (size_t)(MP + b) * D + fq * 8;
    const float* cw = ((const float*)F.in[24]) + (size_t)l * 3 * FF2; const float* cb = ((const float*)F.in[25]) + (size_t)l * FF2;
    const float* sc = ((const float*)F.in[9]) + ((size_t)(l * MS + b) * 2) * FF2; float* so = F.out + O_SCONV + ((size_t)(l * MS + b) * 2) * FF2;
    for (int job = j0; job < FF / 16; job += jstride) {
        const int uu = job >> 3, cc = (job & 7) * 16;
        const bf16* b0 = W + (size_t)(uu * 256 + cc + fr) * D + fq * 8; const bf16* b1 = b0 + (size_t)128 * D;
        f32x4 acc[2] = {(f32x4){0.f, 0.f, 0.f, 0.f}, (f32x4){0.f, 0.f, 0.f, 0.f}};
#pragma unroll 8
        for (int k0 = 0; k0 < D; k0 += 32) { const bf16x8 a = *(const bf16x8*)(ap + k0), x0 = *(const bf16x8*)(b0 + k0), x1 = *(const bf16x8*)(b1 + k0);
            acc[0] = __builtin_amdgcn_mfma_f32_16x16x32_bf16(x0, a, acc[0], 0, 0, 0); acc[1] = __builtin_amdgcn_mfma_f32_16x16x32_bf16(x1, a, acc[1], 0, 0, 0); }
        const int ca = job * 16 + fq * 4; f32x4 c[2];
#pragma unroll
        for (int h = 0; h < 2; ++h) { const size_t co = (size_t)h * FF + ca;
            const f32x4 s0 = *(const f32x4*)(sc + co), s1 = *(const f32x4*)(sc + FF2 + co);
            c[h] = s0 * *(const f32x4*)(cw + co) + s1 * *(const f32x4*)(cw + FF2 + co) + acc[h] * *(const f32x4*)(cw + 2 * FF2 + co) + *(const f32x4*)(cb + co);
            *(f32x4*)(so + co) = s1; *(f32x4*)(so + FF2 + co) = acc[h]; }
        u32x2 wv; wv.x = pk2(gelu_tanh(c[0].x) * c[1].x, gelu_tanh(c[0].y) * c[1].y); wv.y = pk2(gelu_tanh(c[0].z) * c[1].z, gelu_tanh(c[0].w) * c[1].w);
        *(u32x2*)(WSP(bf16, WS_ACT) + (size_t)(MP + b) * FF + ca) = wv;
    }
}

struct OrderD {
    pg8::OrderMN inner; const char* A0; const char* A1; const char* A2; const char* B0; const char* B1; const char* B2;
    DI bool next(int i, pg8::Unit& u) const {
        const int ti = i / 3, mode = i - 3 * ti;
        if (!inner.next(ti, u)) return false;
        const size_t ar = (size_t)u.pm * 256 * D * 2, br = (size_t)u.pn * 256 * D * 2;
        if (mode == 0) { u.a = A0 + ar; u.b = B0 + br; u.nt = 16; }
        else if (mode == 1) { u.a = A1 + ar + (size_t)u.pn * 512; u.b = B1 + br + (size_t)u.pn * 512; u.nt = 4; }
        else { u.a = A2 + ar; u.b = B2 + br; u.nt = 16; }
        u.aux = mode; return true;
    }
};
DI f32x4 nz4(f32x4 v) { const float t = 1e-12f; return (f32x4){fabsf(v.x) < t ? t : v.x, fabsf(v.y) < t ? t : v.y, fabsf(v.z) < t ? t : v.z, fabsf(v.w) < t ? t : v.w}; }
struct EpiMixChain {
    bf16* mixb; const bf16* proj; const float* ps;
    DI bool keep(const pg8::Unit& u) const { return u.aux < 2; }
    DI void init(f32x4 (&acc)[2][2][4][2], const pg8::Unit&, int, int, int, int) const { pg8::acc_zero(acc); }
    DI void operator()(f32x4 (&acc)[2][2][4][2], const pg8::Unit& u, int wr, int wc, int fr, int fq) const {
        const int row0 = u.pm * 256 + wr * 64 + fr, col0 = u.pn * 256 + wc * 32 + 4 * fq, mode = u.aux;
#pragma unroll
        for (int bj = 0; bj < 2; ++bj)
#pragma unroll
            for (int n = 0; n < 2; ++n) {
                const int col = col0 + bj * 128 + n * 16; const f32x4 sv = *(const f32x4*)(ps + col);
#pragma unroll
                for (int ai = 0; ai < 2; ++ai)
#pragma unroll
                    for (int m = 0; m < 4; ++m) {
                        const int row = row0 + ai * 128 + m * 16; const bf16* gp = proj + (size_t)row * NPROJ + C_G + col;
                        if (mode == 0) { const u32x2 a = *(const u32x2*)gp, b = *(const u32x2*)(gp + 1024);
                            const f32x4 g0 = (f32x4){lo16(a.x), hi16(a.x), lo16(a.y), hi16(a.y)}, g1 = nz4((f32x4){lo16(b.x), hi16(b.x), lo16(b.y), hi16(b.y)} * sv);
                            acc[ai][bj][m][n] *= (f32x4){g0.x * __builtin_amdgcn_rcpf(g1.x), g0.y * __builtin_amdgcn_rcpf(g1.y), g0.z * __builtin_amdgcn_rcpf(g1.z), g0.w * __builtin_amdgcn_rcpf(g1.w)}; }
                        else if (mode == 1) { const u32x2 a = *(const u32x2*)(gp + 1024), b = *(const u32x2*)(gp + 2048);
                            const f32x4 g1 = nz4((f32x4){lo16(a.x), hi16(a.x), lo16(a.y), hi16(a.y)} * sv), g2 = nz4((f32x4){lo16(b.x), hi16(b.x), lo16(b.y), hi16(b.y)});
                            acc[ai][bj][m][n] *= (f32x4){g1.x * __builtin_amdgcn_rcpf(g2.x), g1.y * __builtin_amdgcn_rcpf(g2.y), g1.z * __builtin_amdgcn_rcpf(g2.z), g1.w * __builtin_amdgcn_rcpf(g2.w)}; }
                        else { const u32x2 b = *(const u32x2*)(gp + 2048); const f32x4 g2 = nz4((f32x4){lo16(b.x), hi16(b.x), lo16(b.y), hi16(b.y)});
                            const f32x4 v = acc[ai][bj][m][n] * g2; u32x2 w; w.x = pk2(v.x, v.y); w.y = pk2(v.z, v.w); *(u32x2*)(mixb + (size_t)row * D + col) = w; }
                    }
            }
    }
};
template <size_t AROW, size_t AH, size_t BB, size_t BH>
struct OrderAttn {
    int G, c; const char* A; const char* Bt;
    DI bool next(int i, pg8::Unit& u) const {
        const long L = (long)i * G + c; if (L >= 256) return false;
        const int b = (int)L >> 5, h = ((int)L >> 3) & 3, rb = (int)L & 7;
        u.pm = b * 8 + rb; u.pn = h;
        u.a = A + (size_t)u.pm * 256 * AROW + (size_t)h * AH;
        u.b = Bt + (size_t)b * BB + (size_t)h * BH; return true;
    }
};

template <class GE>
DI void skinny_job(Frame& F, const bf16* A, int lda, const bf16* Bt, int ldb, int K, const GE& ge, int col_out) {
    const int tid = opaque_tid(), lane = tid & 63, wid = __builtin_amdgcn_readfirstlane(tid >> 6), fr = lane & 15, fq = lane >> 4, row = wid * 16 + fr;
    const bf16* ap = A + (size_t)row * lda + fq * 8;
    const bf16* b0 = Bt + (size_t)fr * ldb + fq * 8; const bf16* b1 = b0 + (size_t)16 * ldb;
    f32x4 acc0 = (f32x4){0.f, 0.f, 0.f, 0.f}, acc1 = acc0;
#pragma unroll 8
    for (int k0 = 0; k0 < K; k0 += 32) {
        const bf16x8 a = *(const bf16x8*)(ap + k0), x0 = *(const bf16x8*)(b0 + k0), x1 = *(const bf16x8*)(b1 + k0);
        acc0 = __builtin_amdgcn_mfma_f32_16x16x32_bf16(x0, a, acc0, 0, 0, 0);
        acc1 = __builtin_amdgcn_mfma_f32_16x16x32_bf16(x1, a, acc1, 0, 0, 0);
    }
    ge(MP + row, col_out + fq * 4, acc0); ge(MP + row, col_out + 16 + fq * 4, acc1);
}
template <class GE>
DI void skinny_gemm(Frame& F, const bf16* A, int lda, const bf16* Bt, int ldb, int N, int K, const GE& ge) {
    for (int job = F.vcu; job < N / 32; job += F.G) skinny_job(F, A, lda, Bt + (size_t)job * 32 * ldb, ldb, K, ge, job * 32);
}

template <class GE>
DI void skinny_job_sk(Frame& F, const bf16* A, int lda, const bf16* Bt, int ldb, int K, const GE& ge, int rt, int col_out) {
    const int tid = opaque_tid(), lane = tid & 63, wid = __builtin_amdgcn_readfirstlane(tid >> 6), fr = lane & 15, fq = lane >> 4;
    const int kw = K >> 3;
    const bf16* ap = A + (size_t)(rt * 16 + fr) * lda + wid * kw + fq * 8;
    const bf16* b0 = Bt + (size_t)fr * ldb + wid * kw + fq * 8; const bf16* b1 = b0 + (size_t)16 * ldb;
    f32x4 acc0 = (f32x4){0.f, 0.f, 0.f, 0.f}, acc1 = acc0;
#pragma unroll 4
    for (int k0 = 0; k0 < kw; k0 += 32) {
        const bf16x8 a = *(const bf16x8*)(ap + k0), x0 = *(const bf16x8*)(b0 + k0), x1 = *(const bf16x8*)(b1 + k0);
        acc0 = __builtin_amdgcn_mfma_f32_16x16x32_bf16(x0, a, acc0, 0, 0, 0);
        acc1 = __builtin_amdgcn_mfma_f32_16x16x32_bf16(x1, a, acc1, 0, 0, 0);
    }
    LAS f32x4* part = (LAS f32x4*)F.lds;
    part[(wid * 2 + 0) * 64 + lane] = acc0; part[(wid * 2 + 1) * 64 + lane] = acc1;
    __syncthreads();
    if (tid < 128) { const int tile = tid >> 6, ln = tid & 63; f32x4 sum = part[tile * 64 + ln];
#pragma unroll
        for (int w = 1; w < 8; ++w) sum += part[(w * 2 + tile) * 64 + ln];
        ge(MP + rt * 16 + (ln & 15), col_out + tile * 16 + (ln >> 4) * 4, sum); }
    __syncthreads();
}
template <class GE>
DI void skinny_gemm_sk(Frame& F, const bf16* A, int lda, const bf16* Bt, int ldb, int K, const GE& ge) {
    for (int job = F.vcu; job < 256; job += F.G) { const int rt = job >> 5, cp = job & 31; skinny_job_sk(F, A, lda, Bt + (size_t)cp * 32 * ldb, ldb, K, ge, rt, cp * 32); }
}

DI void transpose_item(const float* W, int ldw, int K, bf16* WT, int k0, int n0src, int n0dst, LAS float* scr, int lane) {
#pragma unroll 16
    for (int k = 0; k < 64; ++k) scr[k * 65 + lane] = W[(size_t)(k0 + k) * ldw + n0src + lane];
    LDS_WAIT(); asm volatile("" ::: "memory");
    const int c = lane & 7;
#pragma unroll
    for (int j = 0; j < 8; ++j) { const int n = (lane >> 3) + 8 * j; const LAS float* sp = scr + (8 * c) * 65 + n;
        u32x4 o; o.x = pk2(sp[0 * 65], sp[1 * 65]); o.y = pk2(sp[2 * 65], sp[3 * 65]); o.z = pk2(sp[4 * 65], sp[5 * 65]); o.w = pk2(sp[6 * 65], sp[7 * 65]);
        *(u32x4*)(WT + (size_t)(n0dst + n) * K + k0 + 8 * c) = o; }
    LDS_WAIT(); asm volatile("" ::: "memory");
}
DI void mat_item(const float* W, int ldw, int K, int N, bf16* WT, int item, LAS float* scr, int lane, int shift_at) {
    const int nblk = N / 64, kb = item / nblk, nb = item % nblk, n0 = 64 * nb;
    transpose_item(W, ldw, K, WT, 64 * kb, n0 + (n0 >= shift_at ? 8 : 0), n0, scr, lane);
}
DI void phase_convert(Frame& F) {
    const int tid = opaque_tid(), lane = tid & 63, wid = __builtin_amdgcn_readfirstlane(tid >> 6);
    LAS float* scr = (LAS float*)(F.lds + wid * 16640);
    const int gw = F.vcu * 8 + wid, NGW = F.G * 8;
    constexpr int I_IN = 16 * 144, I_SQ = 16 * 16, I_KV = 16 * 32, I_UP = 16 * 88, I_DN = 44 * 16, I_P = 4 * 4;
    constexpr int PER_L = I_IN + 3 * I_SQ + I_KV + I_UP + I_DN + 4 * I_P;
    for (int it = gw; it < DEPTH * PER_L; it += NGW) {
        const int l = it / PER_L; int r = it % PER_L;
        if (r < I_IN) { mat_item(((const float*)F.in[12]) + (size_t)l * D * INW, INW, D, NPROJ, WSP(bf16, WS_WIN + l * SZ_WIN), r, scr, lane, 4096); continue; } r -= I_IN;
        if (r < I_SQ) { mat_item(((const float*)F.in[15]) + (size_t)l * D * D, D, D, D, WSP(bf16, WS_WM + l * SZ_W1K), r, scr, lane, 1 << 30); continue; } r -= I_SQ;
        if (r < I_SQ) { mat_item(((const float*)F.in[19]) + (size_t)l * D * D, D, D, D, WSP(bf16, WS_WX + l * SZ_W1K), r, scr, lane, 1 << 30); continue; } r -= I_SQ;
        if (r < I_SQ) { mat_item(((const float*)F.in[20]) + (size_t)l * D * D, D, D, D, WSP(bf16, WS_WO + l * SZ_W1K), r, scr, lane, 1 << 30); continue; } r -= I_SQ;
        if (r < I_KV) { mat_item(((const float*)F.in[18]) + (size_t)l * D * 2048, 2048, D, 2048, WSP(bf16, WS_WKV + l * SZ_WKV), r, scr, lane, 1 << 30); continue; } r -= I_KV;
        if (r < I_UP) { const int kb = r / 88, nb = r % 88, u = nb >> 2, q = nb & 3;
            transpose_item(((const float*)F.in[23]) + (size_t)l * D * FF2, FF2, D, WSP(bf16, WS_WUP + l * SZ_WUP), 64 * kb, (q >> 1) * FF + 128 * u + (q & 1) * 64, 64 * nb, scr, lane); continue; } r -= I_UP;
        if (r < I_DN) { mat_item(((const float*)F.in[26]) + (size_t)l * FF * D, D, FF, D, WSP(bf16, WS_WDN + l * SZ_WDN), r, scr, lane, 1 << 30); continue; } r -= I_DN;
        { const int g = r / I_P, ri = r % I_P, kb = ri / 4, nb = ri % 4;
          transpose_item(((const float*)F.in[16]) + ((size_t)l * 4 + g) * 65536, 256, D, WSP(bf16, WS_WP + l * SZ_WP) + g * 256, 64 * kb, 64 * nb, g * 256 + 64 * nb, scr, lane); }
    }
    { const float* mem = ((const float*)F.in[1]); bf16* mb = WSP(bf16, WS_MEMB);
      for (size_t i = ((size_t)F.vcu * 512 + tid) * 8; i < (size_t)2048 * D; i += (size_t)F.G * 512 * 8) {
          const f32x4 a = *(const f32x4*)(mem + i), b = *(const f32x4*)(mem + i + 4);
          u32x4 o; o.x = pk2(a.x, a.y); o.y = pk2(a.z, a.w); o.z = pk2(b.x, b.y); o.w = pk2(b.z, b.w); *(u32x4*)(mb + i) = o; } }
}

DI void stage_gate_w(Frame& F, int l) {
    LAS float* wg = (LAS float*)F.lds;
    const float* w = ((const float*)F.in[12]) + (size_t)l * D * INW + 4096;
    for (int i = opaque_tid(); i < 8192; i += 512) { const int k = i >> 3, j = i & 7; wg[j * 1024 + k] = w[(size_t)k * INW + j]; }
    __syncthreads();
}
DI void ln_row(Frame& F, const int lane, const float* src, const float* gam, const float* bet, int row, int lg, float* fin) {
    const f32x4* xr = (const f32x4*)src + lane;
    f32x4 v[4]; float s = 0.f;
#pragma unroll
    for (int j = 0; j < 4; ++j) { v[j] = xr[64 * j]; s += (v[j].x + v[j].y) + (v[j].z + v[j].w); }
    const float mean = wave_sum(s) * (1.f / D); float s2 = 0.f;
#pragma unroll
    for (int j = 0; j < 4; ++j) { v[j] = v[j] - mean; s2 += (v[j].x * v[j].x + v[j].y * v[j].y) + (v[j].z * v[j].z + v[j].w * v[j].w); }
    const float rstd = 1.f / sqrtf(wave_sum(s2) * (1.f / D) + LN_EPS);
    f32x4* xo = (f32x4*)(WSP(float, WS_X) + (size_t)row * D) + lane;
    u32x2* no = (u32x2*)(WSP(bf16, WS_XN) + (size_t)row * D) + lane;
#pragma unroll
    for (int j = 0; j < 4; ++j) {
        const f32x4 g = ((const f32x4*)gam)[lane + 64 * j], b = ((const f32x4*)bet)[lane + 64 * j];
        v[j] = v[j] * rstd * g + b;
        xo[64 * j] = v[j];
        u32x2 w; w.x = pk2(v[j].x, v[j].y); w.y = pk2(v[j].z, v[j].w); no[64 * j] = w;
        if (fin) ((f32x4*)fin)[lane + 64 * j] = v[j];
    }
    if (lg >= 0) {
        const LAS float* wg = (const LAS float*)F.lds;
        float a[8];
#pragma unroll
        for (int q = 0; q < 8; ++q) { float t = 0.f;
#pragma unroll
            for (int j = 0; j < 4; ++j) { const f32x4 w = *(const LAS f32x4*)(wg + q * 1024 + 4 * lane + 256 * j); t += (v[j].x * w.x + v[j].y * w.y) + (v[j].z * w.z + v[j].w * w.w); }
            a[q] = wave_sum(t); }
        if (lane == 0) { const float* bb = ((const float*)F.in[13]) + (size_t)lg * INW + 4096; float* o = WSP(float, WS_IGFG) + (size_t)row * 8;
#pragma unroll
            for (int q = 0; q < 8; ++q) o[q] = a[q] + bb[q]; }
    }
}
DI void phase_ln_in(Frame& F) {
    stage_gate_w(F, 0);
    const int tid = opaque_tid(), lane = tid & 63, wid = __builtin_amdgcn_readfirstlane(tid >> 6);
    const int gw = F.vcu * 8 + wid, NGW = F.G * 8;
    for (int r = gw; r < MT; r += NGW) {
        const float* src = r < MP ? ((const float*)F.in[0]) + (size_t)r * D : ((const float*)F.in[2]) + (size_t)(r - MP) * D;
        ln_row(F, lane, src, ((const float*)F.in[10]), ((const float*)F.in[11]), r, 0, nullptr);
    }
    __syncthreads();
}
DI void phase_ln(Frame& F, int l, int which) {
    const int lg = (which == 1 && l + 1 < DEPTH) ? l + 1 : -1;
    if (lg >= 0) stage_gate_w(F, lg);
    const float* gam = (const float*)(which ? F.in[27] : F.in[21]) + (size_t)l * D; const float* bet = (const float*)(which ? F.in[28] : F.in[22]) + (size_t)l * D;
    const bool last = (which == 1 && l == DEPTH - 1);
    const int tid = opaque_tid(), lane = tid & 63, wid = __builtin_amdgcn_readfirstlane(tid >> 6);
    const int gw = F.vcu * 8 + wid, NGW = F.G * 8;
    for (int r = gw; r < MT; r += NGW) {
        float* fin = last ? (r < MP ? F.out + O_YP + (size_t)r * D : F.out + O_YS + (size_t)(r - MP) * D) : nullptr;
        ln_row(F, lane, WSP(float, WS_T) + (size_t)r * D, gam, bet, r, lg, fin);
    }
    __syncthreads();
}

constexpr int MP_Q = 0, MP_K = 33792, MP_T2 = 67584, MP_VEC = 104448, MP_END = 104448 + 4 * 6 * 64 * 4;
static_assert(MP_END <= XCH_OFF, "mLSTM prep LDS map");
DI float log_sigmoid(float x) { return fminf(x, 0.f) - log1pf(expf(-fabsf(x))); }
#define DPP_F(oldv, src, ctrl, rmask, bc) __builtin_bit_cast(float, __builtin_amdgcn_update_dpp(__builtin_bit_cast(int, (float)(oldv)), __builtin_bit_cast(int, (float)(src)), ctrl, rmask, 0xf, bc))
DI float wave_scan_add(float v) {
    v += DPP_F(0.f, v, 0x111, 0xf, true); v += DPP_F(0.f, v, 0x112, 0xf, true); v += DPP_F(0.f, v, 0x114, 0xf, true); v += DPP_F(0.f, v, 0x118, 0xf, true);
    v += DPP_F(0.f, v, 0x142, 0xa, true); v += DPP_F(0.f, v, 0x143, 0xc, true); return v; }
DI float wave_scan_max(float v) {
    v = fmaxf(v, DPP_F(v, v, 0x111, 0xf, false)); v = fmaxf(v, DPP_F(v, v, 0x112, 0xf, false)); v = fmaxf(v, DPP_F(v, v, 0x114, 0xf, false)); v = fmaxf(v, DPP_F(v, v, 0x118, 0xf, false));
    v = fmaxf(v, DPP_F(v, v, 0x142, 0xa, false)); v = fmaxf(v, DPP_F(v, v, 0x143, 0xc, false)); return v; }
DI void mlstm_prep_job(Frame& F, int l, int job) {
    const int b = job >> 5, hh = (job >> 3) & 3, c4 = job & 7;
    const int tid = opaque_tid(), lane = tid & 63, wid = __builtin_amdgcn_readfirstlane(tid >> 6), fr = lane & 15, fq = lane >> 4;
    LAS unsigned char* L = F.lds;
    LAS float* vecs = (LAS float*)(L + MP_VEC);
    const bf16* projb = WSP(bf16, WS_PROJ) + (size_t)b * SEQ * NPROJ;
    const size_t bh = (size_t)(b * NH + hh);
    bf16* PTg = WSP(bf16, WS_PT) + bh * 32 * 4096; bf16* KWg = WSP(bf16, WS_KWT) + bh * 32 * 16384; bf16* VTg = WSP(bf16, WS_VTT) + bh * 32 * 16384;
    float* GTg = WSP(float, WS_GT) + bh * 32 * 192;
    if (wid == 0) {
        const float* igfg = WSP(float, WS_IGFG) + (size_t)b * SEQ * 8;
        float mprev = 0.f; const int nch = 4 * c4 + 4;
#pragma unroll 4
        for (int ch = 0; ch < nch; ++ch) {
            const float igv = igfg[(size_t)(ch * 64 + lane) * 8 + hh], fgv = igfg[(size_t)(ch * 64 + lane) * 8 + 4 + hh];
            const float lf = log_sigmoid(fgv);
            const float bb = wave_scan_add(lf);
            const float a = igv - bb; const float cm = wave_scan_max(a);
            const float mt = bb + fmaxf(mprev, cm);
            const float mL = __builtin_bit_cast(float, __builtin_amdgcn_readlane(__builtin_bit_cast(int, mt), 63)), bL = __builtin_bit_cast(float, __builtin_amdgcn_readlane(__builtin_bit_cast(int, bb), 63));
            if (ch >= 4 * c4) {
                const int ci = ch - 4 * c4;
                LAS float* v = vecs + ci * 384;
                v[lane] = a; v[64 + lane] = bb; v[128 + lane] = mt; v[192 + lane] = expf(a + bL - mL);
                float* g = GTg + (size_t)ch * 192;
                g[lane] = expf(mprev + bb - mt); g[64 + lane] = expf(-mt);
                if (lane == 0) g[128] = expf(mprev + bL - mL);
            }
            mprev = mL;
        }
        if (c4 == 7 && lane == 0) F.out[O_PM + (l * NB + b) * NH + hh] = mprev;
    }
    u32x4 q4[4], k4[4], v4[4];
#define MP_LOAD(c) do { const bf16* pr = projb + (size_t)((c) * 64 + lane) * NPROJ + hh * 256 + wid * 32; \
        _Pragma("unroll") for (int i = 0; i < 4; ++i) { q4[i] = *(const u32x4*)(pr + C_Q + i * 8); k4[i] = *(const u32x4*)(pr + C_K + i * 8); v4[i] = *(const u32x4*)(pr + C_V + i * 8); } } while (0)
    MP_LOAD(4 * c4);
    __syncthreads();
    for (int ci = 0; ci < 4; ++ci) {
        const int c = 4 * c4 + ci;
        const LAS float* vec = vecs + ci * 384;
#pragma unroll
        for (int i = 0; i < 4; ++i) { *(LAS u32x4*)(L + MP_Q + lane * 528 + (wid * 32 + i * 8) * 2) = q4[i]; *(LAS u32x4*)(L + MP_K + lane * 528 + (wid * 32 + i * 8) * 2) = k4[i]; }
        { const float w = vec[192 + lane] * 0.0625f;
#pragma unroll
          for (int i = 0; i < 4; ++i) { float kf[8]; unpack8(k4[i], kf);
#pragma unroll
            for (int j = 0; j < 8; ++j) ((LAS unsigned short*)(L + MP_T2))[(wid * 32 + i * 8 + j) * 72 + lane] = (unsigned short)f2bf(kf[j] * w); } }
        u32x4 vc4[4];
#pragma unroll
        for (int i = 0; i < 4; ++i) vc4[i] = v4[i];
        __syncthreads();
        if (ci + 1 < 4) MP_LOAD(c + 1);
        { const int tt = wid >> 1;
#pragma unroll
          for (int si = 0; si < 2; ++si) { const int st = (wid & 1) * 2 + si;
            f32x4 acc = (f32x4){0.f, 0.f, 0.f, 0.f};
            if (st <= tt) {
#pragma unroll
                for (int kk = 0; kk < 8; ++kk) { const bf16x8 kf = *(const LAS bf16x8*)(L + MP_K + (st * 16 + fr) * 528 + (kk * 32 + fq * 8) * 2), qf = *(const LAS bf16x8*)(L + MP_Q + (tt * 16 + fr) * 528 + (kk * 32 + fq * 8) * 2);
                    acc = __builtin_amdgcn_mfma_f32_16x16x32_bf16(kf, qf, acc, 0, 0, 0); }
            }
            const int t = tt * 16 + fr, s0 = st * 16 + fq * 4; const float bt = vec[64 + t] - vec[128 + t];
            float p[4];
#pragma unroll
            for (int j = 0; j < 4; ++j) { const int s = s0 + j; p[j] = (s <= t) ? acc[j] * 0.0625f * __expf(vec[s] + bt) : 0.f; }
            u32x2 w; w.x = pk2(p[0], p[1]); w.y = pk2(p[2], p[3]); *(u32x2*)(PTg + (size_t)c * 4096 + t * 64 + s0) = w; } }
        { const int d = tid >> 1, hf = tid & 1; bf16* o = KWg + (size_t)c * 16384 + d * 64 + hf * 32;
#pragma unroll
          for (int i = 0; i < 4; ++i) *(u32x4*)(o + i * 8) = *(const LAS u32x4*)(L + MP_T2 + d * 144 + hf * 64 + i * 16); }
        __syncthreads();
#pragma unroll
        for (int i = 0; i < 4; ++i) { const unsigned ww[4] = {vc4[i].x, vc4[i].y, vc4[i].z, vc4[i].w};
#pragma unroll
            for (int j = 0; j < 4; ++j) { ((LAS unsigned short*)(L + MP_T2))[(wid * 32 + i * 8 + 2 * j) * 72 + lane] = (unsigned short)(ww[j] & 0xffffu); ((LAS unsigned short*)(L + MP_T2))[(wid * 32 + i * 8 + 2 * j + 1) * 72 + lane] = (unsigned short)(ww[j] >> 16); } }
        __syncthreads();
        { const int d = tid >> 1, hf = tid & 1; bf16* o = VTg + (size_t)c * 16384 + d * 64 + hf * 32;
#pragma unroll
          for (int i = 0; i < 4; ++i) *(u32x4*)(o + i * 8) = *(const LAS u32x4*)(L + MP_T2 + d * 144 + hf * 64 + i * 16); }
        __syncthreads();
    }
#undef MP_LOAD
}

constexpr int MR_CT = 0, MR_NUM = 25344, MR_DEN = 33536, MR_END = 34048;
DI void mlstm_rec_job(Frame& F, int l, int job) {
    const int b = job >> 5, hh = (job >> 3) & 3, sl = job & 7;
    const int tid = opaque_tid(), lane = tid & 63, wid = __builtin_amdgcn_readfirstlane(tid >> 6), fr = lane & 15, fq = lane >> 4;
    const int tt = wid >> 1, et = wid & 1, t = tt * 16 + fr;
    LAS unsigned char* L = F.lds;
    const size_t bh = (size_t)(b * NH + hh);
    const bf16* qp = WSP(bf16, WS_PROJ) + ((size_t)b * SEQ + t) * NPROJ + C_Q + hh * 256 + fq * 8;
    const bf16* pp = WSP(bf16, WS_PT) + bh * 32 * 4096 + t * 64 + fq * 8;
    const bf16* kp = WSP(bf16, WS_KWT) + bh * 32 * 16384 + (wid * 32 + fr) * 64 + fq * 8;
    const bf16* vp = WSP(bf16, WS_VTT) + bh * 32 * 16384 + (sl * 32 + fr) * 64 + fq * 8;
    const float* gp = WSP(float, WS_GT) + bh * 32 * 192;
    const int ht = tid >> 3, he0 = (tid & 7) * 4;
    const bf16* sop = WSP(bf16, WS_PROJ) + ((size_t)b * SEQ + ht) * NPROJ + C_O + hh * 256 + sl * 32 + he0;
    bf16* hc = WSP(bf16, WS_HC) + ((size_t)b * SEQ + ht) * D + hh * 256 + sl * 32 + he0;
    for (int i = tid; i < 25344 / 4; i += 512) ((LAS unsigned*)(L + MR_CT))[i] = 0u;
    f32x4 cacc[2][3];
#pragma unroll
    for (int i = 0; i < 2; ++i)
#pragma unroll
        for (int j = 0; j < 3; ++j) cacc[i][j] = (f32x4){0.f, 0.f, 0.f, 0.f};
    bf16x8 ones; { const short o = (fr == 0) ? (short)0x3F80 : (short)0;
#pragma unroll
        for (int j = 0; j < 8; ++j) ones[j] = o; }
    bf16x8 qf[8], pf[2], kfA[2][2], vfA[2][2], kfB[2][2], vfB[2][2]; float interA, enmA, decA, interB, enmB, decB; u32x2 soA, soB;
#define MR_LOADQP(c) do { \
        _Pragma("unroll") for (int kk = 0; kk < 8; ++kk) qf[kk] = *(const bf16x8*)(qp + (size_t)(c) * 64 * NPROJ + kk * 32); \
        _Pragma("unroll") for (int ks = 0; ks < 2; ++ks) pf[ks] = *(const bf16x8*)(pp + (size_t)(c) * 4096 + ks * 32); } while (0)
#define MR_LOADKV(S, c) do { \
        _Pragma("unroll") for (int ks = 0; ks < 2; ++ks) { \
            _Pragma("unroll") for (int x = 0; x < 2; ++x) { kf##S[x][ks] = *(const bf16x8*)(kp + (size_t)(c) * 16384 + x * 1024 + ks * 32); vf##S[x][ks] = *(const bf16x8*)(vp + (size_t)(c) * 16384 + x * 1024 + ks * 32); } } \
        inter##S = gp[(c) * 192 + t]; enm##S = gp[(c) * 192 + 64 + ht]; dec##S = gp[(c) * 192 + 128]; so##S = *(const u32x2*)(sop + (size_t)(c) * 64 * NPROJ); } while (0)
#define MR_BODY(S, N, c) do { \
          \
        f32x4 aP = (f32x4){0.f, 0.f, 0.f, 0.f}, aC0 = aP, aC1 = aP, dP = aP, dC = aP; \
        bf16x8 cf[8], c2[4]; \
        _Pragma("unroll") for (int kk = 0; kk < 8; ++kk) cf[kk] = *(const LAS bf16x8*)(L + MR_CT + (et * 16 + fr) * 528 + (kk * 32 + fq * 8) * 2); \
        _Pragma("unroll") for (int kk = 0; kk < 4; ++kk) c2[kk] = *(const LAS bf16x8*)(L + MR_CT + (32 + fr) * 528 + ((et * 4 + kk) * 32 + fq * 8) * 2); \
        if (et == 0) { _Pragma("unroll") for (int ks = 0; ks < 2; ++ks) { aP = __builtin_amdgcn_mfma_f32_16x16x32_bf16(vf##S[0][ks], pf[ks], aP, 0, 0, 0); dP = __builtin_amdgcn_mfma_f32_16x16x32_bf16(ones, pf[ks], dP, 0, 0, 0); } \
            _Pragma("unroll") for (int kk = 0; kk < 4; ++kk) dC = __builtin_amdgcn_mfma_f32_16x16x32_bf16(c2[kk], qf[kk], dC, 0, 0, 0); } \
        else { _Pragma("unroll") for (int ks = 0; ks < 2; ++ks) aP = __builtin_amdgcn_mfma_f32_16x16x32_bf16(vf##S[1][ks], pf[ks], aP, 0, 0, 0); \
            _Pragma("unroll") for (int kk = 0; kk < 4; ++kk) dC = __builtin_amdgcn_mfma_f32_16x16x32_bf16(c2[kk], qf[4 + kk], dC, 0, 0, 0); } \
        _Pragma("unroll") for (int kk = 0; kk < 8; kk += 2) { aC0 = __builtin_amdgcn_mfma_f32_16x16x32_bf16(cf[kk], qf[kk], aC0, 0, 0, 0); aC1 = __builtin_amdgcn_mfma_f32_16x16x32_bf16(cf[kk + 1], qf[kk + 1], aC1, 0, 0, 0); } \
        __builtin_amdgcn_sched_barrier(0); \
        if ((c) + 1 < SEQ / 64) { MR_LOADQP((c) + 1); MR_LOADKV(N, (c) + 1); } \
        __builtin_amdgcn_sched_barrier(0); \
        *(LAS f32x4*)(L + MR_NUM + (t * 32 + et * 16 + fq * 4) * 4) = aP + (aC0 + aC1) * inter##S; \
        if (fq == 0) ((LAS float*)(L + MR_DEN))[t * 2 + et] = dP.x + dC.x * inter##S; \
        __syncthreads();                                                      \
          \
        { const f32x4 nm = *(const LAS f32x4*)(L + MR_NUM + (ht * 32 + he0) * 4); const float den = ((LAS float*)(L + MR_DEN))[ht * 2] + ((LAS float*)(L + MR_DEN))[ht * 2 + 1]; \
          const float inv = 1.0f / fmaxf(fabsf(den), enm##S); \
          u32x2 w; w.x = pk2(lo16(so##S.x) * nm.x * inv, hi16(so##S.x) * nm.y * inv); w.y = pk2(lo16(so##S.y) * nm.z * inv, hi16(so##S.y) * nm.w * inv); \
          *(u32x2*)(hc + (size_t)(c) * 64 * D) = w; } \
          \
        _Pragma("unroll") for (int di = 0; di < 2; ++di) { \
            _Pragma("unroll") for (int e3 = 0; e3 < 3; ++e3) { f32x4 a = cacc[di][e3] * dec##S; \
                _Pragma("unroll") for (int ks = 0; ks < 2; ++ks) a = __builtin_amdgcn_mfma_f32_16x16x32_bf16(kf##S[di][ks], e3 == 2 ? ones : vf##S[e3 & 1][ks], a, 0, 0, 0); \
                cacc[di][e3] = a; \
                u32x2 w; w.x = pk2(a.x, a.y); w.y = pk2(a.z, a.w); *(LAS u32x2*)(L + MR_CT + (e3 * 16 + fr) * 528 + ((wid * 2 + di) * 16 + fq * 4) * 2) = w; } } \
        __syncthreads();                                                      \
    } while (0)
    MR_LOADQP(0); MR_LOADKV(A, 0);
    __syncthreads();
#pragma unroll 1
    for (int c = 0; c < SEQ / 64; c += 2) { MR_BODY(A, B, c); MR_BODY(B, A, c + 1); }
#undef MR_BODY
#undef MR_LOADKV
#undef MR_LOADQP
    { float* pc = F.out + O_PC + ((size_t)((l * NB + b) * NH + hh)) * 65536;
#pragma unroll
      for (int di = 0; di < 2; ++di) { const int dt = wid * 2 + di;
#pragma unroll
        for (int e3 = 0; e3 < 2; ++e3)
#pragma unroll
            for (int j = 0; j < 4; ++j) pc[(size_t)(dt * 16 + fq * 4 + j) * 256 + sl * 32 + e3 * 16 + fr] = cacc[di][e3][j];
        if (sl == 0 && fr == 0) { float* pn = F.out + O_PN + ((size_t)((l * NB + b) * NH + hh)) * 256;
#pragma unroll
            for (int j = 0; j < 4; ++j) pn[dt * 16 + fq * 4 + j] = cacc[di][2][j]; } } }
    __syncthreads();
}

constexpr int R2_CT = 0, R2_NUM = 42240, R2_DEN = 75008, R2_END = 75520;
static_assert(R2_END <= XCH_OFF, "rec2 LDS map");
DI void mlstm_rec2_job(Frame& F, int l, int job) {
    const int b = job >> 4, hh = (job >> 2) & 3, sp = job & 3;
    const int tid = opaque_tid(), lane = tid & 63, wid = __builtin_amdgcn_readfirstlane(tid >> 6), fr = lane & 15, fq = lane >> 4;
    const int tt = wid >> 1, kh = wid & 1, t = tt * 16 + fr;
    LAS unsigned char* L = F.lds;
    const size_t bh = (size_t)(b * NH + hh);
    const bf16* qp = WSP(bf16, WS_PROJ) + ((size_t)b * SEQ + t) * NPROJ + C_Q + hh * 256 + kh * 128 + fq * 8;
    const bf16* pp = WSP(bf16, WS_PT) + bh * 32 * 4096 + t * 64 + kh * 32 + fq * 8;
    const bf16* kp = WSP(bf16, WS_KWT) + bh * 32 * 16384 + (wid * 32 + fr) * 64 + fq * 8;
    const bf16* vp = WSP(bf16, WS_VTT) + bh * 32 * 16384 + (sp * 64 + fr) * 64 + fq * 8;
    const float* gp = WSP(float, WS_GT) + bh * 32 * 192;
    const int ht = tid >> 3, he0 = (tid & 7) * 8;
    const bf16* sop = WSP(bf16, WS_PROJ) + ((size_t)b * SEQ + ht) * NPROJ + C_O + hh * 256 + sp * 64 + he0;
    bf16* hc = WSP(bf16, WS_HC) + ((size_t)b * SEQ + ht) * D + hh * 256 + sp * 64 + he0;
    for (int i = tid; i < 42240 / 4; i += 512) ((LAS unsigned*)(L + R2_CT))[i] = 0u;
    f32x4 cacc[2][5];
#pragma unroll
    for (int i = 0; i < 2; ++i)
#pragma unroll
        for (int j = 0; j < 5; ++j) cacc[i][j] = (f32x4){0.f, 0.f, 0.f, 0.f};
    bf16x8 ones; { const short o = (fr == 0) ? (short)0x3F80 : (short)0;
#pragma unroll
        for (int j = 0; j < 8; ++j) ones[j] = o; }
    bf16x8 qf[4], pf, kf[2][2], vfA[4][2], vfB[4][2]; float interA, enmA, decA, interB, enmB, decB; u32x4 soA, soB;
#define R2_LOADQP(c) do { \
        _Pragma("unroll") for (int kk = 0; kk < 4; ++kk) qf[kk] = *(const bf16x8*)(qp + (size_t)(c) * 64 * NPROJ + kk * 32); \
        pf = *(const bf16x8*)(pp + (size_t)(c) * 4096); } while (0)
#define R2_LOADK(c) do { \
        _Pragma("unroll") for (int ks = 0; ks < 2; ++ks) { \
            _Pragma("unroll") for (int x = 0; x < 2; ++x) kf[x][ks] = *(const bf16x8*)(kp + (size_t)(c) * 16384 + x * 1024 + ks * 32); } } while (0)
#define R2_LOADKV(S, c) do { \
        _Pragma("unroll") for (int ks = 0; ks < 2; ++ks) { \
            _Pragma("unroll") for (int e = 0; e < 4; ++e) vf##S[e][ks] = *(const bf16x8*)(vp + (size_t)(c) * 16384 + e * 1024 + ks * 32); } \
        inter##S = gp[(c) * 192 + t]; enm##S = gp[(c) * 192 + 64 + ht]; dec##S = gp[(c) * 192 + 128]; so##S = *(const u32x4*)(sop + (size_t)(c) * 64 * NPROJ); } while (0)
#define R2_BODY(S, N, c) do { \
        f32x4 ac[5]; \
        _Pragma("unroll") for (int e = 0; e < 5; ++e) { bf16x8 cf[4]; f32x4 a = (f32x4){0.f, 0.f, 0.f, 0.f}; \
            _Pragma("unroll") for (int kk = 0; kk < 4; ++kk) cf[kk] = *(const LAS bf16x8*)(L + R2_CT + (e * 16 + fr) * 528 + ((kh * 4 + kk) * 32 + fq * 8) * 2); \
            _Pragma("unroll") for (int kk = 0; kk < 4; ++kk) a = __builtin_amdgcn_mfma_f32_16x16x32_bf16(cf[kk], qf[kk], a, 0, 0, 0); \
            ac[e] = a * inter##S; }                                             \
        if (kh == 0) { _Pragma("unroll") for (int e = 0; e < 4; ++e) ac[e] = __builtin_amdgcn_mfma_f32_16x16x32_bf16(vf##S[e][0], pf, ac[e], 0, 0, 0); } \
        else { _Pragma("unroll") for (int e = 0; e < 4; ++e) ac[e] = __builtin_amdgcn_mfma_f32_16x16x32_bf16(vf##S[e][1], pf, ac[e], 0, 0, 0); } \
        ac[4] = __builtin_amdgcn_mfma_f32_16x16x32_bf16(ones, pf, ac[4], 0, 0, 0); \
        __builtin_amdgcn_sched_barrier(0); \
        if ((c) + 1 < SEQ / 64) { R2_LOADQP((c) + 1); R2_LOADKV(N, (c) + 1); } \
        __builtin_amdgcn_sched_barrier(0); \
        _Pragma("unroll") for (int e = 0; e < 4; ++e) *(LAS f32x4*)(L + R2_NUM + ((kh * 64 + t) * 64 + e * 16 + fq * 4) * 4) = ac[e]; \
        if (fq == 0) ((LAS float*)(L + R2_DEN))[kh * 64 + t] = ac[4].x; \
        __syncthreads();                                                      \
        { const LAS float* n0 = (const LAS float*)(L + R2_NUM) + ht * 64 + he0; \
          const f32x4 x0 = *(const LAS f32x4*)n0 + *(const LAS f32x4*)(n0 + 4096), x1 = *(const LAS f32x4*)(n0 + 4) + *(const LAS f32x4*)(n0 + 4096 + 4); \
          const float den = ((LAS float*)(L + R2_DEN))[ht] + ((LAS float*)(L + R2_DEN))[64 + ht]; \
          const float inv = 1.0f / fmaxf(fabsf(den), enm##S); \
          u32x4 w; w.x = pk2(lo16(so##S.x) * x0.x * inv, hi16(so##S.x) * x0.y * inv); w.y = pk2(lo16(so##S.y) * x0.z * inv, hi16(so##S.y) * x0.w * inv); \
          w.z = pk2(lo16(so##S.z) * x1.x * inv, hi16(so##S.z) * x1.y * inv); w.w = pk2(lo16(so##S.w) * x1.z * inv, hi16(so##S.w) * x1.w * inv); \
          *(u32x4*)(hc + (size_t)(c) * 64 * D) = w; } \
        _Pragma("unroll") for (int di = 0; di < 2; ++di) { \
            _Pragma("unroll") for (int e3 = 0; e3 < 5; ++e3) { f32x4 a = cacc[di][e3] * dec##S; \
                _Pragma("unroll") for (int ks = 0; ks < 2; ++ks) a = __builtin_amdgcn_mfma_f32_16x16x32_bf16(kf[di][ks], e3 == 4 ? ones : vf##S[e3 & 3][ks], a, 0, 0, 0); \
                cacc[di][e3] = a; \
                u32x2 w; w.x = pk2(a.x, a.y); w.y = pk2(a.z, a.w); *(LAS u32x2*)(L + R2_CT + (e3 * 16 + fr) * 528 + ((wid * 2 + di) * 16 + fq * 4) * 2) = w; } } \
        __builtin_amdgcn_sched_barrier(0); \
        if ((c) + 1 < SEQ / 64) R2_LOADK((c) + 1); \
        __builtin_amdgcn_sched_barrier(0); \
        __syncthreads();                                                      \
    } while (0)
    R2_LOADQP(0); R2_LOADKV(A, 0); R2_LOADK(0);
    __syncthreads();
#pragma unroll 1
    for (int c = 0; c < SEQ / 64; c += 2) { R2_BODY(A, B, c); R2_BODY(B, A, c + 1); }
#undef R2_BODY
#undef R2_LOADK
#undef R2_LOADKV
#undef R2_LOADQP
    { float* pc = F.out + O_PC + ((size_t)((l * NB + b) * NH + hh)) * 65536;
#pragma unroll
      for (int di = 0; di < 2; ++di) { const int dt = wid * 2 + di;
#pragma unroll
        for (int e3 = 0; e3 < 4; ++e3)
#pragma unroll
            for (int j = 0; j < 4; ++j) pc[(size_t)(dt * 16 + fq * 4 + j) * 256 + sp * 64 + e3 * 16 + fr] = cacc[di][e3][j];
        if (sp == 0 && fr == 0) { float* pn = F.out + O_PN + ((size_t)((l * NB + b) * NH + hh)) * 256;
#pragma unroll
            for (int j = 0; j < 4; ++j) pn[dt * 16 + fq * 4 + j] = cacc[di][4][j]; } } }
    __syncthreads();
}

DI void mlstm_sample_job(Frame& F, int l, int job) {
    const int b = job >> 2, hh = job & 3; const int tid = opaque_tid(), lane = tid & 63, wid = __builtin_amdgcn_readfirstlane(tid >> 6);
    LAS float* qs = (LAS float*)F.lds;
    LAS float* kws = qs + 256; LAS float* red = qs + 512; LAS float* scal = qs + 512 + 2048;
    const bf16* prow = WSP(bf16, WS_PROJ) + (size_t)(MP + b) * NPROJ;
    const size_t sidx = (size_t)((l * MS + b) * NH + hh);
    const float* C = ((const float*)F.in[5]) + sidx * 65536; const float* nst = ((const float*)F.in[6]) + sidx * 256; float* Cn = F.out + O_SC + sidx * 65536;
    const float ig = WSP(float, WS_IGFG)[(size_t)(MP + b) * 8 + hh], fg = WSP(float, WS_IGFG)[(size_t)(MP + b) * 8 + 4 + hh];
    const float m0 = ((const float*)F.in[7])[sidx];
    const float lf = log_sigmoid(fg), mt = fmaxf(m0 + lf, ig), inter = expf(m0 + lf - mt), wsi = expf(ig - mt);
    if (tid < 256) {
        const float q = bf2f(prow[C_Q + hh * 256 + tid]), k = bf2f(prow[C_K + hh * 256 + tid]) * 0.0625f;
        qs[tid] = q; kws[tid] = k * wsi;
        const float n0 = nst[tid];
        F.out[O_SN + sidx * 256 + tid] = inter * n0 + k * wsi;
        float qk = q * k, qn = q * n0;
        qk = wave_sum(qk); qn = wave_sum(qn);
        if (lane == 0) { scal[wid * 2] = qk; scal[wid * 2 + 1] = qn; }
    }
    __syncthreads();
    const float qk = scal[0] + scal[2] + scal[4] + scal[6], qn = scal[1] + scal[3] + scal[5] + scal[7];
    const float s = qk * wsi, den = s + inter * qn, inv = 1.0f / fmaxf(fabsf(den), expf(-mt));
    const u32x2 vw = *(const u32x2*)(prow + C_V + hh * 256 + lane * 4);
    const f32x4 v4 = (f32x4){lo16(vw.x), hi16(vw.x), lo16(vw.y), hi16(vw.y)};
    f32x4 acc = (f32x4){0.f, 0.f, 0.f, 0.f};
#pragma unroll 16
    for (int i = 0; i < 32; ++i) { const int d = wid * 32 + i; const f32x4 c = *(const f32x4*)(C + (size_t)d * 256 + lane * 4);
        acc += c * qs[d]; *(f32x4*)(Cn + (size_t)d * 256 + lane * 4) = c * inter + v4 * kws[d]; }
    *(LAS f32x4*)(red + wid * 256 + lane * 4) = acc;
    __syncthreads();
    if (tid < 256) { float qc = 0.f;
#pragma unroll
        for (int w = 0; w < 8; ++w) qc += red[w * 256 + tid];
        const float v = bf2f(prow[C_V + hh * 256 + tid]), so = bf2f(prow[C_O + hh * 256 + tid]);
        const float h = (s * v + inter * qc) * inv;
        WSP(bf16, WS_HC)[(size_t)(MP + b) * D + hh * 256 + tid] = (bf16)f2bf(so * h); }
    if (tid == 0) F.out[O_SM + sidx] = mt;
    __syncthreads();
}

DI void xattn_sample_job(Frame& F, int l, int job) {
    const int b = job >> 1, hp = job & 1; const int tid = opaque_tid(), lane = tid & 63, wid = __builtin_amdgcn_readfirstlane(tid >> 6);
    LAS float* part = (LAS float*)F.lds;
    const bf16* prow = WSP(bf16, WS_XQ) + (size_t)(MP + b) * D + hp * 512;
    const float* Kc = ((const float*)F.in[3]) + ((size_t)(l * MS + b) * NMEM) * 1024 + hp * 512 + lane * 8;
    const float* Vc = ((const float*)F.in[4]) + ((size_t)(l * MS + b) * NMEM) * 1024 + hp * 512 + lane * 8;
    float q[8]; { const u32x4 w = *(const u32x4*)(prow + lane * 8); unpack8(w, q); }
#pragma unroll
    for (int j = 0; j < 8; ++j) q[j] *= 0.0625f;
    float M = -3.0e38f, S = 0.f, acc[8];
#pragma unroll
    for (int j = 0; j < 8; ++j) acc[j] = 0.f;
    f32x4 kA[4][2], vA[4][2], kB[4][2], vB[4][2];
#define XS_LOAD(S_, g) do { _Pragma("unroll") for (int u = 0; u < 4; ++u) { const size_t o = (size_t)(wid + 8 * (4 * (g) + u)) * 1024; \
        k##S_[u][0] = *(const f32x4*)(Kc + o); k##S_[u][1] = *(const f32x4*)(Kc + o + 4); v##S_[u][0] = *(const f32x4*)(Vc + o); v##S_[u][1] = *(const f32x4*)(Vc + o + 4); } } while (0)
#define XS_STEP(S_) do { float sc4[4]; \
        _Pragma("unroll") for (int u = 0; u < 4; ++u) sc4[u] = (q[0] * k##S_[u][0].x + q[1] * k##S_[u][0].y) + (q[2] * k##S_[u][0].z + q[3] * k##S_[u][0].w) + (q[4] * k##S_[u][1].x + q[5] * k##S_[u][1].y) + (q[6] * k##S_[u][1].z + q[7] * k##S_[u][1].w); \
        _Pragma("unroll") for (int o = 1; o < 32; o <<= 1) { _Pragma("unroll") for (int u = 0; u < 4; ++u) sc4[u] += __shfl_xor(sc4[u], o); } \
        const float mn = fmaxf(fmaxf(M, fmaxf(sc4[0], sc4[1])), fmaxf(sc4[2], sc4[3])); const float corr = __expf(M - mn); M = mn; S *= corr; \
        _Pragma("unroll") for (int j = 0; j < 8; ++j) acc[j] *= corr; \
        _Pragma("unroll") for (int u = 0; u < 4; ++u) { const float p = __expf(sc4[u] - mn); S += p; \
            acc[0] += p * v##S_[u][0].x; acc[1] += p * v##S_[u][0].y; acc[2] += p * v##S_[u][0].z; acc[3] += p * v##S_[u][0].w; acc[4] += p * v##S_[u][1].x; acc[5] += p * v##S_[u][1].y; acc[6] += p * v##S_[u][1].z; acc[7] += p * v##S_[u][1].w; } } while (0)
    XS_LOAD(A, 0);
#pragma unroll 1
    for (int g = 0; g < 8; g += 2) { XS_LOAD(B, g + 1); XS_STEP(A); if (g + 2 < 8) XS_LOAD(A, g + 2); XS_STEP(B); }
#undef XS_LOAD
#undef XS_STEP
    { LAS float* pw = part + (wid * 2 + (lane >> 5)) * 260;
      if ((lane & 31) == 0) { pw[0] = M; pw[1] = S; }
      *(LAS f32x4*)(pw + 4 + (lane & 31) * 8) = (f32x4){acc[0], acc[1], acc[2], acc[3]}; *(LAS f32x4*)(pw + 4 + (lane & 31) * 8 + 4) = (f32x4){acc[4], acc[5], acc[6], acc[7]}; }
    __syncthreads();
    { const int hsel = tid >> 8, d = tid & 255; float mx = -3.0e38f;
#pragma unroll
      for (int w = 0; w < 8; ++w) mx = fmaxf(mx, part[(w * 2 + hsel) * 260]);
      float num = 0.f, den = 0.f;
#pragma unroll
      for (int w = 0; w < 8; ++w) { const LAS float* pw = part + (w * 2 + hsel) * 260; const float e = __expf(pw[0] - mx); den += e * pw[1]; num += e * pw[4 + d]; }
      WSP(bf16, WS_OX)[(size_t)(MP + b) * D + hp * 512 + tid] = (bf16)f2bf(num / den); }
    __syncthreads();
}

DI void phase_pool_d(Frame& F, int l) {
    const bf16* proj = WSP(bf16, WS_PROJ); bf16* dp = WSP(bf16, WS_DP);
    const int gt = F.vcu * 512 + opaque_tid(), gs = F.G * 512;
    for (int it = gt; it < (MP / 16) * 128; it += gs) {
        const int rb = (int)(it >> 7), cg = (int)(it & 127), row0 = rb * 16, t0 = row0 & (SEQ - 1), b = row0 >> 11, w = 2 << (cg >> 5);
        const bf16* up = proj + (size_t)row0 * NPROJ + C_U + cg * 8;
        float sum[8];
#pragma unroll
        for (int j = 0; j < 8; ++j) sum[j] = 0.f;
        for (int i = 1; i < w; ++i) if (t0 - i >= 0) { float f[8]; unpack8(*(const u32x4*)(up - (size_t)i * NPROJ), f);
#pragma unroll
            for (int j = 0; j < 8; ++j) sum[j] += f[j]; }
#pragma unroll 4
        for (int r = 0; r < 16; ++r) {
            const int t = t0 + r; float u0[8]; unpack8(*(const u32x4*)(up + (size_t)r * NPROJ), u0);
#pragma unroll
            for (int j = 0; j < 8; ++j) sum[j] += u0[j];
            const int nw = (t + 1 < w) ? t + 1 : w; const float inv = 1.0f / (float)nw;
            u32x4 o; o.x = pk2(sum[0] * inv - u0[0], sum[1] * inv - u0[1]); o.y = pk2(sum[2] * inv - u0[2], sum[3] * inv - u0[3]); o.z = pk2(sum[4] * inv - u0[4], sum[5] * inv - u0[5]); o.w = pk2(sum[6] * inv - u0[6], sum[7] * inv - u0[7]);
            *(u32x4*)(dp + (size_t)(row0 + r) * D + cg * 8) = o;
            if (t >= SEQ - 15) { float* pp = F.out + O_PPOOL + ((size_t)(l * NB + b) * 15 + (t - (SEQ - 15))) * 1024 + cg * 8;
                *(f32x4*)pp = (f32x4){u0[0], u0[1], u0[2], u0[3]}; *(f32x4*)(pp + 4) = (f32x4){u0[4], u0[5], u0[6], u0[7]}; }
            if (t - (w - 1) >= 0) { float f[8]; unpack8(*(const u32x4*)(up + (size_t)(r - (w - 1)) * NPROJ), f);
#pragma unroll
                for (int j = 0; j < 8; ++j) sum[j] -= f[j]; }
        }
    }
    for (int it = gt; it < MS * 128; it += gs) {
        const int b = (int)(it >> 7), cg = (int)(it & 127), w = 2 << (cg >> 5);
        const float* sp = ((const float*)F.in[8]) + ((size_t)(l * MS + b) * 15) * 1024 + cg * 8;
        float u0[8], sum[8]; { const u32x4 x = *(const u32x4*)(proj + (size_t)(MP + b) * NPROJ + C_U + cg * 8); unpack8(x, u0); }
#pragma unroll
        for (int j = 0; j < 8; ++j) sum[j] = u0[j];
        for (int i = 1; i < w; ++i) { const f32x4 a = *(const f32x4*)(sp + (size_t)(15 - i) * 1024), c = *(const f32x4*)(sp + (size_t)(15 - i) * 1024 + 4);
            sum[0] += a.x; sum[1] += a.y; sum[2] += a.z; sum[3] += a.w; sum[4] += c.x; sum[5] += c.y; sum[6] += c.z; sum[7] += c.w; }
        const float inv = 1.0f / (float)w;
        u32x4 o; o.x = pk2(sum[0] * inv - u0[0], sum[1] * inv - u0[1]); o.y = pk2(sum[2] * inv - u0[2], sum[3] * inv - u0[3]); o.z = pk2(sum[4] * inv - u0[4], sum[5] * inv - u0[5]); o.w = pk2(sum[6] * inv - u0[6], sum[7] * inv - u0[7]);
        *(u32x4*)(dp + (size_t)(MP + b) * D + cg * 8) = o;
        float* so = F.out + O_SPOOL + ((size_t)(l * MS + b) * 15) * 1024 + cg * 8;
        for (int i = 0; i < 14; ++i) { *(f32x4*)(so + (size_t)i * 1024) = *(const f32x4*)(sp + (size_t)(i + 1) * 1024); *(f32x4*)(so + (size_t)i * 1024 + 4) = *(const f32x4*)(sp + (size_t)(i + 1) * 1024 + 4); }
        *(f32x4*)(so + (size_t)14 * 1024) = (f32x4){u0[0], u0[1], u0[2], u0[3]}; *(f32x4*)(so + (size_t)14 * 1024 + 4) = (f32x4){u0[4], u0[5], u0[6], u0[7]};
    }
}

DI void phase_headnorm(Frame& F, int l) {
    const bf16* hc = WSP(bf16, WS_HC); bf16* hn = WSP(bf16, WS_HN); const float* g = ((const float*)F.in[14]) + (size_t)l * D;
    const int tid = opaque_tid(), lane = tid & 63, wid = __builtin_amdgcn_readfirstlane(tid >> 6);
    const int gw = F.vcu * 8 + wid, NGW = F.G * 8;
    f32x4 gg[4];
#pragma unroll
    for (int h = 0; h < 4; ++h) gg[h] = *(const f32x4*)(g + h * 256 + lane * 4);
#pragma unroll 2
    for (int r = gw; r < MT; r += NGW) {
        const size_t off = (size_t)r * D + lane * 4;
        u32x2 w[4];
#pragma unroll
        for (int h = 0; h < 4; ++h) w[h] = *(const u32x2*)(hc + off + h * 256);
        float x[4][4], mu[4], var[4];
#pragma unroll
        for (int h = 0; h < 4; ++h) { x[h][0] = lo16(w[h].x); x[h][1] = hi16(w[h].x); x[h][2] = lo16(w[h].y); x[h][3] = hi16(w[h].y); mu[h] = (x[h][0] + x[h][1]) + (x[h][2] + x[h][3]); }
#pragma unroll
        for (int o = 1; o < 64; o <<= 1) {
#pragma unroll
            for (int h = 0; h < 4; ++h) mu[h] += __shfl_xor(mu[h], o); }
#pragma unroll
        for (int h = 0; h < 4; ++h) { mu[h] *= (1.f / 256.f);
#pragma unroll
            for (int j = 0; j < 4; ++j) x[h][j] -= mu[h];
            var[h] = (x[h][0] * x[h][0] + x[h][1] * x[h][1]) + (x[h][2] * x[h][2] + x[h][3] * x[h][3]); }
#pragma unroll
        for (int o = 1; o < 64; o <<= 1) {
#pragma unroll
            for (int h = 0; h < 4; ++h) var[h] += __shfl_xor(var[h], o); }
#pragma unroll
        for (int h = 0; h < 4; ++h) { const float rr = 1.f / sqrtf(var[h] * (1.f / 256.f) + LN_EPS);
            u32x2 o; o.x = pk2(x[h][0] * rr * gg[h].x, x[h][1] * rr * gg[h].y); o.y = pk2(x[h][2] * rr * gg[h].z, x[h][3] * rr * gg[h].w);
            *(u32x2*)(hn + off + h * 256) = o; }
    }
}

constexpr int PH_PER_L = 10, PH_TOTAL = 2 + DEPTH * PH_PER_L;
struct Args { const float* in[29]; float* out; unsigned char* ws; int ph_lo, ph_hi, li, pad; };
__global__ void __launch_bounds__(512, 2) trunk_fwd(Args args) {
    extern __shared__ __attribute__((aligned(16))) unsigned char lds_raw[];
    Frame F0;
    F0.lds = (LAS unsigned char*)lds_raw;
    F0.G = gridDim.x; { const int bx = blockIdx.x; F0.vcu = (F0.G % 8 == 0) ? (bx % 8) * (F0.G / 8) + bx / 8 : bx; }
    F0.in = (in_tab_t)__builtin_amdgcn_kernarg_segment_ptr(); F0.out = args.out; F0.ws = args.ws;
    volatile LAS unsigned* MISC = (volatile LAS unsigned*)(F0.lds + MISC_OFF);
    if (threadIdx.x < 64) MISC[threadIdx.x] = 0u;
    __syncthreads();
    unsigned* ctl = (unsigned*)(args.ws + WS_CTL);
    XcdBarrier bar = xcd_barrier_post(ctl + CW_BAR + args.li * XCD_BAR_WORDS, MISC + 8);
    const int lo = args.ph_lo, hi = args.ph_hi;
#define IN(k) (lo <= (k) && (k) < hi)
#define PM(b) ((PHMASK >> (b)) & 1u)
#define SEAM(k) do { if (IN(k) && IN((k) + 1)) xcd_barrier(bar); } while (0)
    const int bx0 = (int)blockIdx.x;

    _Pragma("unroll 1") for (int rep = 0; rep <= REP(16); ++rep) if (PM(0) && IN(0)) { if (rep) xcd_barrier(bar); PHASE_BEGIN(F); phase_convert(F); __syncthreads(); phase_ln_in(F); }
    SEAM(0);
    _Pragma("unroll 1") for (int rep = 0; rep <= REP(17); ++rep) if (PM(1) && IN(1)) { if (rep) xcd_barrier(bar);
        PHASE_BEGIN(F);
        pg8::OrderMN S; S.init(WSP(bf16, WS_MEMB), D, WSP(bf16, WS_WKV), D, 2048, DEPTH * 2048, F.G, bx);
        pg8::EpiGran<GeKV> E{{F.out, WSP(bf16, WS_MK), WSP(bf16, WS_MVT)}};
        pg8::gemm_phase(F.lds, D, D, D, S, E);
    }
    SEAM(1);
    for (int l = 0; l < DEPTH; ++l) {
        const int p0 = 2 + l * PH_PER_L;
        _Pragma("unroll 1") for (int rep = 0; rep <= REP(0); ++rep) if (PM(2) && IN(p0 + 0)) { if (rep) xcd_barrier(bar);
            PHASE_BEGIN(F);
            const bf16* W = WSP(bf16, WS_WIN + l * SZ_WIN);
            pg8::OrderMN S; S.init(WSP(bf16, WS_XN), D, W, D, MP, NPROJ, F.G, bx);
            pg8::EpiGran<GeIn> E{{WSP(bf16, WS_PROJ), ((const float*)F.in[13]) + (size_t)l * INW, WSP(bf16, WS_XQ), true}}; GeIn gs = E.g; gs.pre = false;
            pg8::gemm_phase(F.lds, D, D, D, S, E);
            skinny_gemm(F, WSP(bf16, WS_XN) + (size_t)MP * D, D, W, D, NPROJ, D, gs);
        }
        SEAM(p0 + 0);
        _Pragma("unroll 1") for (int rep = 0; rep <= REP(1); ++rep) if (PM(3) && IN(p0 + 1)) { if (rep) xcd_barrier(bar);
            PHASE_BEGIN(F);
            _Pragma("unroll 1") for (int sr = 0; sr <= SREP(0); ++sr) if (SM(0)) for (int j = F.vcu; j < 256; j += F.G) mlstm_prep_job(F, l, j);
            _Pragma("unroll 1") for (int sr = 0; sr <= SREP(1); ++sr) if (SM(1)) {
                OrderAttn<(size_t)D * 2, (size_t)256 * 2, (size_t)256 * D * 2, (size_t)256 * 2> S{F.G, bx, (const char*)WSP(bf16, WS_XQ), (const char*)(WSP(bf16, WS_MK) + (size_t)l * 2048 * D)};
                EpiSoftmax E{WSP(bf16, WS_PB), (LAS float*)(F.lds + XCH_OFF)};
                pg8::gemm_phase(F.lds, 256, D, D, S, E);
            }
            _Pragma("unroll 1") for (int sr = 0; sr <= SREP(3); ++sr) if (SM(3)) for (int j = F.vcu; j < MS * 2; j += F.G) xattn_sample_job(F, l, j);
        }
        SEAM(p0 + 1);
        _Pragma("unroll 1") for (int rep = 0; rep <= REP(2); ++rep) if (PM(4) && IN(p0 + 2)) { if (rep) xcd_barrier(bar);
            PHASE_BEGIN(F);
            const bool split = (F.G % 16 == 0);
            const int xr = bx >> 3, xi = bx & 7, hx = F.G >> 4;
            const bool rec_role = !split || xr < hx;
            const int ri = split ? xi * hx + xr : F.vcu, rn = split ? F.G / 2 : F.G;
            const int oi = split ? xi * hx + (xr - hx) : F.vcu, on = split ? F.G / 2 : F.G;
            if (rec_role) { _Pragma("unroll 1") for (int sr = 0; sr <= SREP(5); ++sr) if (SM(5)) for (int j = ri; j < 128; j += rn) mlstm_rec2_job(F, l, j); }
            if (!split || !rec_role) {
                Frame F2 = F; F2.vcu = oi; F2.G = on;
                if (SM(6)) { OrderAttn<(size_t)D * 2, (size_t)256 * 2, (size_t)256 * 2, (size_t)256 * 2048 * 2> S{on, oi, (const char*)WSP(bf16, WS_PB), (const char*)(WSP(bf16, WS_MVT) + (size_t)l * 1024 * 2048)};
                    pg8::EpiGran<GeBf16> E{{WSP(bf16, WS_OX), D}};
                    pg8::gemm_phase(F.lds, 256, D, 2048, S, E); }
                _Pragma("unroll 1") for (int sr = 0; sr <= SREP(4); ++sr) if (SM(4)) phase_pool_d(F2, l);
            }
            if (SM(2)) { unsigned* qc = (unsigned*)(F.ws + WS_CTL) + CW_QUEUE + 64 * (l + 4 * rep); volatile LAS unsigned* slot = (volatile LAS unsigned*)(F.lds + MISC_OFF) + 16;
                for (;;) {
                    __syncthreads();
                    if (threadIdx.x == 0) *slot = __hip_atomic_fetch_add(qc, 1u, __ATOMIC_RELAXED, __HIP_MEMORY_SCOPE_AGENT);
                    __syncthreads();
                    const int j = (int)*slot;
                    if (j >= MS * NH) break;
                    mlstm_sample_job(F, l, j);
                } }
        }
        SEAM(p0 + 2);
        _Pragma("unroll 1") for (int rep = 0; rep <= REP(3); ++rep) if (PM(5) && IN(p0 + 3)) { if (rep) xcd_barrier(bar); PHASE_BEGIN(F); phase_headnorm(F, l); }
        SEAM(p0 + 3);
        _Pragma("unroll 1") for (int rep = 0; rep <= REP(4); ++rep) if (PM(6) && IN(p0 + 4)) { if (rep) xcd_barrier(bar);
            PHASE_BEGIN(F);
            const bf16* proj = WSP(bf16, WS_PROJ); float* mix = WSP(float, WS_MIX); bf16* mixb = WSP(bf16, WS_MIXB); const float* ps = ((const float*)F.in[17]) + (size_t)l * D;
            const bf16* Wm = WSP(bf16, WS_WM + l * SZ_W1K); const bf16* Wp = WSP(bf16, WS_WP + l * SZ_WP); const bf16* Wx = WSP(bf16, WS_WX + l * SZ_W1K);
            { OrderD S; S.inner.init(WSP(bf16, WS_HN), D, Wm, D, MP, D, F.G, bx);
              S.A0 = (const char*)WSP(bf16, WS_HN); S.A1 = (const char*)WSP(bf16, WS_DP); S.A2 = (const char*)WSP(bf16, WS_OX); S.B0 = (const char*)Wm; S.B1 = (const char*)Wp; S.B2 = (const char*)Wx;
              EpiMixChain E{mixb, proj, ps}; pg8::gemm_phase(F.lds, D, D, D, S, E); }
            { GeMix<0> g0{mix, mixb, proj, ps}; GeMix<1> g1{mix, mixb, proj, ps}; GeMix<2> g2{mix, mixb, proj, ps};
              skinny_gemm_sk(F, WSP(bf16, WS_HN) + (size_t)MP * D, D, Wm, D, D, g0);
              for (int job = F.vcu; job < 256; job += F.G) { const int rt = job >> 5, cp = job & 31, g = cp >> 3;
                  skinny_job_sk(F, WSP(bf16, WS_DP) + (size_t)MP * D + g * 256, D, Wp + (size_t)(cp * 32) * D + g * 256, D, 256, g1, rt, cp * 32); }
              skinny_gemm_sk(F, WSP(bf16, WS_OX) + (size_t)MP * D, D, Wx, D, D, g2); }
        }
        SEAM(p0 + 4);
        _Pragma("unroll 1") for (int rep = 0; rep <= REP(5); ++rep) if (PM(7) && IN(p0 + 5)) { if (rep) xcd_barrier(bar);
            PHASE_BEGIN(F);
            const bf16* W = WSP(bf16, WS_WO + l * SZ_W1K); pg8::OrderMN S; S.init(WSP(bf16, WS_MIXB), D, W, D, MP, D, F.G, bx);
            pg8::EpiGran<GeRes> E{{WSP(float, WS_X), WSP(float, WS_T), true}}; GeRes gs = E.g; gs.pre = false; pg8::gemm_phase(F.lds, D, D, D, S, E);
            skinny_gemm_sk(F, WSP(bf16, WS_MIXB) + (size_t)MP * D, D, W, D, D, gs);
        }
        SEAM(p0 + 5);
        _Pragma("unroll 1") for (int rep = 0; rep <= REP(6); ++rep) if (PM(8) && IN(p0 + 6)) { if (rep) xcd_barrier(bar); PHASE_BEGIN(F); phase_ln(F, l, 0); }
        SEAM(p0 + 6);
        _Pragma("unroll 1") for (int rep = 0; rep <= REP(7); ++rep) if (PM(9) && IN(p0 + 7)) { if (rep) xcd_barrier(bar);
            PHASE_BEGIN(F);
            const bf16* W = WSP(bf16, WS_WUP + l * SZ_WUP); pg8::OrderMN S; S.init(WSP(bf16, WS_XN), D, W, D, MP, FF2, F.G, bx);
            EpiConv E{WSP(bf16, WS_ACT), WSP(float, WS_HALO), F.out, ((const float*)F.in[24]) + (size_t)l * 3 * FF2, ((const float*)F.in[25]) + (size_t)l * FF2, (LAS float*)(F.lds + XCH_OFF), l};
            pg8::gemm_phase(F.lds, D, D, D, S, E);
            { const int nun = (MP / 256) * (FF2 / 256), nfull = nun % F.G;
              if (nfull == 0) skinny_up_conv(F, l, W, F.vcu, F.G); else if (bx >= nfull) skinny_up_conv(F, l, W, bx - nfull, F.G - nfull); }
        }
        SEAM(p0 + 7);
        _Pragma("unroll 1") for (int rep = 0; rep <= REP(8); ++rep) if (PM(10) && IN(p0 + 8)) { if (rep) xcd_barrier(bar);
            PHASE_BEGIN(F);
            const bf16* W = WSP(bf16, WS_WDN + l * SZ_WDN); pg8::OrderMN S; S.init(WSP(bf16, WS_ACT), FF, W, FF, MP, D, F.G, bx);
            { pg8::Unit uu; for (int i = 0; S.next(i, uu); ++i) conv_fixup(F, l, uu.pm); VM_WAIT(); __syncthreads(); }
            pg8::EpiGran<GeRes> E{{WSP(float, WS_X), WSP(float, WS_T), true}}; GeRes gs = E.g; gs.pre = false; pg8::gemm_phase(F.lds, FF, FF, FF, S, E);
            skinny_gemm_sk(F, WSP(bf16, WS_ACT) + (size_t)MP * FF, FF, W, FF, FF, gs);
        }
        SEAM(p0 + 8);
        _Pragma("unroll 1") for (int rep = 0; rep <= REP(9); ++rep) if (PM(11) && IN(p0 + 9)) { if (rep) xcd_barrier(bar); PHASE_BEGIN(F); phase_ln(F, l, 1); }
        SEAM(p0 + 9);
    }
#undef IN
#undef SEAM
}

extern "C" void kernel_launch(void* const* d_in, const int* in_sizes, int n_in, void* d_out, int out_size, void* d_ws, size_t ws_size, hipStream_t stream) {
    static int grid = 0;
    if (grid == 0) {
        if (n_in != 29 || (size_t)out_size != O_END || ws_size < WS_END) { fprintf(stderr, "kernel_launch: unexpected shapes (n_in %d, out %d, ws %zu; need ws >= %zu)\n", n_in, out_size, ws_size, (size_t)WS_END); grid = -1; return; }
        int dev = 0, cus = 0, per_cu = 0;
        if (hipGetDevice(&dev) != hipSuccess || hipDeviceGetAttribute(&cus, hipDeviceAttributeMultiprocessorCount, dev) != hipSuccess) { grid = -1; return; }
        if (hipFuncSetAttribute((const void*)trunk_fwd, hipFuncAttributeMaxDynamicSharedMemorySize, LDS_BYTES) != hipSuccess) { fprintf(stderr, "kernel_launch: hipFuncSetAttribute failed\n"); grid = -1; return; }
        if (hipOccupancyMaxActiveBlocksPerMultiprocessor(&per_cu, (const void*)trunk_fwd, 512, LDS_BYTES) != hipSuccess || per_cu < 1) fprintf(stderr, "kernel_launch: occupancy query reports %d\n", per_cu);
        (void)hipGetLastError();
        grid = cus;
    }
    if (grid < 0) return;
    (void)hipMemsetAsync((char*)d_ws + WS_CTL, 0, CTL_BYTES, stream);
    Args a{};
    for (int i = 0; i < 29; ++i) a.in[i] = (const float*)d_in[i];
    a.out = (float*)d_out; a.ws = (unsigned char*)d_ws; a.pad = 0;
#if MK_SPLIT
    for (int p = 0; p < PH_TOTAL; ++p) { a.ph_lo = p; a.ph_hi = p + 1; a.li = p; hipLaunchKernelGGL(trunk_fwd, dim3(grid), dim3(512), LDS_BYTES, stream, a); }
#else
    a.ph_lo = 0; a.ph_hi = PH_TOTAL; a.li = 0;
    hipLaunchKernelGGL(trunk_fwd, dim3(grid), dim3(512), LDS_BYTES, stream, a);
#endif
}
```

```cpp
#include <hip/hip_runtime.h>
#include <cstdio>
#include <cstdint>

#define LAS __attribute__((address_space(3)))
#define GAS __attribute__((address_space(1)))
typedef unsigned short bf16;
typedef short bf16x8 __attribute__((ext_vector_type(8)));
typedef float f32x4 __attribute__((ext_vector_type(4)));
typedef float f32x2 __attribute__((ext_vector_type(2)));
typedef unsigned u32x4 __attribute__((ext_vector_type(4)));
typedef unsigned u32x2 __attribute__((ext_vector_type(2)));
#define DI __device__ __forceinline__

#ifndef PHMASK
#define PHMASK 0xFFFFFFFFu
#endif
#ifndef SUBMASK
#define SUBMASK 0xFFFFFFFFu
#endif
#define SM(b) ((SUBMASK >> (b)) & 1u)
#ifndef REPMASK
#define REPMASK 0u
#endif
#ifndef SUBREP
#define SUBREP 0u
#endif
#define REP(k) ((int)((REPMASK >> (k)) & 1u))
#define SREP(k) ((int)((SUBREP >> (k)) & 1u))
#ifndef MK_SPLIT
#define MK_SPLIT 0
#endif

constexpr int D = 1024, NB = 8, SEQ = 2048, MP = NB * SEQ, MS = 128, MT = MP + MS, MTP = MP + 256, DEPTH = 4;
constexpr int NPROJ = 9216, INW = 9224;
constexpr int C_Q = 0, C_K = 1024, C_V = 2048, C_O = 3072, C_U = 4096, C_XQ = 5120, C_G = 6144;
constexpr int FF = 2816, FF2 = 5632, NMEM = 256, HD = 256, NH = 4;
constexpr float LN_EPS = 1e-5f;
constexpr float ALPHA = 1.681792830507429f;
constexpr int PAST_LEN = 16384;

constexpr size_t O_YP = 0, O_YS = 16777216, O_PC = 16908288, O_PN = 25296896, O_PM = 25329664, O_PPOOL = 25329792, O_PCONV = 25821312,
                 O_PMK = 26181760, O_PMV = 34570368, O_SC = 42958976, O_SN = 177176704, O_SM = 177700992, O_SPOOL = 177703040, O_SCONV = 185567360, O_END = 191334528;

constexpr size_t al256(size_t x) { return (x + 255) & ~(size_t)255; }
constexpr size_t WS_CTL = 0, CTL_BYTES = 2u << 20;
constexpr size_t WS_WIN = CTL_BYTES;                                        constexpr size_t SZ_WIN = (size_t)NPROJ * D * 2;
constexpr size_t WS_WM = WS_WIN + DEPTH * SZ_WIN;                           constexpr size_t SZ_W1K = (size_t)D * D * 2;
constexpr size_t WS_WX = WS_WM + DEPTH * SZ_W1K;
constexpr size_t WS_WO = WS_WX + DEPTH * SZ_W1K;
constexpr size_t WS_WP = WS_WO + DEPTH * SZ_W1K;                            constexpr size_t SZ_WP = (size_t)D * D * 2;
constexpr size_t WS_WKV = WS_WP + DEPTH * SZ_WP;                            constexpr size_t SZ_WKV = (size_t)2048 * D * 2;
constexpr size_t WS_WUP = WS_WKV + DEPTH * SZ_WKV;                          constexpr size_t SZ_WUP = (size_t)FF2 * D * 2;
constexpr size_t WS_WDN = WS_WUP + DEPTH * SZ_WUP;                          constexpr size_t SZ_WDN = (size_t)D * FF * 2;
constexpr size_t WS_X = al256(WS_WDN + DEPTH * SZ_WDN);
constexpr size_t WS_T = WS_X + (size_t)MTP * D * 4;
constexpr size_t WS_MIX = WS_T + (size_t)MTP * D * 4;
constexpr size_t WS_XN = WS_MIX + (size_t)MTP * D * 4;
constexpr size_t WS_PROJ = WS_XN + (size_t)MTP * D * 2;
constexpr size_t WS_HC = WS_PROJ + (size_t)MTP * NPROJ * 2;
constexpr size_t WS_HN = WS_HC + (size_t)MTP * D * 2;
constexpr size_t WS_DP = WS_HN + (size_t)MTP * D * 2;
constexpr size_t WS_PB = WS_DP + (size_t)MTP * D * 2;
constexpr size_t WS_OX = WS_PB + (size_t)MTP * D * 2;
constexpr size_t WS_MIXB = WS_OX + (size_t)MTP * D * 2;
constexpr size_t WS_HUP = WS_MIXB + (size_t)MTP * D * 2;
constexpr size_t WS_ACT = WS_HUP + (size_t)MTP * FF2 * 2;
constexpr size_t WS_IGFG = WS_ACT + (size_t)MTP * FF * 2;
constexpr size_t WS_MEMB = WS_IGFG + (size_t)MTP * 8 * 4;
constexpr size_t WS_MK = WS_MEMB + (size_t)2048 * D * 2;
constexpr size_t WS_MVT = WS_MK + (size_t)DEPTH * 2048 * D * 2;
constexpr size_t WS_PT = WS_MVT + (size_t)DEPTH * 2048 * D * 2;
constexpr size_t WS_KWT = WS_PT + (size_t)32 * 32 * 4096 * 2;
constexpr size_t WS_VTT = WS_KWT + (size_t)32 * 32 * 16384 * 2;
constexpr size_t WS_GT = WS_VTT + (size_t)32 * 32 * 16384 * 2;
constexpr size_t WS_XQ = WS_GT + (size_t)32 * 32 * 192 * 4;
constexpr size_t WS_HALO = WS_XQ + (size_t)MTP * D * 2;
constexpr size_t WS_END = WS_HALO + (size_t)64 * 4 * FF2 * 4;
static_assert(WS_END <= 2147483648ull, "workspace map exceeds 2 GiB");
constexpr int CW_BAR = 4096, CW_QUEUE = 1024;

constexpr int LDS_BYTES = 147456;
constexpr int XCH_OFF = 131072;
constexpr int MISC_OFF = LDS_BYTES - 256;

DI float bf2f(unsigned v) { return __uint_as_float(v << 16); }
DI unsigned f2bf(float f) { unsigned u = __float_as_uint(f); return (u + 0x7fffu + ((u >> 16) & 1u)) >> 16; }
DI unsigned pk2(float lo, float hi) { return f2bf(lo) | (f2bf(hi) << 16); }
DI float lo16(unsigned w) { return __uint_as_float(w << 16); }
DI float hi16(unsigned w) { return __uint_as_float(w & 0xffff0000u); }
DI float sigmoid_fast(float x) { return __builtin_amdgcn_rcpf(1.0f + __expf(-x)); }
DI float wave_sum(float v) {
#pragma unroll
    for (int o = 1; o < 64; o <<= 1) v += __shfl_xor(v, o);
    return v;
}
DI void unpack8(const u32x4 w, float (&f)[8]) { f[0] = lo16(w.x); f[1] = hi16(w.x); f[2] = lo16(w.y); f[3] = hi16(w.y); f[4] = lo16(w.z); f[5] = hi16(w.z); f[6] = lo16(w.w); f[7] = hi16(w.w); }
DI int opaque_tid() { int t = threadIdx.x; asm volatile("" : "+v"(t)); return t; }
#define LDS_WAIT() asm volatile("s_waitcnt lgkmcnt(0)" ::: "memory")
#define VM_WAIT() asm volatile("s_waitcnt vmcnt(0)" ::: "memory")

namespace pg8 {
constexpr int BM = 256, BK = 64, HALF = 128, HTB = HALF * BK * 2, STAGE_BYTES = 8 * HTB, NXCD = 8, WGM = 8;
__host__ __device__ __forceinline__ int lds_byte(int r, int c) { const int st = (r >> 4) * 2 + (c >> 5), rr = r & 15, cc = c & 31, ob = rr * 64 + cc * 2; return st * 1024 + (ob ^ (((ob >> 9) & 1) << 5)); }
__host__ __device__ __forceinline__ void stage_rc(int b, int& R, int& C) { const int st = b / 1024, sb = b % 1024, swz = sb ^ (((sb >> 9) & 1) << 5); R = (st >> 1) * 16 + swz / 64; C = (st & 1) * 32 + (swz % 64) / 2; }

struct Unit { const char* a; const char* b; int pm, pn, nt, aux; };

struct OrderMN {
    int nM, nN, nwg, G, c; const char* A; const char* Bt; size_t astep, bstep, apn;
    DI void init(const bf16* A_, int lda, const bf16* Bt_, int ldb, int M, int N, int G_, int c_, int apn_ = 0) { nM = M / BM; nN = N / BM; nwg = nM * nN; G = G_; c = c_; A = (const char*)A_; Bt = (const char*)Bt_; astep = (size_t)BM * lda * 2; bstep = (size_t)BM * ldb * 2; apn = (size_t)apn_; }
    DI bool next(int i, Unit& u) const {
        const long L = (long)i * G + c; if (L >= nwg) return false;
        int wgid = (int)L; { const int q = nwg / NXCD, r = nwg % NXCD, xcd = wgid % NXCD, off = wgid / NXCD; wgid = (xcd < r ? xcd * (q + 1) : r * (q + 1) + (xcd - r) * q) + off; }
        const int nig = WGM * nN, gid = wgid / nig, fm = gid * WGM, gsz = (nM - fm) < WGM ? (nM - fm) : WGM;
        u.pm = fm + ((wgid % nig) % gsz); u.pn = (wgid % nig) / gsz; u.a = A + (size_t)u.pm * astep + (size_t)u.pn * apn; u.b = Bt + (size_t)u.pn * bstep; return true;
    }
};

template <class Epi, class Sched>
DI void gemm_phase(LAS unsigned char* lds, const int K, const int lda, const int ldb, const Sched& S, const Epi& E) {
    const int tid = opaque_tid(), wid = __builtin_amdgcn_readfirstlane(tid >> 6), lane = tid & 63, wr = wid >> 2, wc = wid & 3, fr = lane & 15, fq = lane >> 4;
    const int nt = K / BK;
    unsigned voffA[2], voffB[2];
#pragma unroll
    for (int i = 0; i < 2; ++i) { int R, C; stage_rc(tid * 16 + i * 8192, R, C); voffA[i] = (unsigned)(R * lda + C) * 2u; voffB[i] = (unsigned)(R * ldb + C) * 2u; }
    const size_t kstep = (size_t)(BK * 2);
    const size_t hstepA = (size_t)HALF * lda * 2, hstepB = (size_t)HALF * ldb * 2;
    const unsigned ldsw = (unsigned)wid * 1024u;
    const int aoff = lds_byte(wr * 64 + fr, fq * 8), boff = lds_byte(wc * 32 + fr, fq * 8);
#define PG8_SA(b, h) (((b) * 2 + (h)) * HTB)
#define PG8_SB(b, h) ((4 + (b) * 2 + (h)) * HTB)
#define PG8_STAGE(bufoff, gbase, voff) do { _Pragma("unroll") for (int _i = 0; _i < 2; ++_i) \
        __builtin_amdgcn_global_load_lds((const unsigned*)((const char*)(gbase) + (voff)[_i]), (LAS unsigned*)(lds + (bufoff) + ldsw + _i * 8192), 16, 0, 0); } while (0)
#define PG8_LDA(dst, b, h) do { _Pragma("unroll") for (int m = 0; m < 4; ++m) _Pragma("unroll") for (int k = 0; k < 2; ++k) dst[m][k] = *(const LAS bf16x8*)(lds + PG8_SA(b, h) + aoff + m * 2048 + k * 1024); } while (0)
#define PG8_LDB(dst, b, h) do { _Pragma("unroll") for (int n = 0; n < 2; ++n) _Pragma("unroll") for (int k = 0; k < 2; ++k) dst[n][k] = *(const LAS bf16x8*)(lds + PG8_SB(b, h) + boff + n * 2048 + k * 1024); } while (0)
#define PG8_MMA(ai, bj, At, Bt) do { __builtin_amdgcn_s_setprio(1); _Pragma("unroll") for (int m = 0; m < 4; ++m) _Pragma("unroll") for (int n = 0; n < 2; ++n) _Pragma("unroll") for (int k = 0; k < 2; ++k) \
        acc[ai][bj][m][n] = __builtin_amdgcn_mfma_f32_16x16x32_bf16(Bt[n][k], At[m][k], acc[ai][bj][m][n], 0, 0, 0); __builtin_amdgcn_s_setprio(0); } while (0)
#define PG8_WAIT_V(n) asm volatile("s_waitcnt vmcnt(" #n ")" ::: "memory")
#define PG8_WAIT_L(n) asm volatile("s_waitcnt lgkmcnt(" #n ")" ::: "memory")
#define PG8_BAR __builtin_amdgcn_s_barrier()
#define PG8_SCHED __builtin_amdgcn_sched_barrier(0)
    Unit cur, nxt; int ui = 0; cur.nt = 0; cur.aux = 0;
    if (!S.next(0, cur)) return;
    f32x4 acc[2][2][4][2];
    E.init(acc, cur, wr, wc, fr, fq);
    bf16x8 At[4][2], B0[2][2], B1[2][2];
    const char* cA = cur.a; const char* cB = cur.b;
    PG8_STAGE(PG8_SB(0, 0), cB, voffB); PG8_STAGE(PG8_SB(0, 1), cB + hstepB, voffB); PG8_STAGE(PG8_SA(0, 0), cA, voffA); PG8_STAGE(PG8_SA(0, 1), cA + hstepA, voffA);
    if (wr == 1) PG8_BAR;
    PG8_WAIT_V(2); PG8_BAR;
    PG8_STAGE(PG8_SB(1, 0), cB + kstep, voffB); PG8_STAGE(PG8_SA(1, 0), cA + kstep, voffA); PG8_STAGE(PG8_SB(1, 1), cB + hstepB + kstep, voffB);
    PG8_WAIT_V(6); PG8_BAR;
    for (;;) {
        nxt.nt = 0; nxt.aux = 0;
        const bool has_next = S.next(ui + 1, nxt);
        const int cnt = cur.nt ? cur.nt : nt;
        const char* nA = has_next ? nxt.a : cA; const char* nB = has_next ? nxt.b : cB;
#pragma unroll 1
        for (int t = 0; t < cnt; t += 2) {
            const bool last = (t == cnt - 2);
            const char* a1 = cA + (size_t)(t + 1) * kstep;
            const char* a2 = last ? nA : cA + (size_t)(t + 2) * kstep; const char* b2 = last ? nB : cB + (size_t)(t + 2) * kstep;
            const char* a3 = a2 + kstep; const char* b3 = b2 + kstep;
            PG8_LDB(B0, 0, 0); PG8_LDB(B1, 0, 1); PG8_SCHED; PG8_LDA(At, 0, 0); PG8_STAGE(PG8_SA(1, 1), a1 + hstepA, voffA);
            PG8_WAIT_V(8); PG8_WAIT_L(0); PG8_BAR; PG8_MMA(0, 0, At, B0); PG8_MMA(0, 1, At, B1); PG8_BAR; PG8_SCHED;
            PG8_LDA(At, 0, 1); PG8_STAGE(PG8_SB(0, 0), b2, voffB); PG8_STAGE(PG8_SB(0, 1), b2 + hstepB, voffB); PG8_STAGE(PG8_SA(0, 0), a2, voffA);
            PG8_WAIT_V(8); PG8_WAIT_L(0); PG8_BAR; PG8_MMA(1, 0, At, B0); PG8_MMA(1, 1, At, B1); PG8_BAR; PG8_SCHED;
            PG8_LDB(B0, 1, 0); PG8_LDB(B1, 1, 1); PG8_SCHED; PG8_LDA(At, 1, 0); PG8_STAGE(PG8_SA(0, 1), a2 + hstepA, voffA);
            PG8_WAIT_V(8); PG8_WAIT_L(0); PG8_BAR; PG8_MMA(0, 0, At, B0); PG8_MMA(0, 1, At, B1); PG8_BAR; PG8_SCHED;
            PG8_LDA(At, 1, 1); PG8_STAGE(PG8_SB(1, 0), b3, voffB); PG8_STAGE(PG8_SB(1, 1), b3 + hstepB, voffB); PG8_STAGE(PG8_SA(1, 0), a3, voffA);
            PG8_WAIT_V(8); PG8_WAIT_L(0); PG8_BAR; PG8_MMA(1, 0, At, B0); PG8_MMA(1, 1, At, B1); PG8_BAR; PG8_SCHED;
        }
        if (wr == 0) PG8_BAR;
        E(acc, cur, wr, wc, fr, fq);
        if (!has_next) break;
        if (!E.keep(cur)) E.init(acc, nxt, wr, wc, fr, fq);
        cur = nxt; cA = nA; cB = nB; ++ui;
        if (wr == 1) PG8_BAR;
    }
    PG8_WAIT_V(0);
    PG8_BAR;
#undef PG8_SA
#undef PG8_SB
#undef PG8_STAGE
#undef PG8_LDA
#undef PG8_LDB
#undef PG8_MMA
#undef PG8_WAIT_V
#undef PG8_WAIT_L
#undef PG8_BAR
#undef PG8_SCHED
}

DI void acc_zero(f32x4 (&acc)[2][2][4][2]) {
#pragma unroll
    for (int a = 0; a < 2; ++a)
#pragma unroll
        for (int b = 0; b < 2; ++b)
#pragma unroll
            for (int m = 0; m < 4; ++m)
#pragma unroll
                for (int n = 0; n < 2; ++n) acc[a][b][m][n] = (f32x4){0.f, 0.f, 0.f, 0.f};
}
template <class GE> struct EpiGran {
    GE g;
    DI bool keep(const Unit&) const { return false; }
    DI void init(f32x4 (&acc)[2][2][4][2], const Unit& u, int wr, int wc, int fr, int fq) const { g.init(acc, u, wr, wc, fr, fq); }
    DI void operator()(f32x4 (&acc)[2][2][4][2], const Unit& u, int wr, int wc, int fr, int fq) const {
        const int row0 = u.pm * BM + wr * 64 + fr, col0 = u.pn * BM + wc * 32 + 4 * fq;
#pragma unroll
        for (int ai = 0; ai < 2; ++ai)
#pragma unroll
            for (int m = 0; m < 4; ++m)
#pragma unroll
                for (int bj = 0; bj < 2; ++bj)
#pragma unroll
                    for (int n = 0; n < 2; ++n) g(row0 + ai * HALF + m * 16, col0 + bj * HALF + n * 16, acc[ai][bj][m][n]);
    }
};
}

#define XB_TMO      128
#define XB_XCNT(j)  (256  + 64 * (j))
#define XB_XSUB(j)  (1280 + 64 * (j))
#define XB_XGEN(j)  (2304 + 64 * (j))
#define XB_TOP      3328
#define XB_TOPGEN   3392
#define XCD_BAR_WORDS 3456
#define XB_SPIN_CAP (1u << 22)
DI unsigned xb_ld(unsigned* p)              { return __hip_atomic_load(p, __ATOMIC_RELAXED, __HIP_MEMORY_SCOPE_AGENT); }
DI unsigned xb_add(unsigned* p, unsigned v) { return __hip_atomic_fetch_add(p, v, __ATOMIC_RELAXED, __HIP_MEMORY_SCOPE_AGENT); }
DI unsigned xb_xcc_id() { return (unsigned)__builtin_amdgcn_s_getreg((3 << 11) | 20) & 0xFu; }
#define XB_SPIN(cond, bar) do { unsigned _sp = 0; while (cond) { __builtin_amdgcn_s_sleep(1); \
    if ((++_sp & 255u) == 0u) { if (xb_ld(&(bar)[XB_TMO])) break; if (_sp > XB_SPIN_CAP) { atomicAdd(&(bar)[XB_TMO], 1u); break; } } } } while (0)
struct XcdBarrier { unsigned* bar; unsigned x; volatile LAS unsigned* st; };
DI XcdBarrier xcd_barrier_post(unsigned* bar, volatile LAS unsigned* st) {
    XcdBarrier b; b.bar = bar; b.x = xb_xcc_id(); b.st = st;
    if (threadIdx.x == 0) (void)xb_add(&bar[XB_XCNT(b.x)], 1u);
    return b;
}
DI void xcd_barrier_complete(unsigned* bar, unsigned x, unsigned& nloc, unsigned& nx) {
    const unsigned G = gridDim.x * gridDim.y * gridDim.z;
    unsigned sum, cnt, mine, sp = 0u;
    for (;;) {
        sum = 0u; cnt = 0u; mine = 0u;
#pragma unroll
        for (unsigned j = 0; j < 16; ++j) { const unsigned c = xb_ld(&bar[XB_XCNT(j)]); sum += c; cnt += (c > 0u) ? 1u : 0u; mine = (j == x) ? c : mine; }
        if (sum == G) break;
        __builtin_amdgcn_s_sleep(1);
        if ((++sp & 255u) == 0u) { if (xb_ld(&bar[XB_TMO])) break; if (sp > XB_SPIN_CAP) { atomicAdd(&bar[XB_TMO], 1u); break; } }
    }
    nloc = mine > 0u ? mine : 1u; nx = cnt > 0u ? cnt : 1u;
}
DI void xcd_barrier(const XcdBarrier& b) {
    asm volatile("s_waitcnt vmcnt(0)" ::: "memory");
    __syncthreads();
    if (threadIdx.x == 0) {
        unsigned* bar = b.bar;
        __builtin_amdgcn_s_waitcnt(0);
        unsigned nloc = b.st[0], nx = b.st[1];
        if (nloc == 0u) { xcd_barrier_complete(bar, b.x, nloc, nx); b.st[0] = nloc; b.st[1] = nx; }
        const unsigned old = xb_add(&bar[XB_XSUB(b.x)], 1u);
        const unsigned gen = old / nloc;
        if (old + 1u == (gen + 1u) * nloc) {
            __builtin_amdgcn_fence(__ATOMIC_RELEASE, "agent");
            asm volatile("s_waitcnt vmcnt(0)" ::: "memory");
            const unsigned og = xb_add(&bar[XB_TOP], 1u);
            const unsigned tg = og / nx;
            if (og + 1u == (tg + 1u) * nx) xb_add(&bar[XB_TOPGEN], 1u);
            else XB_SPIN(xb_ld(&bar[XB_TOPGEN]) == tg, bar);
            __builtin_amdgcn_fence(__ATOMIC_ACQUIRE, "agent");
            xb_add(&bar[XB_XGEN(b.x)], 1u);
            asm volatile("s_waitcnt vmcnt(0)" ::: "memory");
        } else {
            XB_SPIN(xb_ld(&bar[XB_XGEN(b.x)]) == gen, bar);
            __builtin_amdgcn_fence(__ATOMIC_ACQUIRE, "agent");
            asm volatile("s_waitcnt vmcnt(0)" ::: "memory");
        }
    }
    __syncthreads();
}

typedef const GAS float* fptr_t;
typedef const __attribute__((address_space(4))) fptr_t* in_tab_t;
struct Frame {
    LAS unsigned char* lds;
    int vcu, G;
    in_tab_t in; float* out; unsigned char* ws;
};
#define PHASE_BEGIN(F) Frame F = F0; int bx = bx0; { unsigned long long _a = (unsigned long long)F0.in, _b = (unsigned long long)F0.out, _c = (unsigned long long)F0.ws; int _g = F0.G, _v = F0.vcu; \
    asm volatile("" : "+s"(_a), "+s"(_b), "+s"(_c), "+s"(_g), "+s"(_v), "+s"(bx)); \
    F.in = (in_tab_t)_a; F.out = (float*)(GAS float*)_b; F.ws = (unsigned char*)(GAS unsigned char*)_c; F.G = _g; F.vcu = _v; }
#define WSP(T, off) ((T*)(F.ws + (off)))

struct GeIn {
    bf16* proj; const float* bias; bf16* xqb; bool pre;
    DI void init(f32x4 (&acc)[2][2][4][2], const pg8::Unit& u, int wr, int wc, int fr, int fq) const {
#pragma unroll
        for (int bj = 0; bj < 2; ++bj)
#pragma unroll
            for (int n = 0; n < 2; ++n) { const int col = u.pn * 256 + wc * 32 + 4 * fq + bj * 128 + n * 16; const f32x4 bv = *(const f32x4*)(bias + col + (col >= 4096 ? 8 : 0));
#pragma unroll
                for (int ai = 0; ai < 2; ++ai)
#pragma unroll
                    for (int m = 0; m < 4; ++m) acc[ai][bj][m][n] = bv; }
    }
    DI void operator()(int row, int col, const f32x4& a) const {
        f32x4 v = a + (pre ? (f32x4){0.f, 0.f, 0.f, 0.f} : *(const f32x4*)(bias + col + (col >= 4096 ? 8 : 0)));
        const bool sg = (col >= C_O && col < C_U) || col >= C_G;
        if (sg) { v.x = sigmoid_fast(v.x); v.y = sigmoid_fast(v.y); v.z = sigmoid_fast(v.z); v.w = sigmoid_fast(v.w); }
        u32x2 w; w.x = pk2(v.x, v.y); w.y = pk2(v.z, v.w);
        if (col >= C_XQ && col < C_G) *(u32x2*)(xqb + (size_t)row * D + (col - C_XQ)) = w;
        else *(u32x2*)(proj + (size_t)row * NPROJ + col) = w;
    }
};
struct GeKV {
    float* out; bf16* mk; bf16* mvt;
    DI void init(f32x4 (&acc)[2][2][4][2], const pg8::Unit&, int, int, int, int) const { pg8::acc_zero(acc); }
    DI void operator()(int row, int col, const f32x4& a) const {
        const int l = col >> 11, c = col & 2047;
        if (c < 1024) {
            *(f32x4*)(out + O_PMK + ((size_t)l * 2048 + row) * 1024 + c) = a;
            u32x2 w; w.x = pk2(a.x, a.y); w.y = pk2(a.z, a.w);
            *(u32x2*)(mk + ((size_t)l * 2048 + row) * 1024 + c) = w;
        } else {
            const int cc = c - 1024;
            *(f32x4*)(out + O_PMV + ((size_t)l * 2048 + row) * 1024 + cc) = a;
            bf16* t = mvt + ((size_t)l * 1024 + cc) * 2048 + row;
            t[0] = (bf16)f2bf(a.x); t[2048] = (bf16)f2bf(a.y); t[4096] = (bf16)f2bf(a.z); t[6144] = (bf16)f2bf(a.w);
        }
    }
};
struct GeBf16 {
    bf16* o; int ldc;
    DI void init(f32x4 (&acc)[2][2][4][2], const pg8::Unit&, int, int, int, int) const { pg8::acc_zero(acc); }
    DI void operator()(int row, int col, const f32x4& a) const { u32x2 w; w.x = pk2(a.x, a.y); w.y = pk2(a.z, a.w); *(u32x2*)(o + (size_t)row * ldc + col) = w; }
};
template <int MODE> struct GeMix {
    float* mix; bf16* mixb; const bf16* proj; const float* ps;
    DI void init(f32x4 (&acc)[2][2][4][2], const pg8::Unit&, int, int, int, int) const { pg8::acc_zero(acc); }
    DI void operator()(int row, int col, const f32x4& a) const {
        const u32x2 gw = *(const u32x2*)(proj + (size_t)row * NPROJ + C_G + MODE * 1024 + col);
        const f32x4 g = (f32x4){lo16(gw.x), hi16(gw.x), lo16(gw.y), hi16(gw.y)};
        float* mp = mix + (size_t)row * D + col;
        if (MODE == 0) { *(f32x4*)mp = g * a; }
        else if (MODE == 1) { const f32x4 s = *(const f32x4*)(ps + col); *(f32x4*)mp = *(const f32x4*)mp + g * s * a; }
        else { const f32x4 v = *(const f32x4*)mp + g * a; u32x2 w; w.x = pk2(v.x, v.y); w.y = pk2(v.z, v.w); *(u32x2*)(mixb + (size_t)row * D + col) = w; }
    }
};
struct GeRes {
    const float* x; float* t; bool pre;
    DI void init(f32x4 (&acc)[2][2][4][2], const pg8::Unit& u, int wr, int wc, int fr, int fq) const {
        const int row0 = u.pm * 256 + wr * 64 + fr, col0 = u.pn * 256 + wc * 32 + 4 * fq;
#pragma unroll
        for (int ai = 0; ai < 2; ++ai)
#pragma unroll
            for (int m = 0; m < 4; ++m)
#pragma unroll
                for (int bj = 0; bj < 2; ++bj)
#pragma unroll
                    for (int n = 0; n < 2; ++n) acc[ai][bj][m][n] = *(const f32x4*)(x + (size_t)(row0 + ai * 128 + m * 16) * D + col0 + bj * 128 + n * 16) * ALPHA;
    }
    DI void operator()(int row, int col, const f32x4& a) const { const size_t o = (size_t)row * D + col; *(f32x4*)(t + o) = pre ? a : *(const f32x4*)(x + o) * ALPHA + a; }
};

struct EpiSoftmax {
    bf16* P; LAS float* X;
    DI bool keep(const pg8::Unit&) const { return false; }
    DI void init(f32x4 (&acc)[2][2][4][2], const pg8::Unit&, int, int, int, int) const { pg8::acc_zero(acc); }
    DI void operator()(f32x4 (&acc)[2][2][4][2], const pg8::Unit& u, int wr, int wc, int fr, int fq) const {
        const float sc = 0.0625f * 1.4426950408889634f;
        LAS float* XM = X; LAS float* XS = X + 1024;
#pragma unroll
        for (int ai = 0; ai < 2; ++ai)
#pragma unroll
            for (int m = 0; m < 4; ++m) {
                float v = -3.0e38f;
#pragma unroll
                for (int bj = 0; bj < 2; ++bj)
#pragma unroll
                    for (int n = 0; n < 2; ++n) { const f32x4 x = acc[ai][bj][m][n]; v = fmaxf(v, fmaxf(fmaxf(x.x, x.y), fmaxf(x.z, x.w))); }
                v = fmaxf(v, __shfl_xor(v, 16)); v = fmaxf(v, __shfl_xor(v, 32));
                if (fq == 0) XM[(ai * 128 + wr * 64 + m * 16 + fr) * 4 + wc] = v;
            }
        LDS_WAIT(); __builtin_amdgcn_s_barrier(); asm volatile("" ::: "memory");
#pragma unroll
        for (int ai = 0; ai < 2; ++ai)
#pragma unroll
            for (int m = 0; m < 4; ++m) {
                const int r = ai * 128 + wr * 64 + m * 16 + fr;
                const f32x4 mm = *(const LAS f32x4*)(XM + r * 4);
                const float mx = fmaxf(fmaxf(mm.x, mm.y), fmaxf(mm.z, mm.w)) * sc;
                float s = 0.f;
#pragma unroll
                for (int bj = 0; bj < 2; ++bj)
#pragma unroll
                    for (int n = 0; n < 2; ++n) { f32x4 x = acc[ai][bj][m][n];
                        x.x = __builtin_amdgcn_exp2f(x.x * sc - mx); x.y = __builtin_amdgcn_exp2f(x.y * sc - mx); x.z = __builtin_amdgcn_exp2f(x.z * sc - mx); x.w = __builtin_amdgcn_exp2f(x.w * sc - mx);
                        acc[ai][bj][m][n] = x; s += (x.x + x.y) + (x.z + x.w); }
                s += __shfl_xor(s, 16); s += __shfl_xor(s, 32);
                if (fq == 0) XS[r * 4 + wc] = s;
                asm volatile("" ::: "memory");
            }
        LDS_WAIT(); __builtin_amdgcn_s_barrier(); asm volatile("" ::: "memory");
#pragma unroll
        for (int ai = 0; ai < 2; ++ai)
#pragma unroll
            for (int m = 0; m < 4; ++m) {
                const int r = ai * 128 + wr * 64 + m * 16 + fr;
                const f32x4 ss = *(const LAS f32x4*)(XS + r * 4);
                const float inv = 1.0f / ((ss.x + ss.y) + (ss.z + ss.w));
                bf16* rowp = P + (size_t)(u.pm * 256 + r) * D + u.pn * 256 + wc * 32 + 4 * fq;
#pragma unroll
                for (int bj = 0; bj < 2; ++bj)
#pragma unroll
                    for (int n = 0; n < 2; ++n) { const f32x4 x = acc[ai][bj][m][n] * inv; u32x2 w; w.x = pk2(x.x, x.y); w.y = pk2(x.z, x.w); *(u32x2*)(rowp + bj * 128 + n * 16) = w; }
                asm volatile("" ::: "memory");
            }
        LDS_WAIT(); __builtin_amdgcn_s_barrier(); asm volatile("" ::: "memory");
    }
};

#define ROR_F(x, n) __builtin_bit_cast(float, __builtin_amdgcn_update_dpp(0, __builtin_bit_cast(int, (float)(x)), 0x120 + (n), 0xf, 0xf, false))
DI float gelu_tanh(float x) { return x * sigmoid_fast(1.5957691216057308f * (x + 0.044715f * x * x * x)); }
struct EpiConv {
    DI bool keep(const pg8::Unit&) const { return false; }
    DI void init(f32x4 (&acc)[2][2][4][2], const pg8::Unit&, int, int, int, int) const { pg8::acc_zero(acc); }
    bf16* act; float* halo; float* out; const float* cw; const float* cb; LAS float* X; int l;
    DI void operator()(f32x4 (&acc)[2][2][4][2], const pg8::Unit& u, int wr, int wc, int fr, int fq) const {
        if (fr >= 14) {
#pragma unroll
            for (int ai = 0; ai < 2; ++ai)
#pragma unroll
                for (int bj = 0; bj < 2; ++bj)
#pragma unroll
                    for (int n = 0; n < 2; ++n) *(LAS f32x4*)(X + (((ai * 2 + wr) * 2 + (fr - 14)) * 256 + bj * 128 + wc * 32 + n * 16 + fq * 4)) = acc[ai][bj][3][n];
        }
        LDS_WAIT(); __builtin_amdgcn_s_barrier(); asm volatile("" ::: "memory");
        if (wr == 0 && fr < 2) {
#pragma unroll
            for (int h = 0; h < 2; ++h)
#pragma unroll
                for (int n = 0; n < 2; ++n) *(f32x4*)(halo + ((size_t)u.pm * 4 + fr) * FF2 + h * FF + u.pn * 128 + wc * 32 + n * 16 + fq * 4) = acc[0][h][0][n];
        }
        if (wr == 1 && fr >= 14) {
#pragma unroll
            for (int h = 0; h < 2; ++h)
#pragma unroll
                for (int n = 0; n < 2; ++n) { const int ca = u.pn * 128 + wc * 32 + n * 16 + fq * 4;
                    *(f32x4*)(halo + ((size_t)u.pm * 4 + 2 + (fr - 14)) * FF2 + h * FF + ca) = acc[1][h][3][n];
                    if ((u.pm & 7) == 7) *(f32x4*)(out + O_PCONV + ((size_t)(l * NB + (u.pm >> 3)) * 2 + (fr - 14)) * FF2 + h * FF + ca) = acc[1][h][3][n]; }
        }
        const bool p1own = fr >= 1, p2own = fr >= 2;
#pragma unroll
        for (int n = 0; n < 2; ++n) {
            asm volatile("" ::: "memory");
            const int ca = u.pn * 128 + wc * 32 + n * 16 + fq * 4;
            f32x4 w[2][3], bsv[2];
#pragma unroll
            for (int h = 0; h < 2; ++h) {
#pragma unroll
                for (int i = 0; i < 3; ++i) w[h][i] = *(const f32x4*)(cw + (size_t)i * FF2 + h * FF + ca);
                bsv[h] = *(const f32x4*)(cb + h * FF + ca); }
            bf16* ap = act + (size_t)(u.pm * 256 + wr * 64 + fr) * FF + ca;
#pragma unroll
            for (int ai = 0; ai < 2; ++ai)
#pragma unroll
                for (int m = 3; m >= 0; --m) {
                    f32x4 c[2];
#pragma unroll
                    for (int h = 0; h < 2; ++h) {
                        const f32x4 cur = acc[ai][h][m][n];
                        f32x4 g;
                        if (m > 0) g = acc[ai][h][m - 1][n];
                        else { g = (f32x4){0.f, 0.f, 0.f, 0.f};
                            if (fr >= 14 && (wr == 1 || ai == 1)) { const int sa = (wr == 1) ? ai : 0, sw = (wr == 1) ? 0 : 1; g = *(const LAS f32x4*)(X + (((sa * 2 + sw) * 2 + (fr - 14)) * 256 + h * 128 + wc * 32 + n * 16 + fq * 4)); } }
                        f32x4 p1, p2;
#pragma unroll
                        for (int j = 0; j < 4; ++j) { const float a1 = ROR_F(cur[j], 1), b1 = ROR_F(g[j], 1), a2 = ROR_F(cur[j], 2), b2 = ROR_F(g[j], 2); p1[j] = p1own ? a1 : b1; p2[j] = p2own ? a2 : b2; }
                        c[h] = p2 * w[h][0] + p1 * w[h][1] + cur * w[h][2] + bsv[h];
                    }
                    const f32x4 o = (f32x4){gelu_tanh(c[0].x) * c[1].x, gelu_tanh(c[0].y) * c[1].y, gelu_tanh(c[0].z) * c[1].z, gelu_tanh(c[0].w) * c[1].w};
                    u32x2 wv; wv.x = pk2(o.x, o.y); wv.y = pk2(o.z, o.w);
                    *(u32x2*)(ap + (size_t)(ai * 128 + m * 16) * FF) = wv;
                }
        }
        LDS_WAIT(); __builtin_amdgcn_s_barrier(); asm volatile("" ::: "memory");
    }
};
DI void conv_fixup(Frame& F, int l, int pm) {
    const float* halo = WSP(float, WS_HALO); bf16* act = WSP(bf16, WS_ACT);
    const float* cw = ((const float*)F.in[24]) + (size_t)l * 3 * FF2; const float* cb = ((const float*)F.in[25]) + (size_t)l * FF2;
    const bool first = (pm & 7) == 0;
    for (int it = opaque_tid(); it < FF / 4; it += 512) {
        const int ca = it * 4; f32x4 c0[2], c1[2];
#pragma unroll
        for (int h = 0; h < 2; ++h) {
            const size_t co = (size_t)h * FF + ca;
            const f32x4 r0 = *(const f32x4*)(halo + ((size_t)pm * 4 + 0) * FF2 + co), r1 = *(const f32x4*)(halo + ((size_t)pm * 4 + 1) * FF2 + co);
            f32x4 q2 = (f32x4){0.f, 0.f, 0.f, 0.f}, q1 = q2;
            if (!first) { q2 = *(const f32x4*)(halo + ((size_t)(pm - 1) * 4 + 2) * FF2 + co); q1 = *(const f32x4*)(halo + ((size_t)(pm - 1) * 4 + 3) * FF2 + co); }
            const f32x4 w0 = *(const f32x4*)(cw + co), w1 = *(const f32x4*)(cw + FF2 + co), w2 = *(const f32x4*)(cw + 2 * FF2 + co), bv = *(const f32x4*)(cb + co);
            c0[h] = q2 * w0 + q1 * w1 + r0 * w2 + bv; c1[h] = q1 * w0 + r0 * w1 + r1 * w2 + bv; }
        u32x2 wv; wv.x = pk2(gelu_tanh(c0[0].x) * c0[1].x, gelu_tanh(c0[0].y) * c0[1].y); wv.y = pk2(gelu_tanh(c0[0].z) * c0[1].z, gelu_tanh(c0[0].w) * c0[1].w);
        *(u32x2*)(act + (size_t)(pm * 256) * FF + ca) = wv;
        wv.x = pk2(gelu_tanh(c1[0].x) * c1[1].x, gelu_tanh(c1[0].y) * c1[1].y); wv.y = pk2(gelu_tanh(c1[0].z) * c1[1].z, gelu_tanh(c1[0].w) * c1[1].w);
        *(u32x2*)(act + (size_t)(pm * 256 + 1) * FF + ca) = wv;
    }
}
DI void skinny_up_conv(Frame& F, int l, const bf16* W, int j0, int jstride) {
    const int tid = opaque_tid(), lane = tid & 63, wid = __builtin_amdgcn_readfirstlane(tid >> 6), fr = lane & 15, fq = lane >> 4, b = wid * 16 + fr;
    const bf16* ap = WSP(bf16, WS_XN) + (size_t)(MP + b) * D + fq * 8;
    const float* cw = ((const float*)F.in[24]) + (size_t)l * 3 * FF2; const float* cb = ((const float*)F.in[25]) + (size_t)l * FF2;
    const float* sc = ((const float*)F.in[9]) + ((size_t)(l * MS + b) * 2) * FF2; float* so = F.out + O_SCONV + ((size_t)(l * MS + b) * 2) * FF2;
    for (int job = j0; job < FF / 16; job += jstride) {
        const int uu = job >> 3, cc = (job & 7) * 16;
        const bf16* b0 = W + (size_t)(uu * 256 + cc + fr) * D + fq * 8; const bf16* b1 = b0 + (size_t)128 * D;
        f32x4 acc[2] = {(f32x4){0.f, 0.f, 0.f, 0.f}, (f32x4){0.f, 0.f, 0.f, 0.f}};
#pragma unroll 8
        for (int k0 = 0; k0 < D; k0 += 32) { const bf16x8 a = *(const bf16x8*)(ap + k0), x0 = *(const bf16x8*)(b0 + k0), x1 = *(const bf16x8*)(b1 + k0);
            acc[0] = __builtin_amdgcn_mfma_f32_16x16x32_bf16(x0, a, acc[0], 0, 0, 0); acc[1] = __builtin_amdgcn_mfma_f32_16x16x32_bf16(x1, a, acc[1], 0, 0, 0); }
        const int ca = job * 16 + fq * 4; f32x4 c[2];
#pragma unroll
        for (int h = 0; h < 2; ++h) { const size_t co = (size_t)h * FF + ca;
            const f32x4 s0 = *(const f32x4*)(sc + co), s1 = *(const f32x4*)(sc + FF2 + co);
            c[h] = s0 * *(const f32x4*)(cw + co) + s1 * *(const f32x4*)(cw + FF2 + co) + acc[h] * *(const f32x4*)(cw + 2 * FF2 + co) + *(const f32x4*)(cb + co);
            *(f32x4*)(so + co) = s1; *(f32x4*)(so + FF2 + co) = acc[h]; }
        u32x2 wv; wv.x = pk2(gelu_tanh(c[0].x) * c[1].x, gelu_tanh(c[0].y) * c[1].y); wv.y = pk2(gelu_tanh(c[0].z) * c[1].z, gelu_tanh(c[0].w) * c[1].w);
        *(u32x2*)(WSP(bf16, WS_ACT) + (size_t)(MP + b) * FF + ca) = wv;
    }
}

struct OrderD {
    pg8::OrderMN inner; const char* A0; const char* A1; const char* A2; const char* B0; const char* B1; const char* B2;
    DI bool next(int i, pg8::Unit& u) const {
        const int ti = i / 3, mode = i - 3 * ti;
        if (!inner.next(ti, u)) return false;
        const size_t ar = (size_t)u.pm * 256 * D * 2, br = (size_t)u.pn * 256 * D * 2;
        if (mode == 0) { u.a = A0 + ar; u.b = B0 + br; u.nt = 16; }
        else if (mode == 1) { u.a = A1 + ar + (size_t)u.pn * 512; u.b = B1 + br + (size_t)u.pn * 512; u.nt = 4; }
        else { u.a = A2 + ar; u.b = B2 + br; u.nt = 16; }
        u.aux = mode; return true;
    }
};
DI f32x4 nz4(f32x4 v) { const float t = 1e-12f; return (f32x4){fabsf(v.x) < t ? t : v.x, fabsf(v.y) < t ? t : v.y, fabsf(v.z) < t ? t : v.z, fabsf(v.w) < t ? t : v.w}; }
struct EpiMixChain {
    bf16* mixb; const bf16* proj; const float* ps;
    DI bool keep(const pg8::Unit& u) const { return u.aux < 2; }
    DI void init(f32x4 (&acc)[2][2][4][2], const pg8::Unit&, int, int, int, int) const { pg8::acc_zero(acc); }
    DI void operator()(f32x4 (&acc)[2][2][4][2], const pg8::Unit& u, int wr, int wc, int fr, int fq) const {
        const int row0 = u.pm * 256 + wr * 64 + fr, col0 = u.pn * 256 + wc * 32 + 4 * fq, mode = u.aux;
#pragma unroll
        for (int bj = 0; bj < 2; ++bj)
#pragma unroll
            for (int n = 0; n < 2; ++n) {
                const int col = col0 + bj * 128 + n * 16; const f32x4 sv = *(const f32x4*)(ps + col);
#pragma unroll
                for (int ai = 0; ai < 2; ++ai)
#pragma unroll
                    for (int m = 0; m < 4; ++m) {
                        const int row = row0 + ai * 128 + m * 16; const bf16* gp = proj + (size_t)row * NPROJ + C_G + col;
                        if (mode == 0) { const u32x2 a = *(const u32x2*)gp, b = *(const u32x2*)(gp + 1024);
                            const f32x4 g0 = (f32x4){lo16(a.x), hi16(a.x), lo16(a.y), hi16(a.y)}, g1 = nz4((f32x4){lo16(b.x), hi16(b.x), lo16(b.y), hi16(b.y)} * sv);
                            acc[ai][bj][m][n] *= (f32x4){g0.x * __builtin_amdgcn_rcpf(g1.x), g0.y * __builtin_amdgcn_rcpf(g1.y), g0.z * __builtin_amdgcn_rcpf(g1.z), g0.w * __builtin_amdgcn_rcpf(g1.w)}; }
                        else if (mode == 1) { const u32x2 a = *(const u32x2*)(gp + 1024), b = *(const u32x2*)(gp + 2048);
                            const f32x4 g1 = nz4((f32x4){lo16(a.x), hi16(a.x), lo16(a.y), hi16(a.y)} * sv), g2 = nz4((f32x4){lo16(b.x), hi16(b.x), lo16(b.y), hi16(b.y)});
                            acc[ai][bj][m][n] *= (f32x4){g1.x * __builtin_amdgcn_rcpf(g2.x), g1.y * __builtin_amdgcn_rcpf(g2.y), g1.z * __builtin_amdgcn_rcpf(g2.z), g1.w * __builtin_amdgcn_rcpf(g2.w)}; }
                        else { const u32x2 b = *(const u32x2*)(gp + 2048); const f32x4 g2 = nz4((f32x4){lo16(b.x), hi16(b.x), lo16(b.y), hi16(b.y)});
                            const f32x4 v = acc[ai][bj][m][n] * g2; u32x2 w; w.x = pk2(v.x, v.y); w.y = pk2(v.z, v.w); *(u32x2*)(mixb + (size_t)row * D + col) = w; }
                    }
            }
    }
};
template <size_t AROW, size_t AH, size_t BB, size_t BH>
struct OrderAttn {
    int G, c; const char* A; const char* Bt;
    DI bool next(int i, pg8::Unit& u) const {
        const long L = (long)i * G + c; if (L >= 256) return false;
        const int b = (int)L >> 5, h = ((int)L >> 3) & 3, rb = (int)L & 7;
        u.pm = b * 8 + rb; u.pn = h;
        u.a = A + (size_t)u.pm * 256 * AROW + (size_t)h * AH;
        u.b = Bt + (size_t)b * BB + (size_t)h * BH; return true;
    }
};

template <class GE>
DI void skinny_job(Frame& F, const bf16* A, int lda, const bf16* Bt, int ldb, int K, const GE& ge, int col_out) {
    const int tid = opaque_tid(), lane = tid & 63, wid = __builtin_amdgcn_readfirstlane(tid >> 6), fr = lane & 15, fq = lane >> 4, row = wid * 16 + fr;
    const bf16* ap = A + (size_t)row * lda + fq * 8;
    const bf16* b0 = Bt + (size_t)fr * ldb + fq * 8; const bf16* b1 = b0 + (size_t)16 * ldb;
    f32x4 acc0 = (f32x4){0.f, 0.f, 0.f, 0.f}, acc1 = acc0;
#pragma unroll 8
    for (int k0 = 0; k0 < K; k0 += 32) {
        const bf16x8 a = *(const bf16x8*)(ap + k0), x0 = *(const bf16x8*)(b0 + k0), x1 = *(const bf16x8*)(b1 + k0);
        acc0 = __builtin_amdgcn_mfma_f32_16x16x32_bf16(x0, a, acc0, 0, 0, 0);
        acc1 = __builtin_amdgcn_mfma_f32_16x16x32_bf16(x1, a, acc1, 0, 0, 0);
    }
    ge(MP + row, col_out + fq * 4, acc0); ge(MP + row, col_out + 16 + fq * 4, acc1);
}
template <class GE>
DI void skinny_gemm(Frame& F, const bf16* A, int lda, const bf16* Bt, int ldb, int N, int K, const GE& ge) {
    for (int job = F.vcu; job < N / 32; job += F.G) skinny_job(F, A, lda, Bt + (size_t)job * 32 * ldb, ldb, K, ge, job * 32);
}

template <class GE>
DI void skinny_job_sk(Frame& F, const bf16* A, int lda, const bf16* Bt, int ldb, int K, const GE& ge, int rt, int col_out) {
    const int tid = opaque_tid(), lane = tid & 63, wid = __builtin_amdgcn_readfirstlane(tid >> 6), fr = lane & 15, fq = lane >> 4;
    const int kw = K >> 3;
    const bf16* ap = A + (size_t)(rt * 16 + fr) * lda + wid * kw + fq * 8;
    const bf16* b0 = Bt + (size_t)fr * ldb + wid * kw + fq * 8; const bf16* b1 = b0 + (size_t)16 * ldb;
    f32x4 acc0 = (f32x4){0.f, 0.f, 0.f, 0.f}, acc1 = acc0;
#pragma unroll 4
    for (int k0 = 0; k0 < kw; k0 += 32) {
        const bf16x8 a = *(const bf16x8*)(ap + k0), x0 = *(const bf16x8*)(b0 + k0), x1 = *(const bf16x8*)(b1 + k0);
        acc0 = __builtin_amdgcn_mfma_f32_16x16x32_bf16(x0, a, acc0, 0, 0, 0);
        acc1 = __builtin_amdgcn_mfma_f32_16x16x32_bf16(x1, a, acc1, 0, 0, 0);
    }
    LAS f32x4* part = (LAS f32x4*)F.lds;
    part[(wid * 2 + 0) * 64 + lane] = acc0; part[(wid * 2 + 1) * 64 + lane] = acc1;
    __syncthreads();
    if (tid < 128) { const int tile = tid >> 6, ln = tid & 63; f32x4 sum = part[tile * 64 + ln];
#pragma unroll
        for (int w = 1; w < 8; ++w) sum += part[(w * 2 + tile) * 64 + ln];
        ge(MP + rt * 16 + (ln & 15), col_out + tile * 16 + (ln >> 4) * 4, sum); }
    __syncthreads();
}
template <class GE>
DI void skinny_gemm_sk(Frame& F, const bf16* A, int lda, const bf16* Bt, int ldb, int K, const GE& ge) {
    for (int job = F.vcu; job < 256; job += F.G) { const int rt = job >> 5, cp = job & 31; skinny_job_sk(F, A, lda, Bt + (size_t)cp * 32 * ldb, ldb, K, ge, rt, cp * 32); }
}

template <class GE>
DI void skinny_gemm_sk3(Frame& F, const bf16* A, int lda, const bf16* Bt, int ldb, int N, const GE& ge) {
    const int tid = opaque_tid(), lane = tid & 63, wid = __builtin_amdgcn_readfirstlane(tid >> 6), fr = lane & 15, fq = lane >> 4;
    const int ng = N / 96; LAS f32x4* part = (LAS f32x4*)F.lds;
    for (int job = F.vcu; job < 8 * ng; job += F.G) {
        const int rt = job / ng, cg = job - rt * ng;
        const bf16* ap = A + (size_t)(rt * 16 + fr) * lda + wid * 128 + fq * 8;
        const bf16* bp = Bt + (size_t)(cg * 96 + fr) * ldb + wid * 128 + fq * 8;
        bf16x8 a[4], x[6][4];
#pragma unroll
        for (int k = 0; k < 4; ++k) { a[k] = *(const bf16x8*)(ap + k * 32);
#pragma unroll
            for (int t = 0; t < 6; ++t) x[t][k] = *(const bf16x8*)(bp + (size_t)t * 16 * ldb + k * 32); }
        f32x4 acc[6];
#pragma unroll
        for (int t = 0; t < 6; ++t) { acc[t] = (f32x4){0.f, 0.f, 0.f, 0.f};
#pragma unroll
            for (int k = 0; k < 4; ++k) acc[t] = __builtin_amdgcn_mfma_f32_16x16x32_bf16(x[t][k], a[k], acc[t], 0, 0, 0);
            part[(wid * 6 + t) * 64 + lane] = acc[t]; }
        __syncthreads();
        if (tid < 384) { const int tile = tid >> 6, ln = tid & 63; f32x4 sum = part[tile * 64 + ln];
#pragma unroll
            for (int w = 1; w < 8; ++w) sum += part[(w * 6 + tile) * 64 + ln];
            ge(MP + rt * 16 + (ln & 15), cg * 96 + tile * 16 + (ln >> 4) * 4, sum); }
        __syncthreads();
    }
}

DI void transpose_item(const float* W, int ldw, int K, bf16* WT, int k0, int n0src, int n0dst, LAS float* scr, int lane) {
    { const int kr = lane >> 4, nc = (lane & 15) * 4;
      f32x4 v[16];
#pragma unroll
      for (int i = 0; i < 16; ++i) v[i] = *(const f32x4*)(W + (size_t)(k0 + 4 * i + kr) * ldw + n0src + nc);
#pragma unroll
      for (int i = 0; i < 16; ++i) { LAS float* d = scr + (4 * i + kr) * 65 + nc; d[0] = v[i].x; d[1] = v[i].y; d[2] = v[i].z; d[3] = v[i].w; } }
    LDS_WAIT(); asm volatile("" ::: "memory");
    const int c = lane & 7;
#pragma unroll
    for (int j = 0; j < 8; ++j) { const int n = (lane >> 3) + 8 * j; const LAS float* sp = scr + (8 * c) * 65 + n;
        u32x4 o; o.x = pk2(sp[0 * 65], sp[1 * 65]); o.y = pk2(sp[2 * 65], sp[3 * 65]); o.z = pk2(sp[4 * 65], sp[5 * 65]); o.w = pk2(sp[6 * 65], sp[7 * 65]);
        *(u32x4*)(WT + (size_t)(n0dst + n) * K + k0 + 8 * c) = o; }
    LDS_WAIT(); asm volatile("" ::: "memory");
}
DI void mat_item(const float* W, int ldw, int K, int N, bf16* WT, int item, LAS float* scr, int lane, int shift_at) {
    const int nblk = N / 64, kb = item / nblk, nb = item % nblk, n0 = 64 * nb;
    transpose_item(W, ldw, K, WT, 64 * kb, n0 + (n0 >= shift_at ? 8 : 0), n0, scr, lane);
}
DI void phase_convert(Frame& F) {
    const int tid = opaque_tid(), lane = tid & 63, wid = __builtin_amdgcn_readfirstlane(tid >> 6);
    LAS float* scr = (LAS float*)(F.lds + wid * 16640);
    const int gw = F.vcu * 8 + wid, NGW = F.G * 8;
    constexpr int I_IN = 16 * 144, I_SQ = 16 * 16, I_KV = 16 * 32, I_UP = 16 * 88, I_DN = 44 * 16, I_P = 4 * 4;
    constexpr int PER_L = I_IN + 3 * I_SQ + I_KV + I_UP + I_DN + 4 * I_P;
    for (int it = gw; it < DEPTH * PER_L; it += NGW) {
        const int l = it / PER_L; int r = it % PER_L;
        if (r < I_IN) { mat_item(((const float*)F.in[12]) + (size_t)l * D * INW, INW, D, NPROJ, WSP(bf16, WS_WIN + l * SZ_WIN), r, scr, lane, 4096); continue; } r -= I_IN;
        if (r < I_SQ) { mat_item(((const float*)F.in[15]) + (size_t)l * D * D, D, D, D, WSP(bf16, WS_WM + l * SZ_W1K), r, scr, lane, 1 << 30); continue; } r -= I_SQ;
        if (r < I_SQ) { mat_item(((const float*)F.in[19]) + (size_t)l * D * D, D, D, D, WSP(bf16, WS_WX + l * SZ_W1K), r, scr, lane, 1 << 30); continue; } r -= I_SQ;
        if (r < I_SQ) { mat_item(((const float*)F.in[20]) + (size_t)l * D * D, D, D, D, WSP(bf16, WS_WO + l * SZ_W1K), r, scr, lane, 1 << 30); continue; } r -= I_SQ;
        if (r < I_KV) { mat_item(((const float*)F.in[18]) + (size_t)l * D * 2048, 2048, D, 2048, WSP(bf16, WS_WKV + l * SZ_WKV), r, scr, lane, 1 << 30); continue; } r -= I_KV;
        if (r < I_UP) { const int kb = r / 88, nb = r % 88, u = nb >> 2, q = nb & 3;
            transpose_item(((const float*)F.in[23]) + (size_t)l * D * FF2, FF2, D, WSP(bf16, WS_WUP + l * SZ_WUP), 64 * kb, (q >> 1) * FF + 128 * u + (q & 1) * 64, 64 * nb, scr, lane); continue; } r -= I_UP;
        if (r < I_DN) { mat_item(((const float*)F.in[26]) + (size_t)l * FF * D, D, FF, D, WSP(bf16, WS_WDN + l * SZ_WDN), r, scr, lane, 1 << 30); continue; } r -= I_DN;
        { const int g = r / I_P, ri = r % I_P, kb = ri / 4, nb = ri % 4;
          transpose_item(((const float*)F.in[16]) + ((size_t)l * 4 + g) * 65536, 256, D, WSP(bf16, WS_WP + l * SZ_WP) + g * 256, 64 * kb, 64 * nb, g * 256 + 64 * nb, scr, lane); }
    }
    { const float* mem = ((const float*)F.in[1]); bf16* mb = WSP(bf16, WS_MEMB);
      for (size_t i = ((size_t)F.vcu * 512 + tid) * 8; i < (size_t)2048 * D; i += (size_t)F.G * 512 * 8) {
          const f32x4 a = *(const f32x4*)(mem + i), b = *(const f32x4*)(mem + i + 4);
          u32x4 o; o.x = pk2(a.x, a.y); o.y = pk2(a.z, a.w); o.z = pk2(b.x, b.y); o.w = pk2(b.z, b.w); *(u32x4*)(mb + i) = o; } }
}

DI void stage_gate_w(Frame& F, int l) {
    LAS float* wg = (LAS float*)F.lds;
    const float* w = ((const float*)F.in[12]) + (size_t)l * D * INW + 4096;
    for (int i = opaque_tid(); i < 8192; i += 512) { const int k = i >> 3, j = i & 7; wg[j * 1024 + k] = w[(size_t)k * INW + j]; }
    __syncthreads();
}
DI void ln_row(Frame& F, const int lane, f32x4 (&v)[4], const f32x4 (&gv)[4], const f32x4 (&bv)[4], int row, int lg, float* fin) {
    float s = 0.f;
#pragma unroll
    for (int j = 0; j < 4; ++j) s += (v[j].x + v[j].y) + (v[j].z + v[j].w);
    const float mean = wave_sum(s) * (1.f / D); float s2 = 0.f;
#pragma unroll
    for (int j = 0; j < 4; ++j) { v[j] = v[j] - mean; s2 += (v[j].x * v[j].x + v[j].y * v[j].y) + (v[j].z * v[j].z + v[j].w * v[j].w); }
    const float rstd = 1.f / sqrtf(wave_sum(s2) * (1.f / D) + LN_EPS);
    f32x4* xo = (f32x4*)(WSP(float, WS_X) + (size_t)row * D) + lane;
    u32x2* no = (u32x2*)(WSP(bf16, WS_XN) + (size_t)row * D) + lane;
#pragma unroll
    for (int j = 0; j < 4; ++j) {
        v[j] = v[j] * rstd * gv[j] + bv[j];
        xo[64 * j] = v[j];
        u32x2 w; w.x = pk2(v[j].x, v[j].y); w.y = pk2(v[j].z, v[j].w); no[64 * j] = w;
        if (fin) ((f32x4*)fin)[lane + 64 * j] = v[j];
    }
    if (lg >= 0) {
        const LAS float* wg = (const LAS float*)F.lds;
        float a[8];
#pragma unroll
        for (int q = 0; q < 8; ++q) { float t = 0.f;
#pragma unroll
            for (int j = 0; j < 4; ++j) { const f32x4 w = *(const LAS f32x4*)(wg + q * 1024 + 4 * lane + 256 * j); t += (v[j].x * w.x + v[j].y * w.y) + (v[j].z * w.z + v[j].w * w.w); }
            a[q] = wave_sum(t); }
        if (lane == 0) { const float* bb = ((const float*)F.in[13]) + (size_t)lg * INW + 4096; float* o = WSP(float, WS_IGFG) + (size_t)row * 8;
#pragma unroll
            for (int q = 0; q < 8; ++q) o[q] = a[q] + bb[q]; }
    }
}
DI void phase_ln_in(Frame& F) {
    stage_gate_w(F, 0);
    const int tid = opaque_tid(), lane = tid & 63, wid = __builtin_amdgcn_readfirstlane(tid >> 6);
    const int gw = F.vcu * 8 + wid, NGW = F.G * 8;
    f32x4 gv[4], bv[4], nv[4];
#pragma unroll
    for (int j = 0; j < 4; ++j) { gv[j] = ((const f32x4*)((const float*)F.in[10]))[lane + 64 * j]; bv[j] = ((const f32x4*)((const float*)F.in[11]))[lane + 64 * j]; }
#define LN_SRC0(r) ((r) < MP ? ((const float*)F.in[0]) + (size_t)(r) * D : ((const float*)F.in[2]) + (size_t)((r) - MP) * D)
    if (gw < MT) {
#pragma unroll
        for (int j = 0; j < 4; ++j) nv[j] = ((const f32x4*)LN_SRC0(gw))[lane + 64 * j]; }
    for (int r = gw; r < MT; r += NGW) {
        f32x4 v[4];
#pragma unroll
        for (int j = 0; j < 4; ++j) v[j] = nv[j];
        if (r + NGW < MT) {
#pragma unroll
            for (int j = 0; j < 4; ++j) nv[j] = ((const f32x4*)LN_SRC0(r + NGW))[lane + 64 * j]; }
        ln_row(F, lane, v, gv, bv, r, 0, nullptr);
    }
#undef LN_SRC0
    __syncthreads();
}
DI void phase_ln(Frame& F, int l, int which) {
    const int lg = (which == 1 && l + 1 < DEPTH) ? l + 1 : -1;
    if (lg >= 0) stage_gate_w(F, lg);
    const float* gam = (const float*)(which ? F.in[27] : F.in[21]) + (size_t)l * D; const float* bet = (const float*)(which ? F.in[28] : F.in[22]) + (size_t)l * D;
    const bool last = (which == 1 && l == DEPTH - 1);
    const int tid = opaque_tid(), lane = tid & 63, wid = __builtin_amdgcn_readfirstlane(tid >> 6);
    const int gw = F.vcu * 8 + wid, NGW = F.G * 8;
    f32x4 gv[4], bv[4], nv[4];
#pragma unroll
    for (int j = 0; j < 4; ++j) { gv[j] = ((const f32x4*)gam)[lane + 64 * j]; bv[j] = ((const f32x4*)bet)[lane + 64 * j]; }
    const float* T = WSP(float, WS_T);
    if (gw < MT) {
#pragma unroll
        for (int j = 0; j < 4; ++j) nv[j] = ((const f32x4*)(T + (size_t)gw * D))[lane + 64 * j]; }
    for (int r = gw; r < MT; r += NGW) {
        f32x4 v[4];
#pragma unroll
        for (int j = 0; j < 4; ++j) v[j] = nv[j];
        if (r + NGW < MT) {
#pragma unroll
            for (int j = 0; j < 4; ++j) nv[j] = ((const f32x4*)(T + (size_t)(r + NGW) * D))[lane + 64 * j]; }
        float* fin = last ? (r < MP ? F.out + O_YP + (size_t)r * D : F.out + O_YS + (size_t)(r - MP) * D) : nullptr;
        ln_row(F, lane, v, gv, bv, r, lg, fin);
    }
    __syncthreads();
}

constexpr int MP_Q = 0, MP_K = 33792, MP_T2 = 67584, MP_VEC = 104448, MP_END = 104448 + 4 * 6 * 64 * 4;
static_assert(MP_END <= XCH_OFF, "mLSTM prep LDS map");
DI float log_sigmoid(float x) { return fminf(x, 0.f) - log1pf(expf(-fabsf(x))); }
#define DPP_F(oldv, src, ctrl, rmask, bc) __builtin_bit_cast(float, __builtin_amdgcn_update_dpp(__builtin_bit_cast(int, (float)(oldv)), __builtin_bit_cast(int, (float)(src)), ctrl, rmask, 0xf, bc))
DI float wave_scan_add(float v) {
    v += DPP_F(0.f, v, 0x111, 0xf, true); v += DPP_F(0.f, v, 0x112, 0xf, true); v += DPP_F(0.f, v, 0x114, 0xf, true); v += DPP_F(0.f, v, 0x118, 0xf, true);
    v += DPP_F(0.f, v, 0x142, 0xa, true); v += DPP_F(0.f, v, 0x143, 0xc, true); return v; }
DI float wave_scan_max(float v) {
    v = fmaxf(v, DPP_F(v, v, 0x111, 0xf, false)); v = fmaxf(v, DPP_F(v, v, 0x112, 0xf, false)); v = fmaxf(v, DPP_F(v, v, 0x114, 0xf, false)); v = fmaxf(v, DPP_F(v, v, 0x118, 0xf, false));
    v = fmaxf(v, DPP_F(v, v, 0x142, 0xa, false)); v = fmaxf(v, DPP_F(v, v, 0x143, 0xc, false)); return v; }
DI void mlstm_prep_job(Frame& F, int l, int job) {
    const int b = job >> 5, hh = (job >> 3) & 3, c4 = job & 7;
    const int tid = opaque_tid(), lane = tid & 63, wid = __builtin_amdgcn_readfirstlane(tid >> 6), fr = lane & 15, fq = lane >> 4;
    LAS unsigned char* L = F.lds;
    LAS float* vecs = (LAS float*)(L + MP_VEC);
    const bf16* projb = WSP(bf16, WS_PROJ) + (size_t)b * SEQ * NPROJ;
    const size_t bh = (size_t)(b * NH + hh);
    bf16* PTg = WSP(bf16, WS_PT) + bh * 32 * 4096; bf16* KWg = WSP(bf16, WS_KWT) + bh * 32 * 16384; bf16* VTg = WSP(bf16, WS_VTT) + bh * 32 * 16384;
    float* GTg = WSP(float, WS_GT) + bh * 32 * 192;
    if (wid == 0) {
        const float* igfg = WSP(float, WS_IGFG) + (size_t)b * SEQ * 8;
        float mprev = 0.f; const int nch = 4 * c4 + 4;
        float igr[32], fgr[32];
#pragma unroll
        for (int ch = 0; ch < 32; ++ch) if (ch < nch) { igr[ch] = igfg[(size_t)(ch * 64 + lane) * 8 + hh]; fgr[ch] = igfg[(size_t)(ch * 64 + lane) * 8 + 4 + hh]; }
#pragma unroll
        for (int ch = 0; ch < 32; ++ch) if (ch < nch) {
            const float igv = igr[ch], fgv = fgr[ch];
            const float lf = fminf(fgv, 0.f) - __logf(1.0f + __expf(-fabsf(fgv)));
            const float bb = wave_scan_add(lf);
            const float a = igv - bb; const float cm = wave_scan_max(a);
            const float mt = bb + fmaxf(mprev, cm);
            const float mL = __builtin_bit_cast(float, __builtin_amdgcn_readlane(__builtin_bit_cast(int, mt), 63)), bL = __builtin_bit_cast(float, __builtin_amdgcn_readlane(__builtin_bit_cast(int, bb), 63));
            if (ch >= 4 * c4) {
                const int ci = ch - 4 * c4;
                LAS float* v = vecs + ci * 384;
                v[lane] = a; v[64 + lane] = bb; v[128 + lane] = mt; v[192 + lane] = expf(a + bL - mL);
                float* g = GTg + (size_t)ch * 192;
                g[lane] = expf(mprev + bb - mt); g[64 + lane] = expf(-mt);
                if (lane == 0) g[128] = expf(mprev + bL - mL);
            }
            mprev = mL;
        }
        if (c4 == 7 && lane == 0) F.out[O_PM + (l * NB + b) * NH + hh] = mprev;
    }
    u32x4 q4[4], k4[4], v4[4];
#define MP_LOAD(c) do { const bf16* pr = projb + (size_t)((c) * 64 + lane) * NPROJ + hh * 256 + wid * 32; \
        _Pragma("unroll") for (int i = 0; i < 4; ++i) { q4[i] = *(const u32x4*)(pr + C_Q + i * 8); k4[i] = *(const u32x4*)(pr + C_K + i * 8); v4[i] = *(const u32x4*)(pr + C_V + i * 8); } } while (0)
    MP_LOAD(4 * c4);
    __syncthreads();
    for (int ci = 0; ci < 4; ++ci) {
        const int c = 4 * c4 + ci;
        const LAS float* vec = vecs + ci * 384;
#pragma unroll
        for (int i = 0; i < 4; ++i) { *(LAS u32x4*)(L + MP_Q + lane * 528 + (wid * 32 + i * 8) * 2) = q4[i]; *(LAS u32x4*)(L + MP_K + lane * 528 + (wid * 32 + i * 8) * 2) = k4[i]; }
        { const float w = vec[192 + lane] * 0.0625f;
#pragma unroll
          for (int i = 0; i < 4; ++i) { float kf[8]; unpack8(k4[i], kf);
#pragma unroll
            for (int j = 0; j < 8; ++j) ((LAS unsigned short*)(L + MP_T2))[(wid * 32 + i * 8 + j) * 72 + lane] = (unsigned short)f2bf(kf[j] * w); } }
        u32x4 vc4[4];
#pragma unroll
        for (int i = 0; i < 4; ++i) vc4[i] = v4[i];
        __syncthreads();
        if (ci + 1 < 4) MP_LOAD(c + 1);
        { const int tt = wid >> 1;
#pragma unroll
          for (int si = 0; si < 2; ++si) { const int st = (wid & 1) * 2 + si;
            f32x4 acc = (f32x4){0.f, 0.f, 0.f, 0.f};
            if (st <= tt) {
#pragma unroll
                for (int kk = 0; kk < 8; ++kk) { const bf16x8 kf = *(const LAS bf16x8*)(L + MP_K + (st * 16 + fr) * 528 + (kk * 32 + fq * 8) * 2), qf = *(const LAS bf16x8*)(L + MP_Q + (tt * 16 + fr) * 528 + (kk * 32 + fq * 8) * 2);
                    acc = __builtin_amdgcn_mfma_f32_16x16x32_bf16(kf, qf, acc, 0, 0, 0); }
            }
            const int t = tt * 16 + fr, s0 = st * 16 + fq * 4; const float bt = vec[64 + t] - vec[128 + t];
            float p[4];
#pragma unroll
            for (int j = 0; j < 4; ++j) { const int s = s0 + j; p[j] = (s <= t) ? acc[j] * 0.0625f * __expf(vec[s] + bt) : 0.f; }
            u32x2 w; w.x = pk2(p[0], p[1]); w.y = pk2(p[2], p[3]); *(u32x2*)(PTg + (size_t)c * 4096 + t * 64 + s0) = w; } }
        { const int d = tid >> 1, hf = tid & 1; bf16* o = KWg + (size_t)c * 16384 + d * 64 + hf * 32;
#pragma unroll
          for (int i = 0; i < 4; ++i) *(u32x4*)(o + i * 8) = *(const LAS u32x4*)(L + MP_T2 + d * 144 + hf * 64 + i * 16); }
        __syncthreads();
#pragma unroll
        for (int i = 0; i < 4; ++i) { const unsigned ww[4] = {vc4[i].x, vc4[i].y, vc4[i].z, vc4[i].w};
#pragma unroll
            for (int j = 0; j < 4; ++j) { ((LAS unsigned short*)(L + MP_T2))[(wid * 32 + i * 8 + 2 * j) * 72 + lane] = (unsigned short)(ww[j] & 0xffffu); ((LAS unsigned short*)(L + MP_T2))[(wid * 32 + i * 8 + 2 * j + 1) * 72 + lane] = (unsigned short)(ww[j] >> 16); } }
        __syncthreads();
        { const int d = tid >> 1, hf = tid & 1; bf16* o = VTg + (size_t)c * 16384 + d * 64 + hf * 32;
#pragma unroll
          for (int i = 0; i < 4; ++i) *(u32x4*)(o + i * 8) = *(const LAS u32x4*)(L + MP_T2 + d * 144 + hf * 64 + i * 16); }
        __syncthreads();
    }
#undef MP_LOAD
}

constexpr int MR_CT = 0, MR_NUM = 25344, MR_DEN = 33536, MR_END = 34048;
DI void mlstm_rec_job(Frame& F, int l, int job) {
    const int b = job >> 5, hh = (job >> 3) & 3, sl = job & 7;
    const int tid = opaque_tid(), lane = tid & 63, wid = __builtin_amdgcn_readfirstlane(tid >> 6), fr = lane & 15, fq = lane >> 4;
    const int tt = wid >> 1, et = wid & 1, t = tt * 16 + fr;
    LAS unsigned char* L = F.lds;
    const size_t bh = (size_t)(b * NH + hh);
    const bf16* qp = WSP(bf16, WS_PROJ) + ((size_t)b * SEQ + t) * NPROJ + C_Q + hh * 256 + fq * 8;
    const bf16* pp = WSP(bf16, WS_PT) + bh * 32 * 4096 + t * 64 + fq * 8;
    const bf16* kp = WSP(bf16, WS_KWT) + bh * 32 * 16384 + (wid * 32 + fr) * 64 + fq * 8;
    const bf16* vp = WSP(bf16, WS_VTT) + bh * 32 * 16384 + (sl * 32 + fr) * 64 + fq * 8;
    const float* gp = WSP(float, WS_GT) + bh * 32 * 192;
    const int ht = tid >> 3, he0 = (tid & 7) * 4;
    const bf16* sop = WSP(bf16, WS_PROJ) + ((size_t)b * SEQ + ht) * NPROJ + C_O + hh * 256 + sl * 32 + he0;
    bf16* hc = WSP(bf16, WS_HC) + ((size_t)b * SEQ + ht) * D + hh * 256 + sl * 32 + he0;
    for (int i = tid; i < 25344 / 4; i += 512) ((LAS unsigned*)(L + MR_CT))[i] = 0u;
    f32x4 cacc[2][3];
#pragma unroll
    for (int i = 0; i < 2; ++i)
#pragma unroll
        for (int j = 0; j < 3; ++j) cacc[i][j] = (f32x4){0.f, 0.f, 0.f, 0.f};
    bf16x8 ones; { const short o = (fr == 0) ? (short)0x3F80 : (short)0;
#pragma unroll
        for (int j = 0; j < 8; ++j) ones[j] = o; }
    bf16x8 qf[8], pf[2], kfA[2][2], vfA[2][2], kfB[2][2], vfB[2][2]; float interA, enmA, decA, interB, enmB, decB; u32x2 soA, soB;
#define MR_LOADQP(c) do { \
        _Pragma("unroll") for (int kk = 0; kk < 8; ++kk) qf[kk] = *(const bf16x8*)(qp + (size_t)(c) * 64 * NPROJ + kk * 32); \
        _Pragma("unroll") for (int ks = 0; ks < 2; ++ks) pf[ks] = *(const bf16x8*)(pp + (size_t)(c) * 4096 + ks * 32); } while (0)
#define MR_LOADKV(S, c) do { \
        _Pragma("unroll") for (int ks = 0; ks < 2; ++ks) { \
            _Pragma("unroll") for (int x = 0; x < 2; ++x) { kf##S[x][ks] = *(const bf16x8*)(kp + (size_t)(c) * 16384 + x * 1024 + ks * 32); vf##S[x][ks] = *(const bf16x8*)(vp + (size_t)(c) * 16384 + x * 1024 + ks * 32); } } \
        inter##S = gp[(c) * 192 + t]; enm##S = gp[(c) * 192 + 64 + ht]; dec##S = gp[(c) * 192 + 128]; so##S = *(const u32x2*)(sop + (size_t)(c) * 64 * NPROJ); } while (0)
#define MR_BODY(S, N, c) do { \
          \
        f32x4 aP = (f32x4){0.f, 0.f, 0.f, 0.f}, aC0 = aP, aC1 = aP, dP = aP, dC = aP; \
        bf16x8 cf[8], c2[4]; \
        _Pragma("unroll") for (int kk = 0; kk < 8; ++kk) cf[kk] = *(const LAS bf16x8*)(L + MR_CT + (et * 16 + fr) * 528 + (kk * 32 + fq * 8) * 2); \
        _Pragma("unroll") for (int kk = 0; kk < 4; ++kk) c2[kk] = *(const LAS bf16x8*)(L + MR_CT + (32 + fr) * 528 + ((et * 4 + kk) * 32 + fq * 8) * 2); \
        if (et == 0) { _Pragma("unroll") for (int ks = 0; ks < 2; ++ks) { aP = __builtin_amdgcn_mfma_f32_16x16x32_bf16(vf##S[0][ks], pf[ks], aP, 0, 0, 0); dP = __builtin_amdgcn_mfma_f32_16x16x32_bf16(ones, pf[ks], dP, 0, 0, 0); } \
            _Pragma("unroll") for (int kk = 0; kk < 4; ++kk) dC = __builtin_amdgcn_mfma_f32_16x16x32_bf16(c2[kk], qf[kk], dC, 0, 0, 0); } \
        else { _Pragma("unroll") for (int ks = 0; ks < 2; ++ks) aP = __builtin_amdgcn_mfma_f32_16x16x32_bf16(vf##S[1][ks], pf[ks], aP, 0, 0, 0); \
            _Pragma("unroll") for (int kk = 0; kk < 4; ++kk) dC = __builtin_amdgcn_mfma_f32_16x16x32_bf16(c2[kk], qf[4 + kk], dC, 0, 0, 0); } \
        _Pragma("unroll") for (int kk = 0; kk < 8; kk += 2) { aC0 = __builtin_amdgcn_mfma_f32_16x16x32_bf16(cf[kk], qf[kk], aC0, 0, 0, 0); aC1 = __builtin_amdgcn_mfma_f32_16x16x32_bf16(cf[kk + 1], qf[kk + 1], aC1, 0, 0, 0); } \
        __builtin_amdgcn_sched_barrier(0); \
        if ((c) + 1 < SEQ / 64) { MR_LOADQP((c) + 1); MR_LOADKV(N, (c) + 1); } \
        __builtin_amdgcn_sched_barrier(0); \
        *(LAS f32x4*)(L + MR_NUM + (t * 32 + et * 16 + fq * 4) * 4) = aP + (aC0 + aC1) * inter##S; \
        if (fq == 0) ((LAS float*)(L + MR_DEN))[t * 2 + et] = dP.x + dC.x * inter##S; \
        __syncthreads();                                                      \
          \
        { const f32x4 nm = *(const LAS f32x4*)(L + MR_NUM + (ht * 32 + he0) * 4); const float den = ((LAS float*)(L + MR_DEN))[ht * 2] + ((LAS float*)(L + MR_DEN))[ht * 2 + 1]; \
          const float inv = 1.0f / fmaxf(fabsf(den), enm##S); \
          u32x2 w; w.x = pk2(lo16(so##S.x) * nm.x * inv, hi16(so##S.x) * nm.y * inv); w.y = pk2(lo16(so##S.y) * nm.z * inv, hi16(so##S.y) * nm.w * inv); \
          *(u32x2*)(hc + (size_t)(c) * 64 * D) = w; } \
          \
        _Pragma("unroll") for (int di = 0; di < 2; ++di) { \
            _Pragma("unroll") for (int e3 = 0; e3 < 3; ++e3) { f32x4 a = cacc[di][e3] * dec##S; \
                _Pragma("unroll") for (int ks = 0; ks < 2; ++ks) a = __builtin_amdgcn_mfma_f32_16x16x32_bf16(kf##S[di][ks], e3 == 2 ? ones : vf##S[e3 & 1][ks], a, 0, 0, 0); \
                cacc[di][e3] = a; \
                u32x2 w; w.x = pk2(a.x, a.y); w.y = pk2(a.z, a.w); *(LAS u32x2*)(L + MR_CT + (e3 * 16 + fr) * 528 + ((wid * 2 + di) * 16 + fq * 4) * 2) = w; } } \
        __syncthreads();                                                      \
    } while (0)
    MR_LOADQP(0); MR_LOADKV(A, 0);
    __syncthreads();
#pragma unroll 1
    for (int c = 0; c < SEQ / 64; c += 2) { MR_BODY(A, B, c); MR_BODY(B, A, c + 1); }
#undef MR_BODY
#undef MR_LOADKV
#undef MR_LOADQP
    { float* pc = F.out + O_PC + ((size_t)((l * NB + b) * NH + hh)) * 65536;
#pragma unroll
      for (int di = 0; di < 2; ++di) { const int dt = wid * 2 + di;
#pragma unroll
        for (int e3 = 0; e3 < 2; ++e3)
#pragma unroll
            for (int j = 0; j < 4; ++j) pc[(size_t)(dt * 16 + fq * 4 + j) * 256 + sl * 32 + e3 * 16 + fr] = cacc[di][e3][j];
        if (sl == 0 && fr == 0) { float* pn = F.out + O_PN + ((size_t)((l * NB + b) * NH + hh)) * 256;
#pragma unroll
            for (int j = 0; j < 4; ++j) pn[dt * 16 + fq * 4 + j] = cacc[di][2][j]; } } }
    __syncthreads();
}

constexpr int R2_CT = 0, R2_NUM = 42240, R2_DEN = 75008, R2_END = 75520;
static_assert(R2_END <= XCH_OFF, "rec2 LDS map");
DI void mlstm_rec2_job(Frame& F, int l, int job) {
    const int b = job >> 4, hh = (job >> 2) & 3, sp = job & 3;
    const int tid = opaque_tid(), lane = tid & 63, wid = __builtin_amdgcn_readfirstlane(tid >> 6), fr = lane & 15, fq = lane >> 4;
    const int tt = wid >> 1, kh = wid & 1, t = tt * 16 + fr;
    LAS unsigned char* L = F.lds;
    const size_t bh = (size_t)(b * NH + hh);
    const bf16* qp = WSP(bf16, WS_PROJ) + ((size_t)b * SEQ + t) * NPROJ + C_Q + hh * 256 + kh * 128 + fq * 8;
    const bf16* pp = WSP(bf16, WS_PT) + bh * 32 * 4096 + t * 64 + kh * 32 + fq * 8;
    const bf16* kp = WSP(bf16, WS_KWT) + bh * 32 * 16384 + (wid * 32 + fr) * 64 + fq * 8;
    const bf16* vp = WSP(bf16, WS_VTT) + bh * 32 * 16384 + (sp * 64 + fr) * 64 + fq * 8;
    const float* gp = WSP(float, WS_GT) + bh * 32 * 192;
    const int ht = tid >> 3, he0 = (tid & 7) * 8;
    const bf16* sop = WSP(bf16, WS_PROJ) + ((size_t)b * SEQ + ht) * NPROJ + C_O + hh * 256 + sp * 64 + he0;
    bf16* hc = WSP(bf16, WS_HC) + ((size_t)b * SEQ + ht) * D + hh * 256 + sp * 64 + he0;
    for (int i = tid; i < 42240 / 4; i += 512) ((LAS unsigned*)(L + R2_CT))[i] = 0u;
    f32x4 cacc[2][5];
#pragma unroll
    for (int i = 0; i < 2; ++i)
#pragma unroll
        for (int j = 0; j < 5; ++j) cacc[i][j] = (f32x4){0.f, 0.f, 0.f, 0.f};
    bf16x8 ones; { const short o = (fr == 0) ? (short)0x3F80 : (short)0;
#pragma unroll
        for (int j = 0; j < 8; ++j) ones[j] = o; }
    bf16x8 qf[4], pf, kf[2][2], vfA[4][2], vfB[4][2]; float interA, enmA, decA, interB, enmB, decB; u32x4 soA, soB;
#define R2_LOADQP(c) do { \
        _Pragma("unroll") for (int kk = 0; kk < 4; ++kk) qf[kk] = *(const bf16x8*)(qp + (size_t)(c) * 64 * NPROJ + kk * 32); \
        pf = *(const bf16x8*)(pp + (size_t)(c) * 4096); } while (0)
#define R2_LOADK(c) do { \
        _Pragma("unroll") for (int ks = 0; ks < 2; ++ks) { \
            _Pragma("unroll") for (int x = 0; x < 2; ++x) kf[x][ks] = *(const bf16x8*)(kp + (size_t)(c) * 16384 + x * 1024 + ks * 32); } } while (0)
#define R2_LOADKV(S, c) do { \
        _Pragma("unroll") for (int ks = 0; ks < 2; ++ks) { \
            _Pragma("unroll") for (int e = 0; e < 4; ++e) vf##S[e][ks] = *(const bf16x8*)(vp + (size_t)(c) * 16384 + e * 1024 + ks * 32); } \
        inter##S = gp[(c) * 192 + t]; enm##S = gp[(c) * 192 + 64 + ht]; dec##S = gp[(c) * 192 + 128]; so##S = *(const u32x4*)(sop + (size_t)(c) * 64 * NPROJ); } while (0)
#define R2_BODY(S, N, c) do { \
        f32x4 ac[5]; \
        _Pragma("unroll") for (int e = 0; e < 5; ++e) { bf16x8 cf[4]; f32x4 a = (f32x4){0.f, 0.f, 0.f, 0.f}; \
            _Pragma("unroll") for (int kk = 0; kk < 4; ++kk) cf[kk] = *(const LAS bf16x8*)(L + R2_CT + (e * 16 + fr) * 528 + ((kh * 4 + kk) * 32 + fq * 8) * 2); \
            _Pragma("unroll") for (int kk = 0; kk < 4; ++kk) a = __builtin_amdgcn_mfma_f32_16x16x32_bf16(cf[kk], qf[kk], a, 0, 0, 0); \
            ac[e] = a * inter##S; }                                             \
        if (kh == 0) { _Pragma("unroll") for (int e = 0; e < 4; ++e) ac[e] = __builtin_amdgcn_mfma_f32_16x16x32_bf16(vf##S[e][0], pf, ac[e], 0, 0, 0); } \
        else { _Pragma("unroll") for (int e = 0; e < 4; ++e) ac[e] = __builtin_amdgcn_mfma_f32_16x16x32_bf16(vf##S[e][1], pf, ac[e], 0, 0, 0); } \
        ac[4] = __builtin_amdgcn_mfma_f32_16x16x32_bf16(ones, pf, ac[4], 0, 0, 0); \
        __builtin_amdgcn_sched_barrier(0); \
        if ((c) + 1 < SEQ / 64) { R2_LOADQP((c) + 1); R2_LOADKV(N, (c) + 1); } \
        __builtin_amdgcn_sched_barrier(0); \
        _Pragma("unroll") for (int e = 0; e < 4; ++e) *(LAS f32x4*)(L + R2_NUM + ((kh * 64 + t) * 64 + e * 16 + fq * 4) * 4) = ac[e]; \
        if (fq == 0) ((LAS float*)(L + R2_DEN))[kh * 64 + t] = ac[4].x; \
        __syncthreads();                                                      \
        { const LAS float* n0 = (const LAS float*)(L + R2_NUM) + ht * 64 + he0; \
          const f32x4 x0 = *(const LAS f32x4*)n0 + *(const LAS f32x4*)(n0 + 4096), x1 = *(const LAS f32x4*)(n0 + 4) + *(const LAS f32x4*)(n0 + 4096 + 4); \
          const float den = ((LAS float*)(L + R2_DEN))[ht] + ((LAS float*)(L + R2_DEN))[64 + ht]; \
          const float inv = 1.0f / fmaxf(fabsf(den), enm##S); \
          u32x4 w; w.x = pk2(lo16(so##S.x) * x0.x * inv, hi16(so##S.x) * x0.y * inv); w.y = pk2(lo16(so##S.y) * x0.z * inv, hi16(so##S.y) * x0.w * inv); \
          w.z = pk2(lo16(so##S.z) * x1.x * inv, hi16(so##S.z) * x1.y * inv); w.w = pk2(lo16(so##S.w) * x1.z * inv, hi16(so##S.w) * x1.w * inv); \
          *(u32x4*)(hc + (size_t)(c) * 64 * D) = w; } \
        _Pragma("unroll") for (int di = 0; di < 2; ++di) { \
            _Pragma("unroll") for (int e3 = 0; e3 < 5; ++e3) { f32x4 a = cacc[di][e3] * dec##S; \
                _Pragma("unroll") for (int ks = 0; ks < 2; ++ks) a = __builtin_amdgcn_mfma_f32_16x16x32_bf16(kf[di][ks], e3 == 4 ? ones : vf##S[e3 & 3][ks], a, 0, 0, 0); \
                cacc[di][e3] = a; \
                u32x2 w; w.x = pk2(a.x, a.y); w.y = pk2(a.z, a.w); *(LAS u32x2*)(L + R2_CT + (e3 * 16 + fr) * 528 + ((wid * 2 + di) * 16 + fq * 4) * 2) = w; } } \
        __builtin_amdgcn_sched_barrier(0); \
        if ((c) + 1 < SEQ / 64) R2_LOADK((c) + 1); \
        __builtin_amdgcn_sched_barrier(0); \
        __syncthreads();                                                      \
    } while (0)
    R2_LOADQP(0); R2_LOADKV(A, 0); R2_LOADK(0);
    __syncthreads();
#pragma unroll 1
    for (int c = 0; c < SEQ / 64; c += 2) { R2_BODY(A, B, c); R2_BODY(B, A, c + 1); }
#undef R2_BODY
#undef R2_LOADK
#undef R2_LOADKV
#undef R2_LOADQP
    { float* pc = F.out + O_PC + ((size_t)((l * NB + b) * NH + hh)) * 65536;
#pragma unroll
      for (int di = 0; di < 2; ++di) { const int dt = wid * 2 + di;
#pragma unroll
        for (int e3 = 0; e3 < 4; ++e3)
#pragma unroll
            for (int j = 0; j < 4; ++j) pc[(size_t)(dt * 16 + fq * 4 + j) * 256 + sp * 64 + e3 * 16 + fr] = cacc[di][e3][j];
        if (sp == 0 && fr == 0) { float* pn = F.out + O_PN + ((size_t)((l * NB + b) * NH + hh)) * 256;
#pragma unroll
            for (int j = 0; j < 4; ++j) pn[dt * 16 + fq * 4 + j] = cacc[di][4][j]; } } }
    __syncthreads();
}

DI void mlstm_sample_job(Frame& F, int l, int job) {
    const int b = job >> 2, hh = job & 3; const int tid = opaque_tid(), lane = tid & 63, wid = __builtin_amdgcn_readfirstlane(tid >> 6);
    LAS float* qs = (LAS float*)F.lds;
    LAS float* kws = qs + 256; LAS float* red = qs + 512; LAS float* scal = qs + 512 + 2048;
    const bf16* prow = WSP(bf16, WS_PROJ) + (size_t)(MP + b) * NPROJ;
    const size_t sidx = (size_t)((l * MS + b) * NH + hh);
    const float* C = ((const float*)F.in[5]) + sidx * 65536; const float* nst = ((const float*)F.in[6]) + sidx * 256; float* Cn = F.out + O_SC + sidx * 65536;
    const float ig = WSP(float, WS_IGFG)[(size_t)(MP + b) * 8 + hh], fg = WSP(float, WS_IGFG)[(size_t)(MP + b) * 8 + 4 + hh];
    const float m0 = ((const float*)F.in[7])[sidx];
    const float lf = log_sigmoid(fg), mt = fmaxf(m0 + lf, ig), inter = expf(m0 + lf - mt), wsi = expf(ig - mt);
    if (tid < 256) {
        const float q = bf2f(prow[C_Q + hh * 256 + tid]), k = bf2f(prow[C_K + hh * 256 + tid]) * 0.0625f;
        qs[tid] = q; kws[tid] = k * wsi;
        const float n0 = nst[tid];
        F.out[O_SN + sidx * 256 + tid] = inter * n0 + k * wsi;
        float qk = q * k, qn = q * n0;
        qk = wave_sum(qk); qn = wave_sum(qn);
        if (lane == 0) { scal[wid * 2] = qk; scal[wid * 2 + 1] = qn; }
    }
    __syncthreads();
    const float qk = scal[0] + scal[2] + scal[4] + scal[6], qn = scal[1] + scal[3] + scal[5] + scal[7];
    const float s = qk * wsi, den = s + inter * qn, inv = 1.0f / fmaxf(fabsf(den), expf(-mt));
    const u32x2 vw = *(const u32x2*)(prow + C_V + hh * 256 + lane * 4);
    const f32x4 v4 = (f32x4){lo16(vw.x), hi16(vw.x), lo16(vw.y), hi16(vw.y)};
    f32x4 acc = (f32x4){0.f, 0.f, 0.f, 0.f};
#pragma unroll 16
    for (int i = 0; i < 32; ++i) { const int d = wid * 32 + i; const f32x4 c = *(const f32x4*)(C + (size_t)d * 256 + lane * 4);
        acc += c * qs[d]; *(f32x4*)(Cn + (size_t)d * 256 + lane * 4) = c * inter + v4 * kws[d]; }
    *(LAS f32x4*)(red + wid * 256 + lane * 4) = acc;
    __syncthreads();
    if (tid < 256) { float qc = 0.f;
#pragma unroll
        for (int w = 0; w < 8; ++w) qc += red[w * 256 + tid];
        const float v = bf2f(prow[C_V + hh * 256 + tid]), so = bf2f(prow[C_O + hh * 256 + tid]);
        const float h = (s * v + inter * qc) * inv;
        WSP(bf16, WS_HC)[(size_t)(MP + b) * D + hh * 256 + tid] = (bf16)f2bf(so * h); }
    if (tid == 0) F.out[O_SM + sidx] = mt;
    __syncthreads();
}

DI void xattn_sample_job(Frame& F, int l, int job) {
    const int b = job >> 1, hp = job & 1; const int tid = opaque_tid(), lane = tid & 63, wid = __builtin_amdgcn_readfirstlane(tid >> 6);
    LAS float* part = (LAS float*)F.lds;
    const bf16* prow = WSP(bf16, WS_XQ) + (size_t)(MP + b) * D + hp * 512;
    const float* Kc = ((const float*)F.in[3]) + ((size_t)(l * MS + b) * NMEM) * 1024 + hp * 512 + lane * 8;
    const float* Vc = ((const float*)F.in[4]) + ((size_t)(l * MS + b) * NMEM) * 1024 + hp * 512 + lane * 8;
    float q[8]; { const u32x4 w = *(const u32x4*)(prow + lane * 8); unpack8(w, q); }
#pragma unroll
    for (int j = 0; j < 8; ++j) q[j] *= 0.0625f;
    float M = -3.0e38f, S = 0.f, acc[8];
#pragma unroll
    for (int j = 0; j < 8; ++j) acc[j] = 0.f;
    f32x4 kA[4][2], vA[4][2], kB[4][2], vB[4][2];
#define XS_LOAD(S_, g) do { _Pragma("unroll") for (int u = 0; u < 4; ++u) { const size_t o = (size_t)(wid + 8 * (4 * (g) + u)) * 1024; \
        k##S_[u][0] = *(const f32x4*)(Kc + o); k##S_[u][1] = *(const f32x4*)(Kc + o + 4); v##S_[u][0] = *(const f32x4*)(Vc + o); v##S_[u][1] = *(const f32x4*)(Vc + o + 4); } } while (0)
#define XS_STEP(S_) do { float sc4[4]; \
        _Pragma("unroll") for (int u = 0; u < 4; ++u) sc4[u] = (q[0] * k##S_[u][0].x + q[1] * k##S_[u][0].y) + (q[2] * k##S_[u][0].z + q[3] * k##S_[u][0].w) + (q[4] * k##S_[u][1].x + q[5] * k##S_[u][1].y) + (q[6] * k##S_[u][1].z + q[7] * k##S_[u][1].w); \
        _Pragma("unroll") for (int o = 1; o < 32; o <<= 1) { _Pragma("unroll") for (int u = 0; u < 4; ++u) sc4[u] += __shfl_xor(sc4[u], o); } \
        const float mn = fmaxf(fmaxf(M, fmaxf(sc4[0], sc4[1])), fmaxf(sc4[2], sc4[3])); const float corr = __expf(M - mn); M = mn; S *= corr; \
        _Pragma("unroll") for (int j = 0; j < 8; ++j) acc[j] *= corr; \
        _Pragma("unroll") for (int u = 0; u < 4; ++u) { const float p = __expf(sc4[u] - mn); S += p; \
            acc[0] += p * v##S_[u][0].x; acc[1] += p * v##S_[u][0].y; acc[2] += p * v##S_[u][0].z; acc[3] += p * v##S_[u][0].w; acc[4] += p * v##S_[u][1].x; acc[5] += p * v##S_[u][1].y; acc[6] += p * v##S_[u][1].z; acc[7] += p * v##S_[u][1].w; } } while (0)
    XS_LOAD(A, 0);
#pragma unroll 1
    for (int g = 0; g < 8; g += 2) { XS_LOAD(B, g + 1); XS_STEP(A); if (g + 2 < 8) XS_LOAD(A, g + 2); XS_STEP(B); }
#undef XS_LOAD
#undef XS_STEP
    { LAS float* pw = part + (wid * 2 + (lane >> 5)) * 260;
      if ((lane & 31) == 0) { pw[0] = M; pw[1] = S; }
      *(LAS f32x4*)(pw + 4 + (lane & 31) * 8) = (f32x4){acc[0], acc[1], acc[2], acc[3]}; *(LAS f32x4*)(pw + 4 + (lane & 31) * 8 + 4) = (f32x4){acc[4], acc[5], acc[6], acc[7]}; }
    __syncthreads();
    { const int hsel = tid >> 8, d = tid & 255; float mx = -3.0e38f;
#pragma unroll
      for (int w = 0; w < 8; ++w) mx = fmaxf(mx, part[(w * 2 + hsel) * 260]);
      float num = 0.f, den = 0.f;
#pragma unroll
      for (int w = 0; w < 8; ++w) { const LAS float* pw = part + (w * 2 + hsel) * 260; const float e = __expf(pw[0] - mx); den += e * pw[1]; num += e * pw[4 + d]; }
      WSP(bf16, WS_OX)[(size_t)(MP + b) * D + hp * 512 + tid] = (bf16)f2bf(num / den); }
    __syncthreads();
}

DI void phase_pool_d(Frame& F, int l) {
    const bf16* proj = WSP(bf16, WS_PROJ); bf16* dp = WSP(bf16, WS_DP);
    const int gt = F.vcu * 512 + opaque_tid(), gs = F.G * 512;
    for (int it = gt; it < (MP / 16) * 128; it += gs) {
        const int rb = (int)(it >> 7), cg = (int)(it & 127), row0 = rb * 16, t0 = row0 & (SEQ - 1), b = row0 >> 11, w = 2 << (cg >> 5);
        const bf16* up = proj + (size_t)row0 * NPROJ + C_U + cg * 8;
        float sum[8];
#pragma unroll
        for (int j = 0; j < 8; ++j) sum[j] = 0.f;
        for (int i = 1; i < w; ++i) if (t0 - i >= 0) { float f[8]; unpack8(*(const u32x4*)(up - (size_t)i * NPROJ), f);
#pragma unroll
            for (int j = 0; j < 8; ++j) sum[j] += f[j]; }
#pragma unroll 4
        for (int r = 0; r < 16; ++r) {
            const int t = t0 + r; float u0[8]; unpack8(*(const u32x4*)(up + (size_t)r * NPROJ), u0);
#pragma unroll
            for (int j = 0; j < 8; ++j) sum[j] += u0[j];
            const int nw = (t + 1 < w) ? t + 1 : w; const float inv = 1.0f / (float)nw;
            u32x4 o; o.x = pk2(sum[0] * inv - u0[0], sum[1] * inv - u0[1]); o.y = pk2(sum[2] * inv - u0[2], sum[3] * inv - u0[3]); o.z = pk2(sum[4] * inv - u0[4], sum[5] * inv - u0[5]); o.w = pk2(sum[6] * inv - u0[6], sum[7] * inv - u0[7]);
            *(u32x4*)(dp + (size_t)(row0 + r) * D + cg * 8) = o;
            if (t >= SEQ - 15) { float* pp = F.out + O_PPOOL + ((size_t)(l * NB + b) * 15 + (t - (SEQ - 15))) * 1024 + cg * 8;
                *(f32x4*)pp = (f32x4){u0[0], u0[1], u0[2], u0[3]}; *(f32x4*)(pp + 4) = (f32x4){u0[4], u0[5], u0[6], u0[7]}; }
            if (t - (w - 1) >= 0) { float f[8]; unpack8(*(const u32x4*)(up + (size_t)(r - (w - 1)) * NPROJ), f);
#pragma unroll
                for (int j = 0; j < 8; ++j) sum[j] -= f[j]; }
        }
    }
    for (int it = gt; it < MS * 128; it += gs) {
        const int b = (int)(it >> 7), cg = (int)(it & 127), w = 2 << (cg >> 5);
        const float* sp = ((const float*)F.in[8]) + ((size_t)(l * MS + b) * 15) * 1024 + cg * 8;
        float u0[8], sum[8]; { const u32x4 x = *(const u32x4*)(proj + (size_t)(MP + b) * NPROJ + C_U + cg * 8); unpack8(x, u0); }
#pragma unroll
        for (int j = 0; j < 8; ++j) sum[j] = u0[j];
        for (int i = 1; i < w; ++i) { const f32x4 a = *(const f32x4*)(sp + (size_t)(15 - i) * 1024), c = *(const f32x4*)(sp + (size_t)(15 - i) * 1024 + 4);
            sum[0] += a.x; sum[1] += a.y; sum[2] += a.z; sum[3] += a.w; sum[4] += c.x; sum[5] += c.y; sum[6] += c.z; sum[7] += c.w; }
        const float inv = 1.0f / (float)w;
        u32x4 o; o.x = pk2(sum[0] * inv - u0[0], sum[1] * inv - u0[1]); o.y = pk2(sum[2] * inv - u0[2], sum[3] * inv - u0[3]); o.z = pk2(sum[4] * inv - u0[4], sum[5] * inv - u0[5]); o.w = pk2(sum[6] * inv - u0[6], sum[7] * inv - u0[7]);
        *(u32x4*)(dp + (size_t)(MP + b) * D + cg * 8) = o;
        float* so = F.out + O_SPOOL + ((size_t)(l * MS + b) * 15) * 1024 + cg * 8;
        for (int i = 0; i < 14; ++i) { *(f32x4*)(so + (size_t)i * 1024) = *(const f32x4*)(sp + (size_t)(i + 1) * 1024); *(f32x4*)(so + (size_t)i * 1024 + 4) = *(const f32x4*)(sp + (size_t)(i + 1) * 1024 + 4); }
        *(f32x4*)(so + (size_t)14 * 1024) = (f32x4){u0[0], u0[1], u0[2], u0[3]}; *(f32x4*)(so + (size_t)14 * 1024 + 4) = (f32x4){u0[4], u0[5], u0[6], u0[7]};
    }
}

DI void phase_headnorm(Frame& F, int l) {
    const bf16* hc = WSP(bf16, WS_HC); bf16* hn = WSP(bf16, WS_HN); const float* g = ((const float*)F.in[14]) + (size_t)l * D;
    const int tid = opaque_tid(), lane = tid & 63, wid = __builtin_amdgcn_readfirstlane(tid >> 6);
    const int gw = F.vcu * 8 + wid, NGW = F.G * 8;
    f32x4 gg[4];
#pragma unroll
    for (int h = 0; h < 4; ++h) gg[h] = *(const f32x4*)(g + h * 256 + lane * 4);
    u32x2 nw[4];
    if (gw < MT) {
#pragma unroll
        for (int h = 0; h < 4; ++h) nw[h] = *(const u32x2*)(hc + (size_t)gw * D + lane * 4 + h * 256); }
    for (int r = gw; r < MT; r += NGW) {
        const size_t off = (size_t)r * D + lane * 4;
        u32x2 w[4];
#pragma unroll
        for (int h = 0; h < 4; ++h) w[h] = nw[h];
        if (r + NGW < MT) {
#pragma unroll
            for (int h = 0; h < 4; ++h) nw[h] = *(const u32x2*)(hc + (size_t)(r + NGW) * D + lane * 4 + h * 256); }
        float x[4][4], mu[4], var[4];
#pragma unroll
        for (int h = 0; h < 4; ++h) { x[h][0] = lo16(w[h].x); x[h][1] = hi16(w[h].x); x[h][2] = lo16(w[h].y); x[h][3] = hi16(w[h].y); mu[h] = (x[h][0] + x[h][1]) + (x[h][2] + x[h][3]); }
#pragma unroll
        for (int o = 1; o < 64; o <<= 1) {
#pragma unroll
            for (int h = 0; h < 4; ++h) mu[h] += __shfl_xor(mu[h], o); }
#pragma unroll
        for (int h = 0; h < 4; ++h) { mu[h] *= (1.f / 256.f);
#pragma unroll
            for (int j = 0; j < 4; ++j) x[h][j] -= mu[h];
            var[h] = (x[h][0] * x[h][0] + x[h][1] * x[h][1]) + (x[h][2] * x[h][2] + x[h][3] * x[h][3]); }
#pragma unroll
        for (int o = 1; o < 64; o <<= 1) {
#pragma unroll
            for (int h = 0; h < 4; ++h) var[h] += __shfl_xor(var[h], o); }
#pragma unroll
        for (int h = 0; h < 4; ++h) { const float rr = 1.f / sqrtf(var[h] * (1.f / 256.f) + LN_EPS);
            u32x2 o; o.x = pk2(x[h][0] * rr * gg[h].x, x[h][1] * rr * gg[h].y); o.y = pk2(x[h][2] * rr * gg[h].z, x[h][3] * rr * gg[h].w);
            *(u32x2*)(hn + off + h * 256) = o; }
    }
}

constexpr int PH_PER_L = 10, PH_TOTAL = 2 + DEPTH * PH_PER_L;
struct Args { const float* in[29]; float* out; unsigned char* ws; int ph_lo, ph_hi, li, pad; };
__global__ void __launch_bounds__(512, 2) trunk_fwd(Args args) {
    extern __shared__ __attribute__((aligned(16))) unsigned char lds_raw[];
    Frame F0;
    F0.lds = (LAS unsigned char*)lds_raw;
    F0.G = gridDim.x; { const int bx = blockIdx.x; F0.vcu = (F0.G % 8 == 0) ? (bx % 8) * (F0.G / 8) + bx / 8 : bx; }
    F0.in = (in_tab_t)__builtin_amdgcn_kernarg_segment_ptr(); F0.out = args.out; F0.ws = args.ws;
    volatile LAS unsigned* MISC = (volatile LAS unsigned*)(F0.lds + MISC_OFF);
    if (threadIdx.x < 64) MISC[threadIdx.x] = 0u;
    __syncthreads();
    unsigned* ctl = (unsigned*)(args.ws + WS_CTL);
    XcdBarrier bar = xcd_barrier_post(ctl + CW_BAR + args.li * XCD_BAR_WORDS, MISC + 8);
    const int lo = args.ph_lo, hi = args.ph_hi;
#define IN(k) (lo <= (k) && (k) < hi)
#define PM(b) ((PHMASK >> (b)) & 1u)
#define SEAM(k) do { if (IN(k) && IN((k) + 1)) xcd_barrier(bar); } while (0)
    const int bx0 = (int)blockIdx.x;

    _Pragma("unroll 1") for (int rep = 0; rep <= REP(16); ++rep) if (PM(0) && IN(0)) { if (rep) xcd_barrier(bar); PHASE_BEGIN(F); phase_convert(F); __syncthreads(); phase_ln_in(F); }
    SEAM(0);
    _Pragma("unroll 1") for (int rep = 0; rep <= REP(17); ++rep) if (PM(1) && IN(1)) { if (rep) xcd_barrier(bar);
        PHASE_BEGIN(F);
        pg8::OrderMN S; S.init(WSP(bf16, WS_MEMB), D, WSP(bf16, WS_WKV), D, 2048, DEPTH * 2048, F.G, bx);
        pg8::EpiGran<GeKV> E{{F.out, WSP(bf16, WS_MK), WSP(bf16, WS_MVT)}};
        pg8::gemm_phase(F.lds, D, D, D, S, E);
    }
    SEAM(1);
    for (int l = 0; l < DEPTH; ++l) {
        const int p0 = 2 + l * PH_PER_L;
        _Pragma("unroll 1") for (int rep = 0; rep <= REP(0); ++rep) if (PM(2) && IN(p0 + 0)) { if (rep) xcd_barrier(bar);
            PHASE_BEGIN(F);
            const bf16* W = WSP(bf16, WS_WIN + l * SZ_WIN);
            pg8::OrderMN S; S.init(WSP(bf16, WS_XN), D, W, D, MP, NPROJ, F.G, bx);
            pg8::EpiGran<GeIn> E{{WSP(bf16, WS_PROJ), ((const float*)F.in[13]) + (size_t)l * INW, WSP(bf16, WS_XQ), true}}; GeIn gs = E.g; gs.pre = false;
            pg8::gemm_phase(F.lds, D, D, D, S, E);
            skinny_gemm_sk3(F, WSP(bf16, WS_XN) + (size_t)MP * D, D, W, D, NPROJ, gs);
        }
        SEAM(p0 + 0);
        _Pragma("unroll 1") for (int rep = 0; rep <= REP(1); ++rep) if (PM(3) && IN(p0 + 1)) { if (rep) xcd_barrier(bar);
            PHASE_BEGIN(F);
            _Pragma("unroll 1") for (int sr = 0; sr <= SREP(0); ++sr) if (SM(0)) for (int j = F.vcu; j < 256; j += F.G) mlstm_prep_job(F, l, j);
            _Pragma("unroll 1") for (int sr = 0; sr <= SREP(1); ++sr) if (SM(1)) {
                OrderAttn<(size_t)D * 2, (size_t)256 * 2, (size_t)256 * D * 2, (size_t)256 * 2> S{F.G, bx, (const char*)WSP(bf16, WS_XQ), (const char*)(WSP(bf16, WS_MK) + (size_t)l * 2048 * D)};
                EpiSoftmax E{WSP(bf16, WS_PB), (LAS float*)(F.lds + XCH_OFF)};
                pg8::gemm_phase(F.lds, 256, D, D, S, E);
            }
            _Pragma("unroll 1") for (int sr = 0; sr <= SREP(3); ++sr) if (SM(3)) for (int j = F.vcu; j < MS * 2; j += F.G) xattn_sample_job(F, l, j);
        }
        SEAM(p0 + 1);
        _Pragma("unroll 1") for (int rep = 0; rep <= REP(2); ++rep) if (PM(4) && IN(p0 + 2)) { if (rep) xcd_barrier(bar);
            PHASE_BEGIN(F);
            const bool split = (F.G % 16 == 0);
            const int xr = bx >> 3, xi = bx & 7, hx = F.G >> 4;
            const bool rec_role = !split || xr < hx;
            const int ri = split ? xi * hx + xr : F.vcu, rn = split ? F.G / 2 : F.G;
            const int oi = split ? xi * hx + (xr - hx) : F.vcu, on = split ? F.G / 2 : F.G;
            if (rec_role) { _Pragma("unroll 1") for (int sr = 0; sr <= SREP(5); ++sr) if (SM(5)) for (int j = ri; j < 128; j += rn) mlstm_rec2_job(F, l, j); }
            if (!split || !rec_role) {
                Frame F2 = F; F2.vcu = oi; F2.G = on;
                if (SM(6)) { OrderAttn<(size_t)D * 2, (size_t)256 * 2, (size_t)256 * 2, (size_t)256 * 2048 * 2> S{on, oi, (const char*)WSP(bf16, WS_PB), (const char*)(WSP(bf16, WS_MVT) + (size_t)l * 1024 * 2048)};
                    pg8::EpiGran<GeBf16> E{{WSP(bf16, WS_OX), D}};
                    pg8::gemm_phase(F.lds, 256, D, 2048, S, E); }
                _Pragma("unroll 1") for (int sr = 0; sr <= SREP(4); ++sr) if (SM(4)) phase_pool_d(F2, l);
            }
            if (SM(2)) { unsigned* qc = (unsigned*)(F.ws + WS_CTL) + CW_QUEUE + 64 * (l + 4 * rep); volatile LAS unsigned* slot = (volatile LAS unsigned*)(F.lds + MISC_OFF) + 16;
                for (;;) {
                    __syncthreads();
                    if (threadIdx.x == 0) *slot = __hip_atomic_fetch_add(qc, 1u, __ATOMIC_RELAXED, __HIP_MEMORY_SCOPE_AGENT);
                    __syncthreads();
                    const int j = (int)*slot;
                    if (j >= MS * NH) break;
                    mlstm_sample_job(F, l, j);
                } }
        }
        SEAM(p0 + 2);
        _Pragma("unroll 1") for (int rep = 0; rep <= REP(3); ++rep) if (PM(5) && IN(p0 + 3)) { if (rep) xcd_barrier(bar); PHASE_BEGIN(F); phase_headnorm(F, l); }
        SEAM(p0 + 3);
        _Pragma("unroll 1") for (int rep = 0; rep <= REP(4); ++rep) if (PM(6) && IN(p0 + 4)) { if (rep) xcd_barrier(bar);
            PHASE_BEGIN(F);
            const bf16* proj = WSP(bf16, WS_PROJ); float* mix = WSP(float, WS_MIX); bf16* mixb = WSP(bf16, WS_MIXB); const float* ps = ((const float*)F.in[17]) + (size_t)l * D;
            const bf16* Wm = WSP(bf16, WS_WM + l * SZ_W1K); const bf16* Wp = WSP(bf16, WS_WP + l * SZ_WP); const bf16* Wx = WSP(bf16, WS_WX + l * SZ_W1K);
            { OrderD S; S.inner.init(WSP(bf16, WS_HN), D, Wm, D, MP, D, F.G, bx);
              S.A0 = (const char*)WSP(bf16, WS_HN); S.A1 = (const char*)WSP(bf16, WS_DP); S.A2 = (const char*)WSP(bf16, WS_OX); S.B0 = (const char*)Wm; S.B1 = (const char*)Wp; S.B2 = (const char*)Wx;
              EpiMixChain E{mixb, proj, ps}; pg8::gemm_phase(F.lds, D, D, D, S, E); }
            { GeMix<0> g0{mix, mixb, proj, ps}; GeMix<1> g1{mix, mixb, proj, ps}; GeMix<2> g2{mix, mixb, proj, ps};
              skinny_gemm_sk(F, WSP(bf16, WS_HN) + (size_t)MP * D, D, Wm, D, D, g0);
              for (int job = F.vcu; job < 256; job += F.G) { const int rt = job >> 5, cp = job & 31, g = cp >> 3;
                  skinny_job_sk(F, WSP(bf16, WS_DP) + (size_t)MP * D + g * 256, D, Wp + (size_t)(cp * 32) * D + g * 256, D, 256, g1, rt, cp * 32); }
              skinny_gemm_sk(F, WSP(bf16, WS_OX) + (size_t)MP * D, D, Wx, D, D, g2); }
        }
        SEAM(p0 + 4);
        _Pragma("unroll 1") for (int rep = 0; rep <= REP(5); ++rep) if (PM(7) && IN(p0 + 5)) { if (rep) xcd_barrier(bar);
            PHASE_BEGIN(F);
            const bf16* W = WSP(bf16, WS_WO + l * SZ_W1K); pg8::OrderMN S; S.init(WSP(bf16, WS_MIXB), D, W, D, MP, D, F.G, bx);
            pg8::EpiGran<GeRes> E{{WSP(float, WS_X), WSP(float, WS_T), true}}; GeRes gs = E.g; gs.pre = false; pg8::gemm_phase(F.lds, D, D, D, S, E);
            skinny_gemm_sk(F, WSP(bf16, WS_MIXB) + (size_t)MP * D, D, W, D, D, gs);
        }
        SEAM(p0 + 5);
        _Pragma("unroll 1") for (int rep = 0; rep <= REP(6); ++rep) if (PM(8) && IN(p0 + 6)) { if (rep) xcd_barrier(bar); PHASE_BEGIN(F); phase_ln(F, l, 0); }
        SEAM(p0 + 6);
        _Pragma("unroll 1") for (int rep = 0; rep <= REP(7); ++rep) if (PM(9) && IN(p0 + 7)) { if (rep) xcd_barrier(bar);
            PHASE_BEGIN(F);
            const bf16* W = WSP(bf16, WS_WUP + l * SZ_WUP); pg8::OrderMN S; S.init(WSP(bf16, WS_XN), D, W, D, MP, FF2, F.G, bx);
            EpiConv E{WSP(bf16, WS_ACT), WSP(float, WS_HALO), F.out, ((const float*)F.in[24]) + (size_t)l * 3 * FF2, ((const float*)F.in[25]) + (size_t)l * FF2, (LAS float*)(F.lds + XCH_OFF), l};
            pg8::gemm_phase(F.lds, D, D, D, S, E);
            { const int nun = (MP / 256) * (FF2 / 256), nfull = nun % F.G;
              if (nfull == 0) skinny_up_conv(F, l, W, F.vcu, F.G); else if (bx >= nfull) skinny_up_conv(F, l, W, bx - nfull, F.G - nfull); }
        }
        SEAM(p0 + 7);
        _Pragma("unroll 1") for (int rep = 0; rep <= REP(8); ++rep) if (PM(10) && IN(p0 + 8)) { if (rep) xcd_barrier(bar);
            PHASE_BEGIN(F);
            const bf16* W = WSP(bf16, WS_WDN + l * SZ_WDN); pg8::OrderMN S; S.init(WSP(bf16, WS_ACT), FF, W, FF, MP, D, F.G, bx);
            { pg8::Unit uu; for (int i = 0; S.next(i, uu); ++i) conv_fixup(F, l, uu.pm); VM_WAIT(); __syncthreads(); }
            pg8::EpiGran<GeRes> E{{WSP(float, WS_X), WSP(float, WS_T), true}}; GeRes gs = E.g; gs.pre = false; pg8::gemm_phase(F.lds, FF, FF, FF, S, E);
            skinny_gemm_sk(F, WSP(bf16, WS_ACT) + (size_t)MP * FF, FF, W, FF, FF, gs);
        }
        SEAM(p0 + 8);
        _Pragma("unroll 1") for (int rep = 0; rep <= REP(9); ++rep) if (PM(11) && IN(p0 + 9)) { if (rep) xcd_barrier(bar); PHASE_BEGIN(F); phase_ln(F, l, 1); }
        SEAM(p0 + 9);
    }
#undef IN
#undef SEAM
}

extern "C" void kernel_launch(void* const* d_in, const int* in_sizes, int n_in, void* d_out, int out_size, void* d_ws, size_t ws_size, hipStream_t stream) {
    static int grid = 0;
    if (grid == 0) {
        if (n_in != 29 || (size_t)out_size != O_END || ws_size < WS_END) { fprintf(stderr, "kernel_launch: unexpected shapes (n_in %d, out %d, ws %zu; need ws >= %zu)\n", n_in, out_size, ws_size, (size_t)WS_END); grid = -1; return; }
        int dev = 0, cus = 0, per_cu = 0;
        if (hipGetDevice(&dev) != hipSuccess || hipDeviceGetAttribute(&cus, hipDeviceAttributeMultiprocessorCount, dev) != hipSuccess) { grid = -1; return; }
        if (hipFuncSetAttribute((const void*)trunk_fwd, hipFuncAttributeMaxDynamicSharedMemorySize, LDS_BYTES) != hipSuccess) { fprintf(stderr, "kernel_launch: hipFuncSetAttribute failed\n"); grid = -1; return; }
        if (hipOccupancyMaxActiveBlocksPerMultiprocessor(&per_cu, (const void*)trunk_fwd, 512, LDS_BYTES) != hipSuccess || per_cu < 1) fprintf(stderr, "kernel_launch: occupancy query reports %d\n", per_cu);
        (void)hipGetLastError();
        grid = cus;
    }
    if (grid < 0) return;
    (void)hipMemsetAsync((char*)d_ws + WS_CTL, 0, CTL_BYTES, stream);
    Args a{};
    for (int i = 0; i < 29; ++i) a.in[i] = (const float*)d_in[i];
    a.out = (float*)d_out; a.ws = (unsigned char*)d_ws; a.pad = 0;
#if MK_SPLIT
    for (int p = 0; p < PH_TOTAL; ++p) { a.ph_lo = p; a.ph_hi = p + 1; a.li = p; hipLaunchKernelGGL(trunk_fwd, dim3(grid), dim3(512), LDS_BYTES, stream, a); }
#else
    a.ph_lo = 0; a.ph_hi = PH_TOTAL; a.li = 0;
    hipLaunchKernelGGL(trunk_fwd, dim3(grid), dim3(512), LDS_BYTES, stream, a);
#endif
}
```
